# Optimizing an MI355X kernel written in HIP

```python
import jax
import jax.numpy as jnp
from jax import lax
import numpy as np


D_MODEL = 1024
BATCH = 8
SEQ = 8192
DEPTH = 2

N_EVEN = (DEPTH + 1) // 2
N_ODD = DEPTH // 2

GLA_HEADS = 4
GLA_DK = D_MODEL // 2 // GLA_HEADS
GLA_DV = D_MODEL // GLA_HEADS
GLA_KEY_WIDTH = GLA_HEADS * GLA_DK
GLA_VALUE_WIDTH = GLA_HEADS * GLA_DV
GLA_GATE_RANK = 16
GLA_GATE_TAU = 16.0
GLA_CHUNK = 64
GLA_SPLITS = tuple(int(s) for s in np.cumsum([GLA_KEY_WIDTH, GLA_KEY_WIDTH, GLA_VALUE_WIDTH, GLA_VALUE_WIDTH, GLA_GATE_RANK]))
GLA_IN_WIDTH = 2 * GLA_KEY_WIDTH + 2 * GLA_VALUE_WIDTH + 2 * GLA_GATE_RANK

N_Q_HEADS = 16
N_KV_HEADS = 4
HEAD_DIM = 64
GROUP = N_Q_HEADS // N_KV_HEADS
WINDOW = 128
ATT_BLOCK = 128
SWA_QKV_WIDTH = (N_Q_HEADS + 2 * N_KV_HEADS) * HEAD_DIM

D_FF = 2816
N_EXPERTS = 8
TOP_K = 2

NORM_EPS = 1e-5

kernel_name = 'hybrid_gla_swa_moe_encoder'


def rms_norm(x, gain):
    xf = x.astype(jnp.float32)
    y = xf * lax.rsqrt(jnp.mean(xf * xf, axis=-1, keepdims=True) + NORM_EPS)
    return (y * gain.astype(jnp.float32)).astype(x.dtype)


def alibi_slopes(n_heads):
    return jnp.asarray(np.power(2.0, -8.0 * np.arange(1, n_heads + 1) / n_heads).astype(np.float32))


def gla_chunked(q, k, v, log_a, inclusive):
    B, H, S, dk = q.shape
    dv = v.shape[-1]
    C = GLA_CHUNK
    n = S // C
    q = q.reshape(B, H, n, C, dk)
    k = k.reshape(B, H, n, C, dk)
    v = v.reshape(B, H, n, C, dv)
    b = jnp.cumsum(log_a.reshape(B, H, n, C, dk), axis=3)
    b_ref = b[:, :, :, C // 2:C // 2 + 1]
    qe = q * jnp.exp(b - b_ref)
    ke = k * jnp.exp(b_ref - b)
    scores = jnp.einsum('bhnik,bhnjk->bhnij', qe, ke)
    mask = jnp.tril(jnp.ones((C, C), dtype=bool), 0 if inclusive else -1)
    scores = jnp.where(mask, scores, 0.0)
    o_intra = jnp.einsum('bhnij,bhnjv->bhniv', scores, v)
    b_last = b[:, :, :, -1:]
    chunk_update = jnp.einsum('bhnjk,bhnjv->bhnkv', k * jnp.exp(b_last - b), v)
    chunk_decay = jnp.exp(b_last[:, :, :, 0])

    def step(state, inp):
        decay, upd = inp
        return state * decay[..., None] + upd, state

    init = jnp.zeros((B, H, dk, dv), jnp.float32)
    _, prev = lax.scan(step, init, (jnp.moveaxis(chunk_decay, 2, 0), jnp.moveaxis(chunk_update, 2, 0)))
    prev = jnp.moveaxis(prev, 0, 2)
    o_inter = jnp.einsum('bhnik,bhnkv->bhniv', q * jnp.exp(b), prev)
    return (o_intra + o_inter).reshape(B, H, S, dv)


def gla_mixer(h, w_in, wg_f, bg_f, wg_b, bg_b, head_gain, w_out):
    B, S, _ = h.shape
    proj = (h @ w_in).astype(jnp.float32)
    q, k, v, r, lr_f, lr_b = jnp.split(proj, GLA_SPLITS, axis=-1)

    def heads(t, d):
        return t.reshape(B, S, GLA_HEADS, d).transpose(0, 2, 1, 3)

    q = heads(q, GLA_DK) * (GLA_DK ** -0.5)
    k = heads(k, GLA_DK)
    v = heads(v, GLA_DV)
    log_a_f = heads(jax.nn.log_sigmoid(lr_f @ wg_f.astype(jnp.float32) + bg_f.astype(jnp.float32)) / GLA_GATE_TAU, GLA_DK)
    log_a_b = heads(jax.nn.log_sigmoid(lr_b @ wg_b.astype(jnp.float32) + bg_b.astype(jnp.float32)) / GLA_GATE_TAU, GLA_DK)
    o_f = gla_chunked(q, k, v, log_a_f, True)
    flip = lambda t: jnp.flip(t, axis=2)
    o_b = flip(gla_chunked(flip(q), flip(k), flip(v), flip(log_a_b), False))
    o = (o_f + o_b).transpose(0, 2, 1, 3)
    o = o * lax.rsqrt(jnp.mean(o * o, axis=-1, keepdims=True) + NORM_EPS)
    o = o * head_gain.astype(jnp.float32).reshape(GLA_HEADS, GLA_DV)
    o = o.reshape(B, S, GLA_VALUE_WIDTH) * jax.nn.silu(r)
    return o.astype(h.dtype) @ w_out


def swa_mixer(h, w_qkv, b_qkv, sinks, w_out, b_out):
    B, S, _ = h.shape
    T = ATT_BLOCK
    n = S // T
    qkv = (h @ w_qkv + b_qkv).astype(jnp.float32)
    q, k, v = jnp.split(qkv, (N_Q_HEADS * HEAD_DIM, (N_Q_HEADS + N_KV_HEADS) * HEAD_DIM), axis=-1)
    q = q.reshape(B, n, T, N_KV_HEADS, GROUP, HEAD_DIM) * (HEAD_DIM ** -0.5)
    k = k.reshape(B, n, T, N_KV_HEADS, HEAD_DIM)
    v = v.reshape(B, n, T, N_KV_HEADS, HEAD_DIM)
    pad = ((0, 0), (1, 1), (0, 0), (0, 0), (0, 0))
    kp = jnp.pad(k, pad)
    vp = jnp.pad(v, pad)
    kw = jnp.concatenate([kp[:, :-2], kp[:, 1:-1], kp[:, 2:]], axis=2)
    vw = jnp.concatenate([vp[:, :-2], vp[:, 1:-1], vp[:, 2:]], axis=2)
    scores = jnp.einsum('bnqhgd,bnkhd->bnhgqk', q, kw)
    q_pos = jnp.arange(n)[:, None] * T + jnp.arange(T)[None, :]
    k_pos = (jnp.arange(n)[:, None] - 1) * T + jnp.arange(3 * T)[None, :]
    dist = jnp.abs(q_pos[:, :, None] - k_pos[:, None, :])
    valid = (dist <= WINDOW) & (k_pos >= 0)[:, None, :] & (k_pos < S)[:, None, :]
    slopes = alibi_slopes(N_Q_HEADS).reshape(N_KV_HEADS, GROUP)
    bias = jnp.where(valid[:, None, None], -slopes[None, :, :, None, None] * dist[:, None, None].astype(jnp.float32), -jnp.inf)
    scores = scores + bias[None]
    sink = sinks.astype(jnp.float32).reshape(N_KV_HEADS, GROUP)[None, None, :, :, None, None]
    m = jnp.maximum(jnp.max(scores, axis=-1, keepdims=True), sink)
    p = jnp.exp(scores - m)
    denom = jnp.sum(p, axis=-1, keepdims=True) + jnp.exp(sink - m)
    out = jnp.einsum('bnhgqk,bnkhd->bnqhgd', p / denom, vw)
    out = out.reshape(B, S, N_Q_HEADS * HEAD_DIM).astype(h.dtype)
    return out @ w_out + b_out


def swiglu(h, w_gate, w_up, w_down):
    return (jax.nn.silu(h @ w_gate) * (h @ w_up)) @ w_down


def moe_swiglu(h, router, w_gate, w_up, w_down):
    B, S, D = h.shape
    t = h.reshape(B * S, D)
    logits = (t @ router).astype(jnp.float32)
    top_val, top_idx = lax.top_k(logits, TOP_K)
    top_w = jax.nn.softmax(top_val, axis=-1)
    combine = jnp.sum(jax.nn.one_hot(top_idx, N_EXPERTS, dtype=jnp.float32) * top_w[..., None], axis=1)
    out = jnp.zeros((B * S, D), jnp.float32)
    for e in range(N_EXPERTS):
        out = out + combine[:, e:e + 1] * swiglu(t, w_gate[e], w_up[e], w_down[e]).astype(jnp.float32)
    return out.astype(h.dtype).reshape(B, S, D)


def _normal(key, shape, scale):
    return jax.random.normal(key, shape, jnp.float32) * scale


def setup_inputs(seed: int = 0) -> dict:
    key = jax.random.key(seed)
    ks = jax.random.split(key, 24)
    D, F, E = D_MODEL, D_FF, N_EXPERTS
    return {
        'x': _normal(ks[0], (BATCH, SEQ, D), 1.0),
        'mix_norm': 1.0 + _normal(ks[1], (DEPTH, D), 0.02),
        'ffn_norm': 1.0 + _normal(ks[2], (DEPTH, D), 0.02),
        'gla_in_proj': _normal(ks[3], (N_EVEN, D, GLA_IN_WIDTH), D ** -0.5),
        'gla_gate_w_fwd': _normal(ks[4], (N_EVEN, GLA_GATE_RANK, GLA_KEY_WIDTH), GLA_GATE_RANK ** -0.5),
        'gla_gate_b_fwd': _normal(ks[5], (N_EVEN, GLA_KEY_WIDTH), 0.1),
        'gla_gate_w_bwd': _normal(ks[6], (N_EVEN, GLA_GATE_RANK, GLA_KEY_WIDTH), GLA_GATE_RANK ** -0.5),
        'gla_gate_b_bwd': _normal(ks[7], (N_EVEN, GLA_KEY_WIDTH), 0.1),
        'gla_head_norm': 1.0 + _normal(ks[8], (N_EVEN, GLA_VALUE_WIDTH), 0.02),
        'gla_out_proj': _normal(ks[9], (N_EVEN, GLA_VALUE_WIDTH, D), GLA_VALUE_WIDTH ** -0.5),
        'swa_qkv_proj': _normal(ks[10], (N_ODD, D, SWA_QKV_WIDTH), D ** -0.5),
        'swa_qkv_bias': _normal(ks[11], (N_ODD, SWA_QKV_WIDTH), 0.02),
        'swa_sinks': _normal(ks[12], (N_ODD, N_Q_HEADS), 0.5),
        'swa_out_proj': _normal(ks[13], (N_ODD, N_Q_HEADS * HEAD_DIM, D), (N_Q_HEADS * HEAD_DIM) ** -0.5),
        'swa_out_bias': _normal(ks[14], (N_ODD, D), 0.02),
        'dense_w_gate': _normal(ks[15], (N_EVEN, D, F), D ** -0.5),
        'dense_w_up': _normal(ks[16], (N_EVEN, D, F), D ** -0.5),
        'dense_w_down': _normal(ks[17], (N_EVEN, F, D), F ** -0.5),
        'moe_router': _normal(ks[18], (N_ODD, D, E), D ** -0.5),
        'moe_w_gate': _normal(ks[19], (N_ODD, E, D, F), D ** -0.5),
        'moe_w_up': _normal(ks[20], (N_ODD, E, D, F), D ** -0.5),
        'moe_w_down': _normal(ks[21], (N_ODD, E, F, D), F ** -0.5),
        'final_norm': 1.0 + _normal(ks[22], (D,), 0.02),
    }


def reference(x, mix_norm, ffn_norm, gla_in_proj, gla_gate_w_fwd, gla_gate_b_fwd, gla_gate_w_bwd, gla_gate_b_bwd,
              gla_head_norm, gla_out_proj, swa_qkv_proj, swa_qkv_bias, swa_sinks, swa_out_proj, swa_out_bias,
              dense_w_gate, dense_w_up, dense_w_down, moe_router, moe_w_gate, moe_w_up, moe_w_down, final_norm):
    h = x
    for i in range(DEPTH):
        j = i // 2
        hn = rms_norm(h, mix_norm[i])
        if i % 2 == 0:
            h = h + gla_mixer(hn, gla_in_proj[j], gla_gate_w_fwd[j], gla_gate_b_fwd[j], gla_gate_w_bwd[j],
                              gla_gate_b_bwd[j], gla_head_norm[j], gla_out_proj[j])
        else:
            h = h + swa_mixer(hn, swa_qkv_proj[j], swa_qkv_bias[j], swa_sinks[j], swa_out_proj[j], swa_out_bias[j])
        hn = rms_norm(h, ffn_norm[i])
        if i % 2 == 0:
            h = h + swiglu(hn, dense_w_gate[j], dense_w_up[j], dense_w_down[j])
        else:
            h = h + moe_swiglu(hn, moe_router[j], moe_w_gate[j], moe_w_up[j], moe_w_down[j])
    return rms_norm(h, final_norm)
```

```cpp
#include <hip/hip_runtime.h>
#include <cstdio>
#include <cstdint>
namespace pg8 {
#define PG8_LAS __attribute__((address_space(3)))
typedef unsigned short bf16_t;
typedef short bf16x8 __attribute__((ext_vector_type(8)));
typedef float f32x4 __attribute__((ext_vector_type(4)));
typedef unsigned u32x4 __attribute__((ext_vector_type(4)));
constexpr int BM = 256, BK = 64, HALF = 128, HTB = HALF * BK * 2  , STAGE_BYTES = 8 * HTB, NXCD = 8, WGM = 8;

__host__ __device__ __forceinline__ int lds_byte(int r, int c) { const int st = (r >> 4) * 2 + (c >> 5), rr = r & 15, cc = c & 31, ob = rr * 64 + cc * 2; return st * 1024 + (ob ^ (((ob >> 9) & 1) << 5)); }
__host__ __device__ __forceinline__ void stage_rc(int b, int& R, int& C) { const int st = b / 1024, sb = b % 1024, swz = sb ^ (((sb >> 9) & 1) << 5); R = (st >> 1) * 16 + swz / 64; C = (st & 1) * 32 + (swz % 64) / 2; }
__host__ __device__ __forceinline__ int perm32(int rho) { const int n = rho >> 4, i = rho & 15; return 8 * (i >> 2) + 4 * n + (i & 3); }

struct Unit { int pm, pn; };
struct Gemm { const bf16_t* A; const bf16_t* Bt; int M, N, K; };

struct StaticOrder {
    int nM, nN, nwg, G, c;
    __host__ __device__ void init(int M, int N, int G_, int c_) { nM = M / BM; nN = N / BM; nwg = nM * nN; G = G_; c = c_; }
    __host__ __device__ bool next(int i, Unit& u) const {
        const long L = (long)i * G + c; if (L >= nwg) return false;
        int wgid = (int)L; { const int q = nwg / NXCD, r = nwg % NXCD, xcd = wgid % NXCD, off = wgid / NXCD; wgid = (xcd < r ? xcd * (q + 1) : r * (q + 1) + (xcd - r) * q) + off; }
        const int nig = WGM * nN, gid = wgid / nig, fm = gid * WGM, gsz = (nM - fm) < WGM ? (nM - fm) : WGM;
        u.pm = fm + ((wgid % nig) % gsz); u.pn = (wgid % nig) / gsz; return true;
    }
    __device__ __forceinline__ void a_ready(const Unit&) const {}
    __device__ __forceinline__ void done(const Unit&) const {}
};

__device__ __forceinline__ unsigned cvt_pk_bf16(float lo, float hi) { unsigned r; asm volatile("v_cvt_pk_bf16_f32 %0, %1, %2" : "=v"(r) : "v"(lo), "v"(hi)); return r; }
typedef float f32x2 __attribute__((ext_vector_type(2)));

typedef unsigned u32x2 __attribute__((ext_vector_type(2)));
typedef float f32x2_t __attribute__((ext_vector_type(2))); typedef __bf16 bf16x2_t __attribute__((ext_vector_type(2)));
__device__ __forceinline__ unsigned cvt2(float lo, float hi) { f32x2_t v = {lo, hi}; bf16x2_t b = __builtin_convertvector(v, bf16x2_t); return __builtin_bit_cast(unsigned, b); }
__device__ __forceinline__ u32x4 pack8(f32x4 a, f32x4 b) { u32x4 w; w.x = cvt2(a[0], a[1]); w.y = cvt2(a[2], a[3]); w.z = cvt2(b[0], b[1]); w.w = cvt2(b[2], b[3]); return w; }

struct EpiGlaIn {
    static constexpr bool PERM = true, AFTER_DRAIN = false;
    bf16_t *Q0, *K0, *V0, *R0; float* LR;
    __device__ __forceinline__ void operator()(const f32x4 (&acc)[2][2][4][2], const Unit& u, int wr, int wc, int fr, int fq) const {
        const int pn = u.pn; const int row0 = u.pm * BM + wr * 64 + fr; const int cw = wc * 32 + 8 * fq;
        if (pn < 12) {
            bf16_t* base; int ld, c0; float sc = 1.f;
            if (pn < 2) { base = Q0; ld = 512; c0 = pn * 256; sc = 0.08838834764831845f; }
            else if (pn < 4) { base = K0; ld = 512; c0 = (pn - 2) * 256; }
            else if (pn < 8) { base = V0; ld = 1024; c0 = (pn - 4) * 256; }
            else { base = R0; ld = 1024; c0 = (pn - 8) * 256; }
#pragma unroll
            for (int ai = 0; ai < 2; ++ai)
#pragma unroll
                for (int m = 0; m < 4; ++m) { bf16_t* rowp = base + (size_t)(row0 + ai * HALF + m * 16) * ld + c0 + cw;
#pragma unroll
                    for (int bj = 0; bj < 2; ++bj) *(u32x4*)(rowp + bj * HALF) = pack8(acc[ai][bj][m][0] * sc, acc[ai][bj][m][1] * sc); }
        } else if (wc == 0) {
#pragma unroll
            for (int ai = 0; ai < 2; ++ai)
#pragma unroll
                for (int m = 0; m < 4; ++m) { float* p = LR + (size_t)(row0 + ai * HALF + m * 16) * 32 + 8 * fq;
                    *(f32x4*)p = acc[ai][0][m][0]; *(f32x4*)(p + 4) = acc[ai][0][m][1]; }
        }
    }
};
struct EpiResF32 {
    static constexpr bool PERM = false, AFTER_DRAIN = false;
    const float* base; float* out; const float* bias;
    __device__ __forceinline__ void operator()(const f32x4 (&acc)[2][2][4][2], const Unit& u, int wr, int wc, int fr, int fq) const {
        const int row0 = u.pm * BM + wr * 64 + fr; const int col0 = u.pn * BM + wc * 32 + 4 * fq;
#pragma unroll
        for (int bj = 0; bj < 2; ++bj)
#pragma unroll
            for (int n = 0; n < 2; ++n) { const int c = col0 + bj * HALF + n * 16; const f32x4 bv = bias ? *(const f32x4*)(bias + c) : (f32x4){0.f, 0.f, 0.f, 0.f};
#pragma unroll
                for (int ai = 0; ai < 2; ++ai)
#pragma unroll
                    for (int m = 0; m < 4; ++m) { const size_t off = (size_t)(row0 + ai * HALF + m * 16) * 1024 + c;
                        const f32x4 o = *(const f32x4*)(base + off) + acc[ai][bj][m][n] + bv; *(f32x4*)(out + off) = o; } }
    }
};
__device__ __forceinline__ float silu_f(float g) { return g * __builtin_amdgcn_rcpf(1.0f + __builtin_amdgcn_exp2f(-1.4426950408889634f * g)); }
struct EpiSwiglu {
    static constexpr bool PERM = true, AFTER_DRAIN = false;
    bf16_t* O; int ldo; int ntn;
    __device__ __forceinline__ void operator()(const f32x4 (&acc)[2][2][4][2], const Unit& u, int wr, int wc, int fr, int fq) const {
        const int row0 = u.pm * BM + wr * 64 + fr; const int col0 = (u.pn % ntn) * HALF + wc * 32 + 8 * fq;
#pragma unroll
        for (int ai = 0; ai < 2; ++ai)
#pragma unroll
            for (int m = 0; m < 4; ++m) { f32x4 v0, v1;
#pragma unroll
                for (int j = 0; j < 4; ++j) { v0[j] = silu_f(acc[ai][0][m][0][j]) * acc[ai][1][m][0][j]; v1[j] = silu_f(acc[ai][0][m][1][j]) * acc[ai][1][m][1][j]; }
                *(u32x4*)(O + (size_t)(row0 + ai * HALF + m * 16) * ldo + col0) = pack8(v0, v1); }
    }
};
struct EpiMoeDown {
    static constexpr bool PERM = true, AFTER_DRAIN = false;
    bf16_t* Y; const float* roww; int row_base;
    __device__ __forceinline__ void operator()(const f32x4 (&acc)[2][2][4][2], const Unit& u, int wr, int wc, int fr, int fq) const {
        const int row0 = row_base + u.pm * BM + wr * 64 + fr; const int col0 = (u.pn & 3) * BM + wc * 32 + 8 * fq;
#pragma unroll
        for (int ai = 0; ai < 2; ++ai)
#pragma unroll
            for (int m = 0; m < 4; ++m) { const int row = row0 + ai * HALF + m * 16; const float w = roww[row]; bf16_t* rowp = Y + (size_t)row * 1024 + col0;
#pragma unroll
                for (int bj = 0; bj < 2; ++bj) *(u32x4*)(rowp + bj * HALF) = pack8(acc[ai][bj][m][0] * w, acc[ai][bj][m][1] * w); }
    }
};
struct EpiQkv {
    static constexpr bool PERM = true, AFTER_DRAIN = false;
    bf16_t *Q1, *K1, *V1; const float* bias;
    __device__ __forceinline__ void operator()(const f32x4 (&acc)[2][2][4][2], const Unit& u, int wr, int wc, int fr, int fq) const {
        const int pn = u.pn; const int row0 = u.pm * BM + wr * 64 + fr; const int cw = wc * 32 + 8 * fq;
        bf16_t* base; int ld, c0; float sc = 1.f;
        if (pn < 4) { base = Q1; ld = 1024; c0 = pn * 256; sc = 0.125f * 1.4426950408889634f; }
        else if (pn == 4) { base = K1; ld = 256; c0 = 0; }
        else { base = V1; ld = 256; c0 = 0; }
        f32x4 bv[2][2];
#pragma unroll
        for (int bj = 0; bj < 2; ++bj)
#pragma unroll
            for (int n = 0; n < 2; ++n) bv[bj][n] = *(const f32x4*)(bias + pn * 256 + bj * HALF + cw + 4 * n);
#pragma unroll
        for (int ai = 0; ai < 2; ++ai)
#pragma unroll
            for (int m = 0; m < 4; ++m) { bf16_t* rowp = base + (size_t)(row0 + ai * HALF + m * 16) * ld + c0 + cw;
#pragma unroll
                for (int bj = 0; bj < 2; ++bj) *(u32x4*)(rowp + bj * HALF) = pack8((acc[ai][bj][m][0] + bv[bj][0]) * sc, (acc[ai][bj][m][1] + bv[bj][1]) * sc); }
    }
};
struct MoeOrder {
    int t_lo, nM, nN, nwg, G, c; int ts[9];
    __device__ __forceinline__ void init(const int* meta, int half, int nN_, int G_, int c_) {
#pragma unroll
        for (int e = 0; e < 9; ++e) ts[e] = meta[e];
        const int T = ts[8], mid = (T + 1) >> 1; t_lo = half ? mid : 0; const int t_hi = half ? T : mid; nM = t_hi - t_lo; nN = nN_; nwg = nM * nN; G = G_; c = c_;
    }
    __device__ __forceinline__ bool next(int i, Unit& u) const {
        const long L = (long)i * G + c; if (L >= nwg) return false;
        int wgid = (int)L; { const int q = nwg / NXCD, r = nwg % NXCD, xcd = wgid % NXCD, off = wgid / NXCD; wgid = (xcd < r ? xcd * (q + 1) : r * (q + 1) + (xcd - r) * q) + off; }
        const int nig = WGM * nN, gid = wgid / nig, fm = gid * WGM, gsz = (nM - fm) < WGM ? (nM - fm) : WGM;
        const int pm = fm + ((wgid % nig) % gsz), pn = (wgid % nig) / gsz; const int pa = t_lo + pm;
        int e = 0;
#pragma unroll
        for (int k = 1; k < 8; ++k) e += (pa >= ts[k]) ? 1 : 0;
        u.pm = pm; u.pn = e * nN + pn; return true;
    }
    __device__ __forceinline__ void a_ready(const Unit&) const {}
    __device__ __forceinline__ void done(const Unit&) const {}
};
template <class Epi, class Sched, bool ALIGN_EPI = false, bool SP2 = false>
__device__ __forceinline__ void gemm_phase(PG8_LAS unsigned char* lds, const Gemm g, const Sched& S, const Epi& E) {
    const int tid = threadIdx.x, wid = __builtin_amdgcn_readfirstlane(tid >> 6), lane = tid & 63, wr = wid >> 2, wc = wid & 3, fr = lane & 15, fq = lane >> 4;
    const int K = g.K, nt = K / BK;
    unsigned voffA[2], voffB[2];
#pragma unroll
    for (int i = 0; i < 2; ++i) { int R, C; stage_rc(tid * 16 + i * 8192, R, C); const int Rb = Epi::PERM ? ((R & ~31) + perm32(R & 31)) : R;
        voffA[i] = (unsigned)(R * K + C) * 2u; voffB[i] = (unsigned)(Rb * K + C) * 2u; }
    const size_t kstep = (size_t)(BK * 2);
    const size_t hstep = (size_t)HALF * K * 2;
    const size_t tstep = 2 * hstep;
    const unsigned ldsw = (unsigned)wid * 1024u;
    const int aoff = lds_byte(wr * 64 + fr, fq * 8), boff = lds_byte(wc * 32 + fr, fq * 8);
#define PG8_SA(b, h) (((b) * 2 + (h)) * HTB)
#define PG8_SB(b, h) ((4 + (b) * 2 + (h)) * HTB)
#define PG8_STAGE(bufoff, gbase, voff) do { _Pragma("unroll") for (int _i = 0; _i < 2; ++_i) \
        __builtin_amdgcn_global_load_lds((const unsigned*)((const char*)(gbase) + (voff)[_i]), (PG8_LAS unsigned*)(lds + (bufoff) + ldsw + _i * 8192), 16, 0, 0); } while (0)
#define PG8_LDA(dst, b, h) do { _Pragma("unroll") for (int m = 0; m < 4; ++m) _Pragma("unroll") for (int k = 0; k < 2; ++k) dst[m][k] = *(const PG8_LAS bf16x8*)(lds + PG8_SA(b, h) + aoff + m * 2048 + k * 1024); } while (0)
#define PG8_LDB(dst, b, h) do { _Pragma("unroll") for (int n = 0; n < 2; ++n) _Pragma("unroll") for (int k = 0; k < 2; ++k) dst[n][k] = *(const PG8_LAS bf16x8*)(lds + PG8_SB(b, h) + boff + n * 2048 + k * 1024); } while (0)
#define PG8_MMA(ai, bj, At, Bt) do { __builtin_amdgcn_s_setprio(1); _Pragma("unroll") for (int m = 0; m < 4; ++m) _Pragma("unroll") for (int n = 0; n < 2; ++n) _Pragma("unroll") for (int k = 0; k < 2; ++k) \
        acc[ai][bj][m][n] = __builtin_amdgcn_mfma_f32_16x16x32_bf16(Bt[n][k], At[m][k], acc[ai][bj][m][n], 0, 0, 0); __builtin_amdgcn_s_setprio(0); } while (0)
#define PG8_WAIT_V(n) asm volatile("s_waitcnt vmcnt(" #n ")" ::: "memory")
#define PG8_WAIT_L(n) asm volatile("s_waitcnt lgkmcnt(" #n ")" ::: "memory")
#define PG8_BAR __builtin_amdgcn_s_barrier()
#define PG8_SCHED __builtin_amdgcn_sched_barrier(0)
    Unit cur, nxt; int ui = 0;
    if (!S.next(0, cur)) return;
    f32x4 acc[2][2][4][2];
#pragma unroll
    for (int a = 0; a < 2; ++a)
#pragma unroll
        for (int b = 0; b < 2; ++b)
#pragma unroll
            for (int m = 0; m < 4; ++m)
#pragma unroll
                for (int n = 0; n < 2; ++n) acc[a][b][m][n] = (f32x4){0.f, 0.f, 0.f, 0.f};
    bf16x8 At[4][2], B0[2][2], B1[2][2];
    const char* cA = (const char*)g.A + (size_t)cur.pm * tstep; const char* cB = (const char*)g.Bt + (size_t)cur.pn * tstep;
    S.a_ready(cur);
    if constexpr (SP2) {
        PG8_STAGE(PG8_SB(0, 0), cB, voffB); PG8_STAGE(PG8_SB(0, 1), cB + hstep, voffB); PG8_STAGE(PG8_SA(0, 0), cA, voffA); PG8_STAGE(PG8_SA(0, 1), cA + hstep, voffA);
        if (wr == 1) PG8_BAR;
        PG8_WAIT_V(2); PG8_BAR;
        PG8_STAGE(PG8_SB(1, 0), cB + kstep, voffB); PG8_STAGE(PG8_SA(1, 0), cA + kstep, voffA); PG8_STAGE(PG8_SB(1, 1), cB + hstep + kstep, voffB);
        PG8_WAIT_V(6); PG8_BAR;
    } else {
        PG8_STAGE(PG8_SB(0, 0), cB, voffB); PG8_STAGE(PG8_SA(0, 0), cA, voffA); PG8_STAGE(PG8_SB(0, 1), cB + hstep, voffB); PG8_STAGE(PG8_SA(0, 1), cA + hstep, voffA);
        if (wr == 1) PG8_BAR;
        PG8_WAIT_V(4); PG8_BAR;
        PG8_STAGE(PG8_SB(1, 0), cB + kstep, voffB); PG8_STAGE(PG8_SA(1, 0), cA + kstep, voffA); PG8_STAGE(PG8_SB(1, 1), cB + hstep + kstep, voffB);
        PG8_WAIT_V(6); PG8_BAR;
    }
    for (;;) {
        const bool has_next = S.next(ui + 1, nxt);
        const char* nA = has_next ? (const char*)g.A + (size_t)nxt.pm * tstep : cA; const char* nB = has_next ? (const char*)g.Bt + (size_t)nxt.pn * tstep : cB;
        for (int t = 0; t < nt; t += 2) {
            const bool last = (t == nt - 2);
            const char* a1 = cA + (size_t)(t + 1) * kstep;
            const char* a2 = last ? nA : cA + (size_t)(t + 2) * kstep; const char* b2 = last ? nB : cB + (size_t)(t + 2) * kstep;
            const char* a3 = a2 + kstep; const char* b3 = b2 + kstep;
            if (last && has_next) S.a_ready(nxt);
            if constexpr (SP2) {
            PG8_LDB(B0, 0, 0); PG8_LDB(B1, 0, 1); PG8_SCHED; PG8_LDA(At, 0, 0); PG8_STAGE(PG8_SA(1, 1), a1 + hstep, voffA);
            PG8_WAIT_V(8); PG8_WAIT_L(0); PG8_BAR; PG8_MMA(0, 0, At, B0); PG8_MMA(0, 1, At, B1); PG8_BAR; PG8_SCHED;
            PG8_LDA(At, 0, 1); PG8_STAGE(PG8_SB(0, 0), b2, voffB); PG8_STAGE(PG8_SB(0, 1), b2 + hstep, voffB); PG8_STAGE(PG8_SA(0, 0), a2, voffA);
            PG8_WAIT_V(8); PG8_WAIT_L(0); PG8_BAR; PG8_MMA(1, 0, At, B0); PG8_MMA(1, 1, At, B1); PG8_BAR; PG8_SCHED;
            PG8_LDB(B0, 1, 0); PG8_LDB(B1, 1, 1); PG8_SCHED; PG8_LDA(At, 1, 0); PG8_STAGE(PG8_SA(0, 1), a2 + hstep, voffA);
            PG8_WAIT_V(8); PG8_WAIT_L(0); PG8_BAR; PG8_MMA(0, 0, At, B0); PG8_MMA(0, 1, At, B1); PG8_BAR; PG8_SCHED;
            PG8_LDA(At, 1, 1); PG8_STAGE(PG8_SB(1, 0), b3, voffB); PG8_STAGE(PG8_SB(1, 1), b3 + hstep, voffB); PG8_STAGE(PG8_SA(1, 0), a3, voffA);
            PG8_WAIT_V(8); PG8_WAIT_L(0); PG8_BAR; PG8_MMA(1, 0, At, B0); PG8_MMA(1, 1, At, B1); PG8_BAR; PG8_SCHED;
            } else {
            PG8_LDB(B0, 0, 0); PG8_SCHED; PG8_LDA(At, 0, 0); PG8_STAGE(PG8_SA(1, 1), a1 + hstep, voffA);
            PG8_WAIT_L(8); PG8_BAR; PG8_WAIT_L(0); PG8_MMA(0, 0, At, B0); PG8_BAR; PG8_SCHED;
            PG8_LDB(B1, 0, 1); PG8_STAGE(PG8_SB(0, 0), b2, voffB);
            PG8_BAR; PG8_WAIT_L(0); PG8_MMA(0, 1, At, B1); PG8_BAR;
            PG8_LDA(At, 0, 1); PG8_STAGE(PG8_SA(0, 0), a2, voffA);
            PG8_BAR; PG8_WAIT_L(0); PG8_MMA(1, 0, At, B0); PG8_BAR; PG8_SCHED;
            PG8_STAGE(PG8_SB(0, 1), b2 + hstep, voffB);
            PG8_WAIT_V(6); PG8_BAR; PG8_MMA(1, 1, At, B1); PG8_BAR;
            PG8_LDB(B0, 1, 0); PG8_SCHED; PG8_LDA(At, 1, 0); PG8_STAGE(PG8_SA(0, 1), a2 + hstep, voffA);
            PG8_WAIT_L(8); PG8_BAR; PG8_WAIT_L(0); PG8_MMA(0, 0, At, B0); PG8_BAR; PG8_SCHED;
            PG8_LDB(B1, 1, 1); PG8_STAGE(PG8_SB(1, 0), b3, voffB);
            PG8_BAR; PG8_WAIT_L(0); PG8_MMA(0, 1, At, B1); PG8_BAR;
            PG8_LDA(At, 1, 1); PG8_STAGE(PG8_SA(1, 0), a3, voffA);
            PG8_BAR; PG8_WAIT_L(0); PG8_MMA(1, 0, At, B0); PG8_BAR; PG8_SCHED;
            PG8_STAGE(PG8_SB(1, 1), b3 + hstep, voffB);
            PG8_WAIT_V(6); PG8_BAR; PG8_MMA(1, 1, At, B1); PG8_BAR;
            }
        }
        if constexpr (ALIGN_EPI) { if (wr == 0) PG8_BAR; }
        if constexpr (!Epi::AFTER_DRAIN) { E(acc, cur, wr, wc, fr, fq); S.done(cur); }
        if (!has_next) break;
#pragma unroll
        for (int a = 0; a < 2; ++a)
#pragma unroll
            for (int b = 0; b < 2; ++b)
#pragma unroll
                for (int m = 0; m < 4; ++m)
#pragma unroll
                    for (int n = 0; n < 2; ++n) acc[a][b][m][n] = (f32x4){0.f, 0.f, 0.f, 0.f};
        cur = nxt; cA = nA; cB = nB; ++ui;
        if constexpr (ALIGN_EPI) { if (wr == 1) PG8_BAR; }
    }
    PG8_WAIT_V(0);
    if constexpr (!ALIGN_EPI) { if (wr == 0) PG8_BAR; }
    PG8_BAR;
    if constexpr (Epi::AFTER_DRAIN) { E.fused(acc, cur, wr, wc, fr, fq, lds, wid, lane); S.done(cur); }
#undef PG8_SA
#undef PG8_SB
#undef PG8_STAGE
#undef PG8_LDA
#undef PG8_LDB
#undef PG8_MMA
#undef PG8_WAIT_V
#undef PG8_WAIT_L
#undef PG8_BAR
#undef PG8_SCHED
}
}

constexpr int NWAVES = 8;
constexpr int NTOK = 65536, SEQ = 8192, DM = 1024, DFF = 2816;
constexpr float NORM_EPS = 1e-5f;
constexpr float LOG2E = 1.4426950408889634f;
#ifndef MK_ONE_LAUNCH
#define MK_ONE_LAUNCH 0
#endif
constexpr int NPHASE = 20;

constexpr size_t MiB = 1u << 20;
constexpr size_t WS_CTL = 0, CTL_ZERO_BYTES = 1 * MiB;
constexpr size_t WS_W_GLAIN = 1 * MiB, WS_W_GLAOUT = 8 * MiB, WS_W_QKV = 10 * MiB, WS_W_SWAOUT = 13 * MiB, WS_W_DGU = 15 * MiB, WS_W_DDN = 26 * MiB, WS_W_MGU = 32 * MiB, WS_W_MDN = 120 * MiB;
constexpr size_t WS_XN = 164 * MiB;
constexpr size_t WS_Q0 = 292 * MiB, WS_K0 = 356 * MiB, WS_V0 = 420 * MiB, WS_R0 = 548 * MiB, WS_LR = 676 * MiB;
constexpr size_t WS_QE = 684 * MiB;
constexpr size_t WS_CC = 940 * MiB;
constexpr size_t WS_OF = WS_XN, WS_OB = WS_Q0, WS_G = WS_V0;
constexpr size_t WS_ACT0 = 292 * MiB;
constexpr size_t WS_Q1 = 292 * MiB, WS_K1 = 420 * MiB, WS_V1 = 452 * MiB, WS_O1 = 484 * MiB;
constexpr size_t WS_XS = 292 * MiB;
constexpr size_t WS_ACT1 = 552 * MiB;
constexpr size_t WS_ROUT = 952 * MiB;
constexpr size_t WS_SEL = WS_ROUT, WS_WSEL = WS_ROUT + 1 * MiB, WS_POSTOK = WS_ROUT + 2 * MiB, WS_ROWW = WS_ROUT + 3 * MiB, WS_WCNT = WS_ROUT + 4 * MiB, WS_META = WS_ROUT + 5 * MiB;
constexpr size_t WS_END = 1024 * MiB;
static_assert(WS_W_MDN + (size_t)8 * 1024 * 2816 * 2 <= WS_XN && WS_CC + (size_t)2 * 8 * 128 * 1536 * 4 <= WS_ROUT && WS_ACT0 + (size_t)NTOK * DFF * 2 <= WS_QE + 4 * 64 * MiB, "ws map");
static_assert(WS_ACT1 + (size_t)261 * 256 * DFF * 2 <= WS_ROUT && WS_XS + (size_t)133120 * 1024 * 2 <= WS_ACT1, "ws map 2");
constexpr int CW_TMO = 0, CW_BAR = 4096;

constexpr int RING_OFF = 0, RING_BYTES = 131072;
constexpr int LDSCTL_OFF = RING_BYTES, MISC_OFF = LDSCTL_OFF + 320;
constexpr int LDS_BYTES = 147456;

#define GAS __attribute__((address_space(1)))
#define LAS __attribute__((address_space(3)))
typedef unsigned short bf16;
typedef unsigned v4u __attribute__((ext_vector_type(4)));
typedef float f32x4 __attribute__((ext_vector_type(4)));
typedef short bf16x8 __attribute__((ext_vector_type(8)));
typedef GAS unsigned gu32;
typedef GAS unsigned long long gu64;
#define RLX_AGENT __ATOMIC_RELAXED, __HIP_MEMORY_SCOPE_AGENT
#define LDS_WAIT() asm volatile("s_waitcnt lgkmcnt(0)" ::: "memory")
#define VM_WAIT() asm volatile("s_waitcnt vmcnt(0)" ::: "memory")
__device__ __forceinline__ unsigned long long rt() { return __builtin_amdgcn_s_memrealtime(); }
__device__ __forceinline__ unsigned f2bf(float f) { unsigned u = __builtin_bit_cast(unsigned, f); return (u + 0x7fffu + ((u >> 16) & 1u)) >> 16; }
__device__ __forceinline__ unsigned pk2(float lo, float hi) { return f2bf(lo) | (f2bf(hi) << 16); }

#define XB_TMO      128
#define XB_XCNT(j)  (256  + 64 * (j))
#define XB_XSUB(j)  (1280 + 64 * (j))
#define XB_XGEN(j)  (2304 + 64 * (j))
#define XB_TOP      3328
#define XB_TOPGEN   3392
#define XCD_BAR_WORDS 3456
#define XB_SPIN_CAP (1u << 18)

__device__ __forceinline__ unsigned xb_ld(unsigned* p)              { return __hip_atomic_load(p, __ATOMIC_RELAXED, __HIP_MEMORY_SCOPE_AGENT); }
__device__ __forceinline__ unsigned xb_add(unsigned* p, unsigned v) { return __hip_atomic_fetch_add(p, v, __ATOMIC_RELAXED, __HIP_MEMORY_SCOPE_AGENT); }
__device__ __forceinline__ unsigned xb_xcc_id() { return (unsigned)__builtin_amdgcn_s_getreg((3 << 11) | 20) & 0xFu; }
#define XB_SPIN(cond, bar) do { unsigned _sp = 0; while (cond) { __builtin_amdgcn_s_sleep(1); \
    if ((++_sp & 255u) == 0u) { if (xb_ld(&(bar)[XB_TMO])) break; if (_sp > XB_SPIN_CAP) { atomicAdd(&(bar)[XB_TMO], 1u); break; } } } } while (0)

struct XcdBarrier {
    unsigned* bar; unsigned x;
    volatile LAS unsigned* st;
};

__device__ __forceinline__ XcdBarrier xcd_barrier_post(unsigned* bar, volatile LAS unsigned* st) {
    XcdBarrier b; b.bar = bar; b.x = xb_xcc_id(); b.st = st;
    if (threadIdx.x == 0) (void)xb_add(&bar[XB_XCNT(b.x)], 1u);
    return b;
}
__device__ __forceinline__ void xcd_barrier_complete(unsigned* bar, unsigned x, unsigned& nloc, unsigned& nx) {
    const unsigned G = gridDim.x * gridDim.y * gridDim.z;
    unsigned sum, cnt, mine, sp = 0u;
    for (;;) {
        sum = 0u; cnt = 0u; mine = 0u;
#pragma unroll
        for (unsigned j = 0; j < 16; ++j) { const unsigned c = xb_ld(&bar[XB_XCNT(j)]); sum += c; cnt += (c > 0u) ? 1u : 0u; mine = (j == x) ? c : mine; }
        if (sum == G) break;
        __builtin_amdgcn_s_sleep(1);
        if ((++sp & 255u) == 0u) { if (xb_ld(&bar[XB_TMO])) break; if (sp > XB_SPIN_CAP) { atomicAdd(&bar[XB_TMO], 1u); break; } }
    }
    nloc = mine > 0u ? mine : 1u; nx = cnt > 0u ? cnt : 1u;
}

__device__ __forceinline__ void xcd_barrier(const XcdBarrier& b) {
    asm volatile("s_waitcnt vmcnt(0)" ::: "memory");
    __syncthreads();
    if (threadIdx.x == 0) {
        unsigned* bar = b.bar;
        __builtin_amdgcn_s_waitcnt(0);
        unsigned nloc = b.st[0], nx = b.st[1];
        if (nloc == 0u) { xcd_barrier_complete(bar, b.x, nloc, nx); b.st[0] = nloc; b.st[1] = nx; }
        const unsigned old = xb_add(&bar[XB_XSUB(b.x)], 1u);
        const unsigned gen = old / nloc;
        if (old + 1u == (gen + 1u) * nloc) {
            __builtin_amdgcn_fence(__ATOMIC_RELEASE, "agent");
            asm volatile("s_waitcnt vmcnt(0)" ::: "memory");
            const unsigned og = xb_add(&bar[XB_TOP], 1u);
            const unsigned tg = og / nx;
            if (og + 1u == (tg + 1u) * nx) xb_add(&bar[XB_TOPGEN], 1u);
            else XB_SPIN(xb_ld(&bar[XB_TOPGEN]) == tg, bar);
            __builtin_amdgcn_fence(__ATOMIC_ACQUIRE, "agent");
            xb_add(&bar[XB_XGEN(b.x)], 1u);
            asm volatile("s_waitcnt vmcnt(0)" ::: "memory");
        } else {
            XB_SPIN(xb_ld(&bar[XB_XGEN(b.x)]) == gen, bar);
            __builtin_amdgcn_fence(__ATOMIC_ACQUIRE, "agent");
            asm volatile("s_waitcnt vmcnt(0)" ::: "memory");
        }
    }
    __syncthreads();
}
typedef unsigned u32x4 __attribute__((ext_vector_type(4)));

typedef unsigned u32x2 __attribute__((ext_vector_type(2)));
typedef short s16x4 __attribute__((ext_vector_type(4)));
struct Frame {
    LAS unsigned char* lds;
    volatile LAS unsigned* MISC;
    gu32* ctl;
    int tid, lane, wave;
    int vcu, G;
    float* out; unsigned char* ws;
    const float *x, *mix_norm, *ffn_norm, *gla_in, *wgf, *bgf, *wgb, *bgb, *head_norm, *gla_out, *swa_qkv, *qkv_bias, *sinks, *swa_out, *swa_out_bias,
                *d_gate, *d_up, *d_down, *router, *m_gate, *m_up, *m_down, *final_norm;
};
__device__ __forceinline__ float bf_lo(unsigned u) { return __uint_as_float(u << 16); }
__device__ __forceinline__ float bf_hi(unsigned u) { return __uint_as_float(u & 0xffff0000u); }
typedef float f32x2_t __attribute__((ext_vector_type(2))); typedef __bf16 bf16x2_t __attribute__((ext_vector_type(2)));
__device__ __forceinline__ unsigned cvtpk(float lo, float hi) { f32x2_t v = {lo, hi}; bf16x2_t b = __builtin_convertvector(v, bf16x2_t); return __builtin_bit_cast(unsigned, b); }
__device__ __forceinline__ float wave_sum(float v) {
#pragma unroll
    for (int o = 1; o < 64; o <<= 1) v += __shfl_xor(v, o);
    return v;
}
__device__ __forceinline__ int wave_sum_i(int v) {
#pragma unroll
    for (int o = 1; o < 64; o <<= 1) v += __shfl_xor(v, o);
    return v;
}
#define LBAR() do { asm volatile("s_waitcnt lgkmcnt(0)" ::: "memory"); __builtin_amdgcn_s_barrier(); asm volatile("" ::: "memory"); } while (0)
__device__ __forceinline__ f32x4 mfma16(bf16x8 a, bf16x8 b, f32x4 c) { return __builtin_amdgcn_mfma_f32_16x16x32_bf16(a, b, c, 0, 0, 0); }
typedef short v4i16_t __attribute__((ext_vector_type(4)));
__device__ __forceinline__ s16x4 ldtr(const LAS unsigned char* p) { return __builtin_bit_cast(s16x4, __builtin_amdgcn_ds_read_tr16_b64_v4i16((LAS v4i16_t*)p)); }
__device__ __forceinline__ bf16x8 cat8(s16x4 lo, s16x4 hi) { return (bf16x8){lo[0], lo[1], lo[2], lo[3], hi[0], hi[1], hi[2], hi[3]}; }

__device__ __forceinline__ void conv_item(const float* W, int K, int N, bf16* WT, int drow0, int k0, int n0, LAS float* scr, int lane) {
#pragma unroll 8
    for (int i = 0; i < 32; ++i) { const int kk = 2 * i + (lane >> 5); scr[kk * 33 + (lane & 31)] = W[(size_t)(k0 + kk) * N + n0 + (lane & 31)]; }
    LDS_WAIT(); asm volatile("" ::: "memory");
    const int c = lane & 7;
#pragma unroll
    for (int j = 0; j < 4; ++j) { const int n = (lane >> 3) + 8 * j; const LAS float* s = scr + (8 * c) * 33 + n;
        v4u o; o.x = pk2(s[0 * 33], s[1 * 33]); o.y = pk2(s[2 * 33], s[3 * 33]); o.z = pk2(s[4 * 33], s[5 * 33]); o.w = pk2(s[6 * 33], s[7 * 33]);
        *(GAS v4u*)(WT + (size_t)(drow0 + n) * K + k0 + 8 * c) = o; }
    LDS_WAIT(); asm volatile("" ::: "memory");
}
constexpr int IT_GLAIN = 16 * 97, IT_SQ = 16 * 32, IT_QKV = 16 * 48, IT_FF = 1408;
constexpr int NITEMS = IT_GLAIN + 2 * IT_SQ + IT_QKV + 27 * IT_FF;
__device__ __forceinline__ void p0_weights(Frame& F, const float* gla_in, const float* gla_out, const float* swa_qkv, const float* swa_out, const float* d_gate, const float* d_up, const float* d_down, const float* m_gate, const float* m_up, const float* m_down) {
    LAS float* scr = (LAS float*)(F.lds + RING_OFF + F.wave * 16384);
    const int gw = F.vcu * NWAVES + F.wave, NGW = F.G * NWAVES;
    for (int it = gw; it < NITEMS; it += NGW) {
        int r = it; const float* W; int K = 1024, N; bf16* WT; int mode = 0;
        if (r < IT_GLAIN) { W = gla_in; N = 3104; WT = (bf16*)(F.ws + WS_W_GLAIN); }
        else if ((r -= IT_GLAIN) < IT_SQ) { W = gla_out; N = 1024; WT = (bf16*)(F.ws + WS_W_GLAOUT); }
        else if ((r -= IT_SQ) < IT_QKV) { W = swa_qkv; N = 1536; WT = (bf16*)(F.ws + WS_W_QKV); }
        else if ((r -= IT_QKV) < IT_SQ) { W = swa_out; N = 1024; WT = (bf16*)(F.ws + WS_W_SWAOUT); }
        else { r -= IT_SQ; const int j = r / IT_FF; r -= j * IT_FF;
            int kind, e; if (j < 3) { kind = j; e = 0; } else { kind = (j - 3) >> 3; e = (j - 3) & 7; }
            const bool moe = j >= 3;
            if (kind == 2) { W = (moe ? m_down : d_down) + (size_t)e * DFF * 1024; K = DFF; N = 1024; WT = (bf16*)(F.ws + (moe ? WS_W_MDN : WS_W_DDN)) + (size_t)e * 1024 * DFF; }
            else { W = (kind == 0 ? (moe ? m_gate : d_gate) : (moe ? m_up : d_up)) + (size_t)e * 1024 * DFF; N = DFF; WT = (bf16*)(F.ws + (moe ? WS_W_MGU : WS_W_DGU)) + (size_t)e * 5632 * 1024; mode = 1 + kind; }
        }
        const int nblk = N >> 5, kb = r / nblk, nb = r - kb * nblk, n0 = nb * 32;
        const int drow0 = (mode == 0) ? n0 : (((n0 >> 7) << 8) + (n0 & 127) + (mode == 2 ? 128 : 0));
        conv_item(W, K, N, WT, drow0, kb * 64, n0, scr, F.lane);
    }
    { GAS v4u* z = (GAS v4u*)(F.ws + WS_W_GLAIN + (size_t)3104 * 2048); const int nth = F.G * NWAVES * 64;
      for (int i = F.vcu * NWAVES * 64 + F.tid; i < 224 * 128; i += nth) z[i] = (v4u){0u, 0u, 0u, 0u}; }
}
__device__ __forceinline__ void rmsnorm_rows(Frame& F, const float* src, const float* gain, bf16* dst) {
    const int gw = F.vcu * NWAVES + F.wave, NGW = F.G * NWAVES;
    f32x4 g[4];
#pragma unroll
    for (int j = 0; j < 4; ++j) g[j] = ((const f32x4*)gain)[F.lane + 64 * j];
    for (int m = gw; m < NTOK; m += NGW) {
        const GAS f32x4* xr = (const GAS f32x4*)(src + (size_t)m * DM) + F.lane;
        f32x4 v[4]; float s = 0.f;
#pragma unroll
        for (int j = 0; j < 4; ++j) { v[j] = xr[64 * j]; s += (v[j].x * v[j].x + v[j].y * v[j].y) + (v[j].z * v[j].z + v[j].w * v[j].w); }
        const float rs = 1.0f / sqrtf(wave_sum(s) * (1.f / DM) + NORM_EPS);
        GAS unsigned long long* o8 = (GAS unsigned long long*)(dst + (size_t)m * DM) + F.lane;
#pragma unroll
        for (int j = 0; j < 4; ++j) { const f32x4 o = v[j] * rs * g[j]; o8[64 * j] = (unsigned long long)cvtpk(o.x, o.y) | ((unsigned long long)cvtpk(o.z, o.w) << 32); }
    }
}

__device__ __forceinline__ float logsig16(float z) { const float e = __expf(-fabsf(z)); return (fminf(z, 0.f) - __logf(1.f + e)) * 0.0625f; }
__device__ __forceinline__ void gla_prep(Frame& F) {
    typedef float f32x2 __attribute__((ext_vector_type(2)));
    LAS float* lrs = (LAS float*)(F.lds + RING_OFF);
    LAS f32x2* xch0 = (LAS f32x2*)(F.lds + RING_OFF + 8192);
    LAS f32x4* xch1 = (LAS f32x4*)(F.lds + RING_OFF + 12288);
    const int tid = F.tid, ph = tid >> 8, cp = tid & 255, col = 2 * cp;
    const bf16* Q0 = (const bf16*)(F.ws + WS_Q0); const bf16* K0 = (const bf16*)(F.ws + WS_K0); const float* LR = (const float*)(F.ws + WS_LR);
    float* CC = (float*)(F.ws + WS_CC);
    for (int u = F.vcu; u < 2048; u += F.G) {
        const int b = u >> 8, n = (u >> 1) & 127, dir = u & 1; const size_t row0 = (size_t)b * SEQ + 64 * n;
        const float* wg = dir ? F.wgb : F.wgf; const float* bg = dir ? F.bgb : F.bgf;
        bf16* QEd = (bf16*)(F.ws + WS_QE) + (size_t)dir * 2 * NTOK * 512; bf16* KEd = QEd + (size_t)NTOK * 512;
        f32x2 wgv[16];
#pragma unroll
        for (int r = 0; r < 16; ++r) wgv[r] = *(const f32x2*)(wg + r * 512 + col);
        const f32x2 bgv = *(const f32x2*)(bg + col);
        __syncthreads();
        { const int r = tid >> 3, o = (tid & 7) * 4; *(LAS f32x4*)(lrs + r * 32 + o) = *(const f32x4*)(LR + (row0 + r) * 32 + o); }
        __syncthreads();
        float bc0[32], bc1[32]; float run0 = 0.f, run1 = 0.f;
#pragma unroll
        for (int i = 0; i < 32; ++i) { const int p = 32 * ph + i; const int tok = dir ? 63 - p : p; const LAS float* lp = lrs + tok * 32 + dir * 16;
            float z0 = bgv.x, z1 = bgv.y;
#pragma unroll
            for (int r4 = 0; r4 < 4; ++r4) { const f32x4 l4 = *(const LAS f32x4*)(lp + 4 * r4);
#pragma unroll
                for (int k = 0; k < 4; ++k) { z0 += l4[k] * wgv[4 * r4 + k].x; z1 += l4[k] * wgv[4 * r4 + k].y; } }
            run0 += logsig16(z0); run1 += logsig16(z1); bc0[i] = run0; bc1[i] = run1; }
        if (ph == 0) xch0[cp] = (f32x2){run0, run1};
        __syncthreads();
        if (ph == 1) { const f32x2 add = xch0[cp];
#pragma unroll
            for (int i = 0; i < 32; ++i) { bc0[i] += add.x; bc1[i] += add.y; }
            xch1[cp] = (f32x4){bc0[0], bc1[0], bc0[31], bc1[31]}; }
        __syncthreads();
        const f32x4 rl = xch1[cp]; const float br0 = rl[0], br1 = rl[1], bl0 = rl[2], bl1 = rl[3];
#pragma unroll
        for (int i = 0; i < 32; ++i) { const int p = 32 * ph + i; const int tok = dir ? 63 - p : p; const size_t off = (row0 + tok) * 512 + col;
            const unsigned q2 = *(const unsigned*)(Q0 + off), k2 = *(const unsigned*)(K0 + off);
            const float e0 = __expf(bc0[i] - br0), e1 = __expf(bc1[i] - br1), i0 = __expf(br0 - bc0[i]), i1 = __expf(br1 - bc1[i]);
            *(unsigned*)(QEd + off) = cvtpk(bf_lo(q2) * e0, bf_hi(q2) * e1);
            *(unsigned*)(KEd + off) = cvtpk(bf_lo(k2) * i0, bf_hi(k2) * i1); }
        if (ph == 0) { const int c = dir ? 127 - n : n; float* rec = CC + ((size_t)(dir * 8 + b) * 128 + c) * 1536;
            *(f32x2*)(rec + col) = (f32x2){__expf(bl0 - br0), __expf(bl1 - br1)};
            *(f32x2*)(rec + 512 + col) = (f32x2){__expf(bl0), __expf(bl1)};
            if (c >= 1) *(f32x2*)(rec - 1536 + 1024 + col) = (f32x2){__expf(br0), __expf(br1)}; }
    }
}

constexpr int GS_QE = 0, GS_KE = 17408, GS_V = 34816, GS_CC = 44032, GS_BUF = 45568, GS_SB = 2 * GS_BUF, GS_SBB = 17408;
static_assert(GS_SB + 2 * GS_SBB <= RING_BYTES, "gla scan LDS");
__device__ __forceinline__ void gla_scan(Frame& F) {
    const int tid = F.tid, lane = F.lane, w = F.wave, r16 = lane & 15, g4 = lane >> 4;
    LAS unsigned char* L = F.lds + RING_OFF;
    const bf16* V0 = (const bf16*)(F.ws + WS_V0);
    const int qrow = tid >> 4, qch = tid & 15, vrow = tid >> 3, vch = tid & 7;
    const int it = w >> 1, half = w & 1;
    for (int unit = F.vcu; unit < 256; unit += F.G) {
        const int combo = unit >> 2, dvq = unit & 3, dir = combo & 1, h = (combo >> 1) & 3, b = combo >> 3;
        const bf16* QEg = (const bf16*)(F.ws + WS_QE) + (size_t)dir * 2 * NTOK * 512; const bf16* KEg = QEg + (size_t)NTOK * 512;
        const float* CCg = (const float*)(F.ws + WS_CC) + (size_t)(dir * 8 + b) * 128 * 1536;
        bf16* Og = (bf16*)(F.ws + (dir ? WS_OB : WS_OF));
        v4u rq0, rq1, rk0, rk1, rv, rc = (v4u){0u, 0u, 0u, 0u};
#define GS_LOAD(c_) do { const int orig_ = dir ? 127 - (c_) : (c_); const size_t r0_ = (size_t)b * SEQ + 64 * orig_; \
        rq0 = *(const v4u*)(QEg + (r0_ + qrow) * 512 + h * 128 + qch * 8); rq1 = *(const v4u*)(QEg + (r0_ + qrow + 32) * 512 + h * 128 + qch * 8); \
        rk0 = *(const v4u*)(KEg + (r0_ + qrow) * 512 + h * 128 + qch * 8); rk1 = *(const v4u*)(KEg + (r0_ + qrow + 32) * 512 + h * 128 + qch * 8); \
        rv = *(const v4u*)(V0 + (r0_ + vrow) * 1024 + h * 256 + dvq * 64 + vch * 8); \
        if (tid < 96) rc = *(const v4u*)(CCg + (size_t)(c_) * 1536 + (tid >> 5) * 512 + h * 128 + (tid & 31) * 4); } while (0)
#define GS_STORE(buf_) do { LAS unsigned char* B_ = L + (buf_) * GS_BUF; \
        *(LAS v4u*)(B_ + GS_QE + qrow * 272 + qch * 16) = rq0; *(LAS v4u*)(B_ + GS_QE + (qrow + 32) * 272 + qch * 16) = rq1; \
        *(LAS v4u*)(B_ + GS_KE + qrow * 272 + qch * 16) = rk0; *(LAS v4u*)(B_ + GS_KE + (qrow + 32) * 272 + qch * 16) = rk1; \
        *(LAS v4u*)(B_ + GS_V + vrow * 144 + vch * 16) = rv; \
        if (tid < 96) *(LAS v4u*)(B_ + GS_CC + (tid >> 5) * 512 + (tid & 31) * 16) = rc; } while (0)
        LBAR();
        for (int i = tid; i < GS_SBB / 16; i += NWAVES * 64) *(LAS v4u*)(L + GS_SB + i * 16) = (v4u){0u, 0u, 0u, 0u};
        GS_LOAD(0); GS_STORE(0);
        f32x4 sacc[4];
#pragma unroll
        for (int d = 0; d < 4; ++d) sacc[d] = (f32x4){0.f, 0.f, 0.f, 0.f};
        LBAR();
        for (int c = 0; c < 128; ++c) {
            const int cur = c & 1; const LAS unsigned char* B = L + cur * GS_BUF; const LAS unsigned char* SBc = L + GS_SB + cur * GS_SBB; LAS unsigned char* SBn = L + GS_SB + (cur ^ 1) * GS_SBB;
            if (c + 1 < 128) GS_LOAD(c + 1);
            const int orig = dir ? 127 - c : c; const size_t row0 = (size_t)b * SEQ + 64 * orig;
            bf16x8 qf[4];
#pragma unroll
            for (int ks = 0; ks < 4; ++ks) qf[ks] = *(const LAS bf16x8*)(B + GS_QE + (16 * it + r16) * 272 + ks * 64 + g4 * 16);
            unsigned pb[4][2];
#pragma unroll
            for (int jt = 0; jt < 4; ++jt) { f32x4 pacc = (f32x4){0.f, 0.f, 0.f, 0.f};
#pragma unroll
                for (int ks = 0; ks < 4; ++ks) { const bf16x8 kf = *(const LAS bf16x8*)(B + GS_KE + (16 * jt + r16) * 272 + ks * 64 + g4 * 16); pacc = mfma16(kf, qf[ks], pacc); }
                const int i = 16 * it + r16, j0 = 16 * jt + 4 * g4;
#pragma unroll
                for (int r = 0; r < 4; ++r) { const int j = j0 + r; const bool keep = dir ? (j > i) : (j <= i); pacc[r] = keep ? pacc[r] : 0.f; }
                pb[jt][0] = cvtpk(pacc[0], pacc[1]); pb[jt][1] = cvtpk(pacc[2], pacc[3]); }
            bf16x8 vf[4][2];
#pragma unroll
            for (int dvt = 0; dvt < 4; ++dvt)
#pragma unroll
                for (int kk = 0; kk < 2; ++kk) { const LAS unsigned char* a = B + GS_V + (32 * kk + 4 * g4 + (r16 >> 2)) * 144 + (16 * dvt + 4 * (r16 & 3)) * 2; vf[dvt][kk] = cat8(ldtr(a), ldtr(a + 16 * 144)); }
#pragma unroll
            for (int d2 = 0; d2 < 2; ++d2) { const int dvt = 2 * half + d2; f32x4 o = (f32x4){0.f, 0.f, 0.f, 0.f};
#pragma unroll
                for (int ks = 0; ks < 4; ++ks) { const bf16x8 sf = *(const LAS bf16x8*)(SBc + (16 * dvt + r16) * 272 + ks * 64 + g4 * 16); o = mfma16(sf, qf[ks], o); }
#pragma unroll
                for (int kk = 0; kk < 2; ++kk) { bf16x8 va, vb2; va = vf[d2][kk]; vb2 = vf[2 + d2][kk]; bf16x8 vsel;
#pragma unroll
                    for (int e = 0; e < 8; ++e) vsel[e] = half ? vb2[e] : va[e];
                    const u32x4 pw = (u32x4){pb[2 * kk][0], pb[2 * kk][1], pb[2 * kk + 1][0], pb[2 * kk + 1][1]};
                    o = mfma16(vsel, __builtin_bit_cast(bf16x8, pw), o); }
                *(u32x2*)(Og + (row0 + 16 * it + r16) * 1024 + h * 256 + dvq * 64 + 16 * dvt + 4 * g4) = (u32x2){cvtpk(o[0], o[1]), cvtpk(o[2], o[3])}; }
            bf16x8 kt[2];
#pragma unroll
            for (int kk = 0; kk < 2; ++kk) { const LAS unsigned char* a = B + GS_KE + (32 * kk + 4 * g4 + (r16 >> 2)) * 272 + (16 * w + 4 * (r16 & 3)) * 2; kt[kk] = cat8(ldtr(a), ldtr(a + 16 * 272)); }
            const f32x4 c1v = *(const LAS f32x4*)(B + GS_CC + (16 * w + 4 * g4) * 4), decv = *(const LAS f32x4*)(B + GS_CC + 512 + (16 * w + 4 * g4) * 4), c2n = *(const LAS f32x4*)(B + GS_CC + 1024 + (16 * w + 4 * g4) * 4);
#pragma unroll
            for (int dvt = 0; dvt < 4; ++dvt) { f32x4 ua = (f32x4){0.f, 0.f, 0.f, 0.f};
#pragma unroll
                for (int kk = 0; kk < 2; ++kk) ua = mfma16(kt[kk], vf[dvt][kk], ua);
                sacc[dvt] = decv * sacc[dvt] + c1v * ua;
                const f32x4 sb = c2n * sacc[dvt];
                *(LAS u32x2*)(SBn + (16 * dvt + r16) * 272 + (16 * w + 4 * g4) * 2) = (u32x2){cvtpk(sb[0], sb[1]), cvtpk(sb[2], sb[3])}; }
            if (c + 1 < 128) GS_STORE(cur ^ 1);
            LBAR();
        }
#undef GS_LOAD
#undef GS_STORE
    }
}

__device__ __forceinline__ void gla_post(Frame& F) {
    const int gw = F.vcu * NWAVES + F.wave, NGW = F.G * NWAVES, lane = F.lane;
    const bf16* OFp = (const bf16*)(F.ws + WS_OF); const bf16* OBp = (const bf16*)(F.ws + WS_OB); const bf16* R0 = (const bf16*)(F.ws + WS_R0); bf16* Gp = (bf16*)(F.ws + WS_G);
    float gn[16];
#pragma unroll
    for (int j = 0; j < 4; ++j) { const f32x4 t = *(const f32x4*)(F.head_norm + 16 * lane + 4 * j); gn[4 * j] = t.x; gn[4 * j + 1] = t.y; gn[4 * j + 2] = t.z; gn[4 * j + 3] = t.w; }
    for (int m = gw; m < NTOK; m += NGW) {
        const size_t off = (size_t)m * 1024 + 16 * lane;
        const v4u a0 = *(const v4u*)(OFp + off), a1 = *(const v4u*)(OFp + off + 8), b0 = *(const v4u*)(OBp + off), b1 = *(const v4u*)(OBp + off + 8), r0 = *(const v4u*)(R0 + off), r1 = *(const v4u*)(R0 + off + 8);
        float o[16], rr[16]; float ss = 0.f;
#pragma unroll
        for (int j = 0; j < 4; ++j) { o[2 * j] = bf_lo(a0[j]) + bf_lo(b0[j]); o[2 * j + 1] = bf_hi(a0[j]) + bf_hi(b0[j]); o[8 + 2 * j] = bf_lo(a1[j]) + bf_lo(b1[j]); o[8 + 2 * j + 1] = bf_hi(a1[j]) + bf_hi(b1[j]);
            rr[2 * j] = bf_lo(r0[j]); rr[2 * j + 1] = bf_hi(r0[j]); rr[8 + 2 * j] = bf_lo(r1[j]); rr[8 + 2 * j + 1] = bf_hi(r1[j]); }
#pragma unroll
        for (int j = 0; j < 16; ++j) ss += o[j] * o[j];
        ss += __shfl_xor(ss, 1); ss += __shfl_xor(ss, 2); ss += __shfl_xor(ss, 4); ss += __shfl_xor(ss, 8);
        const float rs = 1.0f / sqrtf(ss * (1.f / 256.f) + NORM_EPS);
        float y[16];
#pragma unroll
        for (int j = 0; j < 16; ++j) y[j] = o[j] * rs * gn[j] * pg8::silu_f(rr[j]);
        v4u w0, w1;
#pragma unroll
        for (int j = 0; j < 4; ++j) { w0[j] = cvtpk(y[2 * j], y[2 * j + 1]); w1[j] = cvtpk(y[8 + 2 * j], y[8 + 2 * j + 1]); }
        *(v4u*)(Gp + off) = w0; *(v4u*)(Gp + off + 8) = w1;
    }
}

constexpr int AT_K = 0, AT_V = 55296, AT_STRIDE = 144;
static_assert(2 * 55296 <= RING_BYTES, "attention LDS");
__device__ __forceinline__ void swa_attn(Frame& F) {
    const int tid = F.tid, lane = F.lane, w = F.wave, r16 = lane & 15, g4 = lane >> 4;
    LAS unsigned char* L = F.lds + RING_OFF;
    const bf16* Q1 = (const bf16*)(F.ws + WS_Q1); const bf16* K1 = (const bf16*)(F.ws + WS_K1); const bf16* V1 = (const bf16*)(F.ws + WS_V1); bf16* O1 = (bf16*)(F.ws + WS_O1);
    for (int u = F.vcu; u < 2048; u += F.G) {
        const int b = u >> 8, g = (u >> 6) & 3, nb = u & 63;
        const int kbase = (nb - 1) * 128;
        LBAR();
#pragma unroll
        for (int i = 0; i < 6; ++i) { const int piece = tid + 512 * i, row = piece >> 3, ch = piece & 7, tok = kbase + row;
            if (tok >= 0 && tok < SEQ) { const size_t go = ((size_t)b * SEQ + tok) * 256 + g * 64 + ch * 8;
                const v4u kv = *(const v4u*)(K1 + go), vv = *(const v4u*)(V1 + go);
                *(LAS v4u*)(L + AT_K + row * AT_STRIDE + ch * 16) = kv; *(LAS v4u*)(L + AT_V + row * AT_STRIDE + ch * 16) = vv; } }
        const int hq = 4 * g + (w >> 1), q0 = nb * 128 + 64 * (w & 1);
        bf16x8 qf[4][2];
#pragma unroll
        for (int qt = 0; qt < 4; ++qt)
#pragma unroll
            for (int ks = 0; ks < 2; ++ks) qf[qt][ks] = *(const bf16x8*)(Q1 + ((size_t)b * SEQ + q0 + 16 * qt + r16) * 1024 + hq * 64 + 32 * ks + 8 * g4);
        const float slope = exp2f(-0.5f * (float)(hq + 1)) * LOG2E, sink2 = F.sinks[hq] * LOG2E;
        float mrun[4], lrun[4]; f32x4 oacc[4][4];
#pragma unroll
        for (int qt = 0; qt < 4; ++qt) { mrun[qt] = sink2; lrun[qt] = (g4 == 0) ? 1.f : 0.f;
#pragma unroll
            for (int dt = 0; dt < 4; ++dt) oacc[qt][dt] = (f32x4){0.f, 0.f, 0.f, 0.f}; }
        LBAR();
        const int s_lo = 64 * (w & 1);
        for (int t = 0; t < 10; ++t) {
            const int s0 = s_lo + 32 * t, ktok0 = kbase + s0;
            if (ktok0 < 0 || ktok0 >= SEQ) continue;
            bf16x8 kf[2][2];
#pragma unroll
            for (int sub = 0; sub < 2; ++sub)
#pragma unroll
                for (int ks = 0; ks < 2; ++ks) kf[sub][ks] = *(const LAS bf16x8*)(L + AT_K + (s0 + 16 * sub + r16) * AT_STRIDE + ks * 64 + g4 * 16);
            bf16x8 vf[4];
#pragma unroll
            for (int dt = 0; dt < 4; ++dt) { const LAS unsigned char* a = L + AT_V + (s0 + 4 * g4 + (r16 >> 2)) * AT_STRIDE + (16 * dt + 4 * (r16 & 3)) * 2; vf[dt] = cat8(ldtr(a), ldtr(a + 16 * AT_STRIDE)); }
#pragma unroll
            for (int qt = 0; qt < 4; ++qt) {
                f32x4 s[2];
#pragma unroll
                for (int sub = 0; sub < 2; ++sub) { s[sub] = (f32x4){0.f, 0.f, 0.f, 0.f};
#pragma unroll
                    for (int ks = 0; ks < 2; ++ks) s[sub] = mfma16(kf[sub][ks], qf[qt][ks], s[sub]); }
                const int qi = q0 + 16 * qt + r16; float mx = -INFINITY;
#pragma unroll
                for (int sub = 0; sub < 2; ++sub)
#pragma unroll
                    for (int r = 0; r < 4; ++r) { const int kj = ktok0 + 16 * sub + 4 * g4 + r; const int d = (qi > kj) ? (qi - kj) : (kj - qi);
                        float v = s[sub][r] - slope * (float)d; v = (d > 128) ? -INFINITY : v; s[sub][r] = v; mx = fmaxf(mx, v); }
                mx = fmaxf(mx, __shfl_xor(mx, 16)); mx = fmaxf(mx, __shfl_xor(mx, 32));
                const float mnew = fmaxf(mrun[qt], mx), alpha = __builtin_amdgcn_exp2f(mrun[qt] - mnew); mrun[qt] = mnew;
                float ps = 0.f;
#pragma unroll
                for (int sub = 0; sub < 2; ++sub)
#pragma unroll
                    for (int r = 0; r < 4; ++r) { const float p = __builtin_amdgcn_exp2f(s[sub][r] - mnew); s[sub][r] = p; ps += p; }
                lrun[qt] = lrun[qt] * alpha + ps;
                const u32x4 pw = (u32x4){cvtpk(s[0][0], s[0][1]), cvtpk(s[0][2], s[0][3]), cvtpk(s[1][0], s[1][1]), cvtpk(s[1][2], s[1][3])};
#pragma unroll
                for (int dt = 0; dt < 4; ++dt) { oacc[qt][dt] = oacc[qt][dt] * alpha; oacc[qt][dt] = mfma16(vf[dt], __builtin_bit_cast(bf16x8, pw), oacc[qt][dt]); }
            }
        }
#pragma unroll
        for (int qt = 0; qt < 4; ++qt) { float l = lrun[qt]; l += __shfl_xor(l, 16); l += __shfl_xor(l, 32); const float inv = 1.0f / l;
            bf16* op = O1 + ((size_t)b * SEQ + q0 + 16 * qt + r16) * 1024 + hq * 64 + 4 * g4;
#pragma unroll
            for (int dt = 0; dt < 4; ++dt) { const f32x4 o = oacc[qt][dt] * inv; *(u32x2*)(op + 16 * dt) = (u32x2){cvtpk(o[0], o[1]), cvtpk(o[2], o[3])}; } }
    }
}

__device__ __forceinline__ void moe_route(Frame& F, const float* H, const float* gain) {
    const int gw = F.vcu * NWAVES + F.wave, NGW = F.G * NWAVES, lane = F.lane;
    bf16* XN = (bf16*)(F.ws + WS_XN); int* sel = (int*)(F.ws + WS_SEL); float* wsel = (float*)(F.ws + WS_WSEL); int* wcnt = (int*)(F.ws + WS_WCNT);
    const float* router = F.router;
    f32x4 g[4]; f32x4 rt[4][4][2];
#pragma unroll
    for (int j = 0; j < 4; ++j) { g[j] = ((const f32x4*)gain)[lane + 64 * j];
#pragma unroll
        for (int i = 0; i < 4; ++i) { const float* rp = router + (size_t)(256 * j + 4 * lane + i) * 8; rt[j][i][0] = *(const f32x4*)rp; rt[j][i][1] = *(const f32x4*)(rp + 4); } }
    int cnt[8];
#pragma unroll
    for (int e = 0; e < 8; ++e) cnt[e] = 0;
    for (int m = gw; m < NTOK; m += NGW) {
        const GAS f32x4* xr = (const GAS f32x4*)(H + (size_t)m * DM) + lane;
        f32x4 v[4]; float s = 0.f;
#pragma unroll
        for (int j = 0; j < 4; ++j) { v[j] = xr[64 * j]; s += (v[j].x * v[j].x + v[j].y * v[j].y) + (v[j].z * v[j].z + v[j].w * v[j].w); }
        const float rs = 1.0f / sqrtf(wave_sum(s) * (1.f / DM) + NORM_EPS);
        GAS unsigned long long* o8 = (GAS unsigned long long*)(XN + (size_t)m * DM) + lane;
        float lg[8];
#pragma unroll
        for (int e = 0; e < 8; ++e) lg[e] = 0.f;
#pragma unroll
        for (int j = 0; j < 4; ++j) { const f32x4 o = v[j] * rs * g[j]; o8[64 * j] = (unsigned long long)cvtpk(o.x, o.y) | ((unsigned long long)cvtpk(o.z, o.w) << 32);
#pragma unroll
            for (int i = 0; i < 4; ++i)
#pragma unroll
                for (int e = 0; e < 8; ++e) lg[e] += o[i] * rt[j][i][e >> 2][e & 3]; }
#pragma unroll
        for (int e = 0; e < 8; ++e) lg[e] = wave_sum(lg[e]);
        int e0 = 0; float l0 = lg[0];
#pragma unroll
        for (int e = 1; e < 8; ++e) if (lg[e] > l0) { l0 = lg[e]; e0 = e; }
        int e1 = -1; float l1 = -INFINITY;
#pragma unroll
        for (int e = 0; e < 8; ++e) if (e != e0 && lg[e] > l1) { l1 = lg[e]; e1 = e; }
        const float w0 = 1.0f / (1.0f + __expf(l1 - l0)), w1 = 1.0f - w0;
        int rk0 = 0, rk1 = 0;
#pragma unroll
        for (int e = 0; e < 8; ++e) { rk0 = (e0 == e) ? cnt[e] : rk0; rk1 = (e1 == e) ? cnt[e] : rk1; cnt[e] += ((e0 == e) ? 1 : 0) + ((e1 == e) ? 1 : 0); }
        if (lane == 0) { *(int4*)(sel + (size_t)m * 4) = make_int4(e0, e1, rk0, rk1); *(float2*)(wsel + (size_t)m * 2) = make_float2(w0, w1); }
    }
    if (lane < 8) { int cv = 0;
#pragma unroll
        for (int e = 0; e < 8; ++e) cv = (lane == e) ? cnt[e] : cv;
        wcnt[(size_t)gw * 8 + lane] = cv; }
}
__device__ __forceinline__ void moe_gather(Frame& F) {
    const int gw = F.vcu * NWAVES + F.wave, NGW = F.G * NWAVES, lane = F.lane;
    const bf16* XN = (const bf16*)(F.ws + WS_XN); bf16* XS = (bf16*)(F.ws + WS_XS);
    const int* sel = (const int*)(F.ws + WS_SEL); const float* wsel = (const float*)(F.ws + WS_WSEL); const int* wcnt = (const int*)(F.ws + WS_WCNT);
    int* postok = (int*)(F.ws + WS_POSTOK); float* roww = (float*)(F.ws + WS_ROWW); int* meta = (int*)(F.ws + WS_META);
    int base[8], tot[8];
#pragma unroll
    for (int e = 0; e < 8; ++e) { base[e] = 0; tot[e] = 0; }
    for (int w2 = lane; w2 < NGW; w2 += 64) { const int4 a = *(const int4*)(wcnt + (size_t)w2 * 8), c = *(const int4*)(wcnt + (size_t)w2 * 8 + 4); const int lt = (w2 < gw) ? 1 : 0;
        tot[0] += a.x; tot[1] += a.y; tot[2] += a.z; tot[3] += a.w; tot[4] += c.x; tot[5] += c.y; tot[6] += c.z; tot[7] += c.w;
        base[0] += lt * a.x; base[1] += lt * a.y; base[2] += lt * a.z; base[3] += lt * a.w; base[4] += lt * c.x; base[5] += lt * c.y; base[6] += lt * c.z; base[7] += lt * c.w; }
    int ts[9]; ts[0] = 0;
#pragma unroll
    for (int e = 0; e < 8; ++e) { tot[e] = wave_sum_i(tot[e]); base[e] = wave_sum_i(base[e]); ts[e + 1] = ts[e] + ((tot[e] + 255) >> 8); base[e] += ts[e] * 256; }
    if (gw == 0 && lane < 9) { int tv = 0;
#pragma unroll
        for (int e = 0; e < 9; ++e) tv = (lane == e) ? ts[e] : tv;
        meta[lane] = tv; }
    for (int m = gw; m < NTOK; m += NGW) {
        const int4 sv = *(const int4*)(sel + (size_t)m * 4); const float2 wv = *(const float2*)(wsel + (size_t)m * 2);
        int p0 = 0, p1 = 0;
#pragma unroll
        for (int e = 0; e < 8; ++e) { p0 = (sv.x == e) ? base[e] : p0; p1 = (sv.y == e) ? base[e] : p1; }
        p0 += sv.z; p1 += sv.w;
        const v4u a0 = *(const v4u*)(XN + (size_t)m * 1024 + 8 * lane), a1 = *(const v4u*)(XN + (size_t)m * 1024 + 512 + 8 * lane);
        *(v4u*)(XS + (size_t)p0 * 1024 + 8 * lane) = a0; *(v4u*)(XS + (size_t)p0 * 1024 + 512 + 8 * lane) = a1;
        *(v4u*)(XS + (size_t)p1 * 1024 + 8 * lane) = a0; *(v4u*)(XS + (size_t)p1 * 1024 + 512 + 8 * lane) = a1;
        if (lane == 0) { roww[p0] = wv.x; roww[p1] = wv.y; *(int2*)(postok + (size_t)m * 2) = make_int2(p0, p1); }
    }
}
__device__ __forceinline__ void final_rows(Frame& F, float* H, const float* gain) {
    const int gw = F.vcu * NWAVES + F.wave, NGW = F.G * NWAVES, lane = F.lane;
    const bf16* Y = (const bf16*)(F.ws + WS_XS); const int* postok = (const int*)(F.ws + WS_POSTOK);
    f32x4 g[4];
#pragma unroll
    for (int j = 0; j < 4; ++j) g[j] = ((const f32x4*)gain)[lane + 64 * j];
    for (int m = gw; m < NTOK; m += NGW) {
        const int2 pp = *(const int2*)(postok + (size_t)m * 2);
        GAS f32x4* xr = (GAS f32x4*)(H + (size_t)m * DM) + lane;
        const u32x2* y0 = (const u32x2*)(Y + (size_t)pp.x * 1024) + lane; const u32x2* y1 = (const u32x2*)(Y + (size_t)pp.y * 1024) + lane;
        f32x4 v[4]; float s = 0.f;
#pragma unroll
        for (int j = 0; j < 4; ++j) { v[j] = xr[64 * j]; const u32x2 a = y0[64 * j], c = y1[64 * j];
            v[j].x += bf_lo(a.x) + bf_lo(c.x); v[j].y += bf_hi(a.x) + bf_hi(c.x); v[j].z += bf_lo(a.y) + bf_lo(c.y); v[j].w += bf_hi(a.y) + bf_hi(c.y);
            s += (v[j].x * v[j].x + v[j].y * v[j].y) + (v[j].z * v[j].z + v[j].w * v[j].w); }
        const float rs = 1.0f / sqrtf(wave_sum(s) * (1.f / DM) + NORM_EPS);
#pragma unroll
        for (int j = 0; j < 4; ++j) xr[64 * j] = v[j] * rs * g[j];
    }
}

struct Args { const float* in[23]; float* out; unsigned char* ws; int ph_lo, ph_hi; };
__global__ void __launch_bounds__(NWAVES * 64, 2) fwd_kernel(Args args) {
    extern __shared__ __attribute__((aligned(16))) unsigned char lds[];
    Frame F;
    F.lds = (LAS unsigned char*)lds;
    F.MISC = (volatile LAS unsigned*)(F.lds + MISC_OFF);
    F.tid = threadIdx.x; F.lane = F.tid & 63; F.wave = __builtin_amdgcn_readfirstlane(F.tid >> 6);
    F.G = gridDim.x; { const int bx = blockIdx.x; F.vcu = (F.G % 8 == 0) ? (bx % 8) * (F.G / 8) + bx / 8 : bx; }
    F.ws = args.ws; F.out = args.out; F.ctl = (gu32*)(args.ws + WS_CTL);
    F.x = args.in[0]; F.mix_norm = args.in[1]; F.ffn_norm = args.in[2]; F.gla_in = args.in[3]; F.wgf = args.in[4]; F.bgf = args.in[5]; F.wgb = args.in[6]; F.bgb = args.in[7];
    F.head_norm = args.in[8]; F.gla_out = args.in[9]; F.swa_qkv = args.in[10]; F.qkv_bias = args.in[11]; F.sinks = args.in[12]; F.swa_out = args.in[13]; F.swa_out_bias = args.in[14];
    F.d_gate = args.in[15]; F.d_up = args.in[16]; F.d_down = args.in[17]; F.router = args.in[18]; F.m_gate = args.in[19]; F.m_up = args.in[20]; F.m_down = args.in[21]; F.final_norm = args.in[22];
    for (int u = F.tid; u < (LDS_BYTES - LDSCTL_OFF) / 4; u += NWAVES * 64) ((LAS unsigned*)(F.lds + LDSCTL_OFF))[u] = 0u;
    __syncthreads();
    const int lo = args.ph_lo, hi = args.ph_hi;
    XcdBarrier bar; bar.bar = (unsigned*)(F.ctl + CW_BAR); bar.x = 0; bar.st = nullptr;
    if (hi - lo > 1) bar = xcd_barrier_post((unsigned*)(F.ctl + CW_BAR), F.MISC + 8);
#ifndef MK_PHASE_MASK
#define MK_PHASE_MASK 0xFFFFFu
#endif
#define IN(k) (((MK_PHASE_MASK >> (k)) & 1u) && lo <= (k) && (k) < hi)
#define SEAM(k) do { if (IN(k) && IN((k) + 1)) xcd_barrier(bar); } while (0)
    bf16* XN = (bf16*)(F.ws + WS_XN); float* H = F.out;

    if (IN(0)) { p0_weights(F, args.in[3], args.in[9], args.in[10], args.in[13], args.in[15], args.in[16], args.in[17], args.in[19], args.in[20], args.in[21]); rmsnorm_rows(F, F.x, F.mix_norm, XN); } SEAM(0);
    if (IN(1)) { pg8::Gemm g{XN, (const bf16*)(F.ws + WS_W_GLAIN), NTOK, 3328, 1024}; pg8::StaticOrder S; S.init(NTOK, 3328, F.G, (int)blockIdx.x);
        pg8::EpiGlaIn E{(bf16*)(F.ws + WS_Q0), (bf16*)(F.ws + WS_K0), (bf16*)(F.ws + WS_V0), (bf16*)(F.ws + WS_R0), (float*)(F.ws + WS_LR)};
        pg8::gemm_phase<pg8::EpiGlaIn, pg8::StaticOrder, true, true>(F.lds + RING_OFF, g, S, E); } SEAM(1);
    if (IN(2)) { gla_prep(F); } SEAM(2);
    if (IN(3)) { gla_scan(F); } SEAM(3);
    if (IN(4)) { gla_post(F); } SEAM(4);
    if (IN(5)) { pg8::Gemm g{(const bf16*)(F.ws + WS_G), (const bf16*)(F.ws + WS_W_GLAOUT), NTOK, 1024, 1024}; pg8::StaticOrder S; S.init(NTOK, 1024, F.G, (int)blockIdx.x);
        pg8::EpiResF32 E{F.x, H, nullptr};
        pg8::gemm_phase<pg8::EpiResF32, pg8::StaticOrder, true, true>(F.lds + RING_OFF, g, S, E); } SEAM(5);
    if (IN(6)) { rmsnorm_rows(F, H, F.ffn_norm, XN); } SEAM(6);
    if (IN(7)) { pg8::Gemm g{XN, (const bf16*)(F.ws + WS_W_DGU), NTOK, 5632, 1024}; pg8::StaticOrder S; S.init(NTOK, 5632, F.G, (int)blockIdx.x);
        pg8::EpiSwiglu E{(bf16*)(F.ws + WS_ACT0), DFF, 22};
        pg8::gemm_phase<pg8::EpiSwiglu, pg8::StaticOrder, true, true>(F.lds + RING_OFF, g, S, E); } SEAM(7);
    if (IN(8)) { pg8::Gemm g{(const bf16*)(F.ws + WS_ACT0), (const bf16*)(F.ws + WS_W_DDN), NTOK, 1024, DFF}; pg8::StaticOrder S; S.init(NTOK, 1024, F.G, (int)blockIdx.x);
        pg8::EpiResF32 E{H, H, nullptr};
        pg8::gemm_phase<pg8::EpiResF32, pg8::StaticOrder, true, true>(F.lds + RING_OFF, g, S, E); } SEAM(8);
    if (IN(9)) { rmsnorm_rows(F, H, F.mix_norm + DM, XN); } SEAM(9);
    if (IN(10)) { pg8::Gemm g{XN, (const bf16*)(F.ws + WS_W_QKV), NTOK, 1536, 1024}; pg8::StaticOrder S; S.init(NTOK, 1536, F.G, (int)blockIdx.x);
        pg8::EpiQkv E{(bf16*)(F.ws + WS_Q1), (bf16*)(F.ws + WS_K1), (bf16*)(F.ws + WS_V1), F.qkv_bias};
        pg8::gemm_phase<pg8::EpiQkv, pg8::StaticOrder, true, true>(F.lds + RING_OFF, g, S, E); } SEAM(10);
    if (IN(11)) { swa_attn(F); } SEAM(11);
    if (IN(12)) { pg8::Gemm g{(const bf16*)(F.ws + WS_O1), (const bf16*)(F.ws + WS_W_SWAOUT), NTOK, 1024, 1024}; pg8::StaticOrder S; S.init(NTOK, 1024, F.G, (int)blockIdx.x);
        pg8::EpiResF32 E{H, H, F.swa_out_bias};
        pg8::gemm_phase<pg8::EpiResF32, pg8::StaticOrder, true, true>(F.lds + RING_OFF, g, S, E); } SEAM(12);
    if (IN(13)) { moe_route(F, H, F.ffn_norm + DM); } SEAM(13);
    if (IN(14)) { moe_gather(F); } SEAM(14);
    if (IN(15)) { pg8::MoeOrder S; S.init((const int*)(F.ws + WS_META), 0, 22, F.G, (int)blockIdx.x);
        pg8::Gemm g{(const bf16*)(F.ws + WS_XS) + (size_t)S.t_lo * 256 * 1024, (const bf16*)(F.ws + WS_W_MGU), 0, 0, 1024};
        pg8::EpiSwiglu E{(bf16*)(F.ws + WS_ACT1), DFF, 22};
        pg8::gemm_phase<pg8::EpiSwiglu, pg8::MoeOrder, true, true>(F.lds + RING_OFF, g, S, E); } SEAM(15);
    if (IN(16)) { pg8::MoeOrder S; S.init((const int*)(F.ws + WS_META), 0, 4, F.G, (int)blockIdx.x);
        pg8::Gemm g{(const bf16*)(F.ws + WS_ACT1), (const bf16*)(F.ws + WS_W_MDN), 0, 0, DFF};
        pg8::EpiMoeDown E{(bf16*)(F.ws + WS_XS), (const float*)(F.ws + WS_ROWW), S.t_lo * 256};
        pg8::gemm_phase<pg8::EpiMoeDown, pg8::MoeOrder, true, true>(F.lds + RING_OFF, g, S, E); } SEAM(16);
    if (IN(17)) { pg8::MoeOrder S; S.init((const int*)(F.ws + WS_META), 1, 22, F.G, (int)blockIdx.x);
        pg8::Gemm g{(const bf16*)(F.ws + WS_XS) + (size_t)S.t_lo * 256 * 1024, (const bf16*)(F.ws + WS_W_MGU), 0, 0, 1024};
        pg8::EpiSwiglu E{(bf16*)(F.ws + WS_ACT1), DFF, 22};
        pg8::gemm_phase<pg8::EpiSwiglu, pg8::MoeOrder, true, true>(F.lds + RING_OFF, g, S, E); } SEAM(17);
    if (IN(18)) { pg8::MoeOrder S; S.init((const int*)(F.ws + WS_META), 1, 4, F.G, (int)blockIdx.x);
        pg8::Gemm g{(const bf16*)(F.ws + WS_ACT1), (const bf16*)(F.ws + WS_W_MDN), 0, 0, DFF};
        pg8::EpiMoeDown E{(bf16*)(F.ws + WS_XS), (const float*)(F.ws + WS_ROWW), S.t_lo * 256};
        pg8::gemm_phase<pg8::EpiMoeDown, pg8::MoeOrder, true, true>(F.lds + RING_OFF, g, S, E); } SEAM(18);
    if (IN(19)) { final_rows(F, H, F.final_norm); }
#undef IN
#undef SEAM
}

extern "C" void kernel_launch(void* const* d_in, const int* in_sizes, int n_in, void* d_out, int out_size, void* d_ws, size_t ws_size, hipStream_t stream) {
    static int grid = 0;
    if (grid == 0) {
        if (n_in != 23 || in_sizes[0] != NTOK * DM || out_size != NTOK * DM || ws_size < WS_END) {
            fprintf(stderr, "kernel_launch: built for 23 inputs, x/out of %d floats, >= %zu bytes of workspace; got n_in %d, in0 %d, out %d, ws %zu; nothing launched\n", NTOK * DM, (size_t)WS_END, n_in, n_in > 0 ? in_sizes[0] : -1, out_size, ws_size); grid = -1; return; }
        int dev = 0, cus = 0, per_cu = 0;
        if (hipGetDevice(&dev) != hipSuccess || hipDeviceGetAttribute(&cus, hipDeviceAttributeMultiprocessorCount, dev) != hipSuccess) { fprintf(stderr, "kernel_launch: device query failed\n"); grid = -1; return; }
        if (hipFuncSetAttribute((const void*)fwd_kernel, hipFuncAttributeMaxDynamicSharedMemorySize, LDS_BYTES) != hipSuccess) { fprintf(stderr, "kernel_launch: hipFuncSetAttribute failed\n"); grid = -1; return; }
        if (hipOccupancyMaxActiveBlocksPerMultiprocessor(&per_cu, (const void*)fwd_kernel, NWAVES * 64, LDS_BYTES) != hipSuccess || per_cu < 1) {
            fprintf(stderr, "kernel_launch: occupancy query reports %d workgroups per CU\n", per_cu); (void)hipGetLastError(); grid = -1; return; }
        grid = cus;
    }
    if (grid < 0) return;
    if (hipMemsetAsync((char*)d_ws + WS_CTL, 0, CTL_ZERO_BYTES, stream) != hipSuccess) { fprintf(stderr, "kernel_launch: memset failed\n"); return; }
    Args a{};
    for (int i = 0; i < 23; ++i) a.in[i] = (const float*)d_in[i];
    a.out = (float*)d_out; a.ws = (unsigned char*)d_ws;
#if MK_ONE_LAUNCH
    a.ph_lo = 0; a.ph_hi = NPHASE;
    hipLaunchKernelGGL(fwd_kernel, dim3(grid), dim3(NWAVES * 64), LDS_BYTES, stream, a);
#else
    for (int p = 0; p < NPHASE; ++p) { a.ph_lo = p; a.ph_hi = p + 1; hipLaunchKernelGGL(fwd_kernel, dim3(grid), dim3(NWAVES * 64), LDS_BYTES, stream, a); }
#endif
    const hipError_t le = hipPeekAtLastError();
    if (le != hipSuccess) fprintf(stderr, "kernel_launch: launch failed: %s\n", hipGetErrorName(le));
}
```

```cpp
#include <hip/hip_runtime.h>
#include <cstdio>
#include <cstdint>
namespace pg8 {
#define PG8_LAS __attribute__((address_space(3)))
typedef unsigned short bf16_t;
typedef short bf16x8 __attribute__((ext_vector_type(8)));
typedef float f32x4 __attribute__((ext_vector_type(4)));
typedef unsigned u32x4 __attribute__((ext_vector_type(4)));
constexpr int BM = 256, BK = 64, HALF = 128, HTB = HALF * BK * 2  , STAGE_BYTES = 8 * HTB, NXCD = 8,
#ifdef MK_WGM
    WGM = MK_WGM;
#else
    WGM = 8;
#endif

__host__ __device__ __forceinline__ int lds_byte(int r, int c) { const int st = (r >> 4) * 2 + (c >> 5), rr = r & 15, cc = c & 31, ob = rr * 64 + cc * 2; return st * 1024 + (ob ^ (((ob >> 9) & 1) << 5)); }
__host__ __device__ __forceinline__ void stage_rc(int b, int& R, int& C) { const int st = b / 1024, sb = b % 1024, swz = sb ^ (((sb >> 9) & 1) << 5); R = (st >> 1) * 16 + swz / 64; C = (st & 1) * 32 + (swz % 64) / 2; }
__host__ __device__ __forceinline__ int perm32(int rho) { const int n = rho >> 4, i = rho & 15; return 8 * (i >> 2) + 4 * n + (i & 3); }

struct Unit { int pm, pn; };
struct Gemm { const bf16_t* A; const bf16_t* Bt; int M, N, K; };

struct StaticOrder {
    int nM, nN, nwg, G, c;
    __host__ __device__ void init(int M, int N, int G_, int c_) { nM = M / BM; nN = N / BM; nwg = nM * nN; G = G_; c = c_; }
    __host__ __device__ bool next(int i, Unit& u) const {
        const long L = (long)i * G + c; if (L >= nwg) return false;
        int wgid = (int)L; { const int q = nwg / NXCD, r = nwg % NXCD, xcd = wgid % NXCD, off = wgid / NXCD; wgid = (xcd < r ? xcd * (q + 1) : r * (q + 1) + (xcd - r) * q) + off; }
        const int nig = WGM * nN, gid = wgid / nig, fm = gid * WGM, gsz = (nM - fm) < WGM ? (nM - fm) : WGM;
        u.pm = fm + ((wgid % nig) % gsz); u.pn = (wgid % nig) / gsz; return true;
    }
    __device__ __forceinline__ void a_ready(const Unit&) const {}
    __device__ __forceinline__ void done(const Unit&) const {}
};

__device__ __forceinline__ unsigned cvt_pk_bf16(float lo, float hi) { unsigned r; asm volatile("v_cvt_pk_bf16_f32 %0, %1, %2" : "=v"(r) : "v"(lo), "v"(hi)); return r; }
typedef float f32x2 __attribute__((ext_vector_type(2)));

typedef unsigned u32x2 __attribute__((ext_vector_type(2)));
__device__ __forceinline__ int pg8_lane() { int l; asm volatile("v_mbcnt_lo_u32_b32 %0, -1, 0\n\tv_mbcnt_hi_u32_b32 %0, -1, %0" : "=v"(l)); return l; }
typedef float f32x2_t __attribute__((ext_vector_type(2))); typedef __bf16 bf16x2_t __attribute__((ext_vector_type(2)));
__device__ __forceinline__ unsigned cvt2(float lo, float hi) { f32x2_t v = {lo, hi}; bf16x2_t b = __builtin_convertvector(v, bf16x2_t); return __builtin_bit_cast(unsigned, b); }
__device__ __forceinline__ u32x4 pack8(f32x4 a, f32x4 b) { u32x4 w; w.x = cvt2(a[0], a[1]); w.y = cvt2(a[2], a[3]); w.z = cvt2(b[0], b[1]); w.w = cvt2(b[2], b[3]); return w; }

constexpr int RC_MAXP = 15, RC_BYTES = 64 + RC_MAXP * 1024;
__device__ __forceinline__ float rs_from_partials(const float* ssp, int row) {
    const f32x4 a = *(const f32x4*)(ssp + (size_t)row * 16), b = *(const f32x4*)(ssp + (size_t)row * 16 + 4), c = *(const f32x4*)(ssp + (size_t)row * 16 + 8), d = *(const f32x4*)(ssp + (size_t)row * 16 + 12);
    const float s = ((a[0] + a[1]) + (a[2] + a[3])) + ((b[0] + b[1]) + (b[2] + b[3])) + ((c[0] + c[1]) + (c[2] + c[3])) + ((d[0] + d[1]) + (d[2] + d[3]));
    return __builtin_amdgcn_rsqf(s * (1.0f / 1024.0f) + 1e-5f);
}
template <class Sched>
__device__ __forceinline__ void rowcache_fill(PG8_LAS unsigned char* aux, const Sched& S, const float* src, int np, int wid) {
    PG8_LAS int* hdr = (PG8_LAS int*)aux; PG8_LAS float* val = (PG8_LAS float*)(aux + 64);
    const int lane = pg8_lane(), tid = wid * 64 + lane;
    asm volatile("s_waitcnt lgkmcnt(0)" ::: "memory"); __builtin_amdgcn_s_barrier(); asm volatile("" ::: "memory");
    if (wid == 0) {
        Unit u; const bool has = S.next(lane, u); const int pm = has ? u.pm : -1; bool first = has;
        for (int j = 0; j < 63; ++j) { const int pj = __shfl(pm, j); if (j < lane && pj == pm) first = false; }
        const unsigned long long mask = __ballot(first);
        const int pos = __builtin_popcountll(mask & ((1ull << lane) - 1ull));
        if (first && pos < RC_MAXP) hdr[1 + pos] = pm;
        if (lane == 0) { const int n = __builtin_popcountll(mask); hdr[0] = n < RC_MAXP ? n : RC_MAXP; }
    }
    asm volatile("s_waitcnt lgkmcnt(0)" ::: "memory"); __builtin_amdgcn_s_barrier(); asm volatile("" ::: "memory");
    const int n = hdr[0];
    for (int s = (tid >> 8); s < n; s += 2) { const int row = hdr[1 + s] * BM + (tid & 255);
        val[s * 256 + (tid & 255)] = (np == 16) ? rs_from_partials(src, row) : src[row]; }
    asm volatile("s_waitcnt vmcnt(0) lgkmcnt(0)" ::: "memory"); __builtin_amdgcn_s_barrier(); asm volatile("" ::: "memory");
}
__device__ __forceinline__ void rowcache_get8(const PG8_LAS unsigned char* aux, const float* src, int np, int pm, int rr0, float (&v)[2][4]) {
    const PG8_LAS int* hdr = (const PG8_LAS int*)aux; const PG8_LAS float* val = (const PG8_LAS float*)(aux + 64);
    const int n = hdr[0]; int slot = -1;
#pragma unroll
    for (int k = 0; k < RC_MAXP; ++k) slot = (k < n && hdr[1 + k] == pm) ? k : slot;
    slot = __builtin_amdgcn_readfirstlane(slot);
    if (slot >= 0) {
#pragma unroll
        for (int ai = 0; ai < 2; ++ai)
#pragma unroll
            for (int m = 0; m < 4; ++m) v[ai][m] = val[slot * 256 + rr0 + ai * HALF + m * 16];
    } else {
#pragma unroll
        for (int ai = 0; ai < 2; ++ai)
#pragma unroll
            for (int m = 0; m < 4; ++m) { const int row = pm * BM + rr0 + ai * HALF + m * 16; v[ai][m] = (np == 16) ? rs_from_partials(src, row) : src[row]; }
    }
}
struct EpiGlaIn {
    static constexpr bool PERM = true, AFTER_DRAIN = false;
    bf16_t *Q0, *K0, *V0, *R0; float* LR; const float* rs0; const PG8_LAS unsigned char* aux;
    __device__ __forceinline__ void operator()(const f32x4 (&acc)[2][2][4][2], const Unit& u, int wr, int wc, int fr, int fq) const {
        const int pn = u.pn; const int row0 = u.pm * BM + wr * 64 + fr; const int cw = wc * 32 + 8 * fq;
        float rs[2][4]; rowcache_get8(aux, rs0, 1, u.pm, wr * 64 + fr, rs);
        if (pn < 12) {
            bf16_t* base; int ld, c0; float sc = 1.f;
            if (pn < 2) { base = Q0; ld = 512; c0 = pn * 256; sc = 0.08838834764831845f; }
            else if (pn < 4) { base = K0; ld = 512; c0 = (pn - 2) * 256; }
            else if (pn < 8) { base = V0; ld = 1024; c0 = (pn - 4) * 256; }
            else { base = R0; ld = 1024; c0 = (pn - 8) * 256; }
#pragma unroll
            for (int ai = 0; ai < 2; ++ai)
#pragma unroll
                for (int m = 0; m < 4; ++m) { bf16_t* rowp = base + (size_t)(row0 + ai * HALF + m * 16) * ld + c0 + cw;
#pragma unroll
                    for (int bj = 0; bj < 2; ++bj) *(u32x4*)(rowp + bj * HALF) = pack8(acc[ai][bj][m][0] * (sc * rs[ai][m]), acc[ai][bj][m][1] * (sc * rs[ai][m])); }
        } else if (wc == 0) {
#pragma unroll
            for (int ai = 0; ai < 2; ++ai)
#pragma unroll
                for (int m = 0; m < 4; ++m) { float* p = LR + (size_t)(row0 + ai * HALF + m * 16) * 32 + 8 * fq;
                    *(f32x4*)p = acc[ai][0][m][0] * rs[ai][m]; *(f32x4*)(p + 4) = acc[ai][0][m][1] * rs[ai][m]; }
        }
    }
};
struct EpiResBf16 {
    static constexpr bool PERM = true, AFTER_DRAIN = false;
    const bf16_t* base; bf16_t* out; const float* bias; float* ssp; float accs;
    __device__ __forceinline__ void operator()(const f32x4 (&acc)[2][2][4][2], const Unit& u, int wr, int wc, int fr, int fq) const {
        const int row0 = u.pm * BM + wr * 64 + fr; const int col0 = u.pn * BM + wc * 32 + 8 * fq;
        f32x4 bv[2][2];
#pragma unroll
        for (int bj = 0; bj < 2; ++bj)
#pragma unroll
            for (int n = 0; n < 2; ++n) bv[bj][n] = bias ? *(const f32x4*)(bias + col0 + bj * HALF + 4 * n) : (f32x4){0.f, 0.f, 0.f, 0.f};
#pragma unroll
        for (int ai = 0; ai < 2; ++ai) {
            u32x4 bbv[4][2];
#pragma unroll
            for (int m = 0; m < 4; ++m)
#pragma unroll
                for (int bj = 0; bj < 2; ++bj) bbv[m][bj] = *(const u32x4*)(base + (size_t)(row0 + ai * HALF + m * 16) * 1024 + col0 + bj * HALF);
#pragma unroll
            for (int m = 0; m < 4; ++m) { const int row = row0 + ai * HALF + m * 16; const size_t off = (size_t)row * 1024 + col0; float s = 0.f;
#pragma unroll
                for (int bj = 0; bj < 2; ++bj) { const u32x4 bb = bbv[m][bj]; f32x4 v0, v1;
#pragma unroll
                    for (int j = 0; j < 2; ++j) { v0[2 * j] = __uint_as_float(bb[j] << 16); v0[2 * j + 1] = __uint_as_float(bb[j] & 0xffff0000u); v1[2 * j] = __uint_as_float(bb[2 + j] << 16); v1[2 * j + 1] = __uint_as_float(bb[2 + j] & 0xffff0000u); }
                    v0 = v0 + acc[ai][bj][m][0] * accs + bv[bj][0]; v1 = v1 + acc[ai][bj][m][1] * accs + bv[bj][1];
                    s += (v0[0] * v0[0] + v0[1] * v0[1]) + (v0[2] * v0[2] + v0[3] * v0[3]) + (v1[0] * v1[0] + v1[1] * v1[1]) + (v1[2] * v1[2] + v1[3] * v1[3]);
                    *(u32x4*)(out + off + bj * HALF) = pack8(v0, v1); }
                s += __shfl_xor(s, 16); s += __shfl_xor(s, 32);
                if (fq == 0) ssp[(size_t)row * 16 + 4 * u.pn + wc] = s; }
        }
    }
};
__device__ __forceinline__ float silu_f(float g) { return g * __builtin_amdgcn_rcpf(1.0f + __builtin_amdgcn_exp2f(-1.4426950408889634f * g)); }
__device__ __forceinline__ unsigned pk4_fp8(float a, float b, float c, float d) {
    a = __builtin_amdgcn_fmed3f(a, -448.f, 448.f); b = __builtin_amdgcn_fmed3f(b, -448.f, 448.f); c = __builtin_amdgcn_fmed3f(c, -448.f, 448.f); d = __builtin_amdgcn_fmed3f(d, -448.f, 448.f);
    unsigned r = 0u; r = __builtin_amdgcn_cvt_pk_fp8_f32(a, b, r, false); r = __builtin_amdgcn_cvt_pk_fp8_f32(c, d, r, true); return r;
}
struct EpiSwiglu {
    static constexpr bool PERM = true, AFTER_DRAIN = false;
    bf16_t* O; int ldo; int ntn; const float* ssp; const PG8_LAS unsigned char* aux; float f8scale;
    __device__ __forceinline__ void operator()(const f32x4 (&acc)[2][2][4][2], const Unit& u, int wr, int wc, int fr, int fq) const {
        const int row0 = u.pm * BM + wr * 64 + fr; const int col0 = (u.pn % ntn) * HALF + wc * 32 + 8 * fq;
        float rsv[2][4]; rowcache_get8(aux, ssp, 16, u.pm, wr * 64 + fr, rsv);
#pragma unroll
        for (int ai = 0; ai < 2; ++ai)
#pragma unroll
            for (int m = 0; m < 4; ++m) { f32x4 v0, v1; const float rs = rsv[ai][m];
                { const float c0 = -1.4426950408889634f * rs, c1 = rs * rs; const f32x4 g0 = acc[ai][0][m][0], g1 = acc[ai][0][m][1]; f32x4 t0 = g0 * c0, t1 = g1 * c0;
#pragma unroll
                  for (int j = 0; j < 4; ++j) { t0[j] = __builtin_amdgcn_rcpf(1.0f + __builtin_amdgcn_exp2f(t0[j])); t1[j] = __builtin_amdgcn_rcpf(1.0f + __builtin_amdgcn_exp2f(t1[j])); }
                  v0 = (g0 * acc[ai][1][m][0]) * (t0 * c1); v1 = (g1 * acc[ai][1][m][1]) * (t1 * c1); }
                if (f8scale > 0.f) { v0 = v0 * f8scale; v1 = v1 * f8scale; *(u32x2*)((unsigned char*)O + (size_t)(row0 + ai * HALF + m * 16) * ldo + col0) = (u32x2){pk4_fp8(v0[0], v0[1], v0[2], v0[3]), pk4_fp8(v1[0], v1[1], v1[2], v1[3])}; }
                else *(u32x4*)(O + (size_t)(row0 + ai * HALF + m * 16) * ldo + col0) = pack8(v0, v1); }
    }
};
struct EpiSwiglu8 {
    static constexpr bool PERM = true, AFTER_DRAIN = false;
    unsigned char* O; int ldo; int ntn; float inv, oscale;
    __device__ __forceinline__ void operator()(const f32x4 (&acc)[2][2][4][2], const Unit& u, int wr, int wc, int fr, int fq) const {
        const int row0 = u.pm * BM + wr * 64 + fr; const int col0 = (u.pn % ntn) * HALF + wc * 32 + 8 * fq;
#pragma unroll
        for (int ai = 0; ai < 2; ++ai)
#pragma unroll
            for (int m = 0; m < 4; ++m) { f32x4 v0, v1;
                { const float c0 = -1.4426950408889634f * inv, c1 = inv * inv * oscale; const f32x4 g0 = acc[ai][0][m][0], g1 = acc[ai][0][m][1]; f32x4 t0 = g0 * c0, t1 = g1 * c0;
#pragma unroll
                  for (int j = 0; j < 4; ++j) { t0[j] = __builtin_amdgcn_rcpf(1.0f + __builtin_amdgcn_exp2f(t0[j])); t1[j] = __builtin_amdgcn_rcpf(1.0f + __builtin_amdgcn_exp2f(t1[j])); }
                  v0 = (g0 * acc[ai][1][m][0]) * (t0 * c1); v1 = (g1 * acc[ai][1][m][1]) * (t1 * c1); }
                *(u32x2*)(O + (size_t)(row0 + ai * HALF + m * 16) * ldo + col0) = (u32x2){pk4_fp8(v0[0], v0[1], v0[2], v0[3]), pk4_fp8(v1[0], v1[1], v1[2], v1[3])}; }
    }
};
struct EpiMoeDown {
    static constexpr bool PERM = true, AFTER_DRAIN = false;
    bf16_t* Y; const float* roww; int row_base; float inv; const PG8_LAS unsigned char* aux;
    __device__ __forceinline__ void operator()(const f32x4 (&acc)[2][2][4][2], const Unit& u, int wr, int wc, int fr, int fq) const {
        const int row0 = row_base + u.pm * BM + wr * 64 + fr; const int col0 = (u.pn & 3) * BM + wc * 32 + 8 * fq;
        float wv[2][4]; rowcache_get8(aux, roww, 1, u.pm, wr * 64 + fr, wv);
#pragma unroll
        for (int ai = 0; ai < 2; ++ai)
#pragma unroll
            for (int m = 0; m < 4; ++m) wv[ai][m] *= inv;
#pragma unroll
        for (int ai = 0; ai < 2; ++ai)
#pragma unroll
            for (int m = 0; m < 4; ++m) { const int row = row0 + ai * HALF + m * 16; const float w = wv[ai][m]; bf16_t* rowp = Y + (size_t)row * 1024 + col0;
#pragma unroll
                for (int bj = 0; bj < 2; ++bj) *(u32x4*)(rowp + bj * HALF) = pack8(acc[ai][bj][m][0] * w, acc[ai][bj][m][1] * w); }
    }
};
struct EpiQkv {
    static constexpr bool PERM = true, AFTER_DRAIN = false;
    bf16_t *Q1, *K1, *V1; const float* bias; const float* ssp; const PG8_LAS unsigned char* aux;
    __device__ __forceinline__ void operator()(const f32x4 (&acc)[2][2][4][2], const Unit& u, int wr, int wc, int fr, int fq) const {
        const int pn = u.pn; const int row0 = u.pm * BM + wr * 64 + fr; const int cw = wc * 32 + 8 * fq;
        bf16_t* base; int ld, c0; float sc = 1.f;
        if (pn < 4) { base = Q1; ld = 1024; c0 = pn * 256; sc = 0.125f * 1.4426950408889634f; }
        else if (pn == 4) { base = K1; ld = 256; c0 = 0; }
        else { base = V1; ld = 256; c0 = 0; }
        f32x4 bv[2][2];
#pragma unroll
        for (int bj = 0; bj < 2; ++bj)
#pragma unroll
            for (int n = 0; n < 2; ++n) bv[bj][n] = *(const f32x4*)(bias + pn * 256 + bj * HALF + cw + 4 * n);
        float rsv[2][4]; rowcache_get8(aux, ssp, 16, u.pm, wr * 64 + fr, rsv);
#pragma unroll
        for (int ai = 0; ai < 2; ++ai)
#pragma unroll
            for (int m = 0; m < 4; ++m) { bf16_t* rowp = base + (size_t)(row0 + ai * HALF + m * 16) * ld + c0 + cw; const float rs = rsv[ai][m];
#pragma unroll
                for (int bj = 0; bj < 2; ++bj) *(u32x4*)(rowp + bj * HALF) = pack8((acc[ai][bj][m][0] * rs + bv[bj][0]) * sc, (acc[ai][bj][m][1] * rs + bv[bj][1]) * sc); }
    }
};
struct MoeOrder {
    int nM, nN, nwg, G, c, rev, i0, i1; const int* meta;
    __device__ __forceinline__ void init(const int* meta_, int nN_, int G_, int c_, int rev_ = 0, int i0_ = 0, int i1_ = 0x7fffffff) { meta = meta_; nM = meta_[8]; nN = nN_; nwg = nM * nN; G = G_; c = c_; rev = rev_; i0 = i0_; i1 = i1_; }
    __device__ __forceinline__ bool next(int i, Unit& u) const {
        const int ii = i + i0; if (ii >= i1) return false;
        const long L = (long)ii * G + c; if (L >= nwg) return false;
        int wgid = (int)L; { const int q = nwg / NXCD, r = nwg % NXCD, xcd = wgid % NXCD, off = wgid / NXCD; wgid = (xcd < r ? xcd * (q + 1) : r * (q + 1) + (xcd - r) * q) + off; }
        const int nig = WGM * nN, gid = wgid / nig, fm = gid * WGM, gsz = (nM - fm) < WGM ? (nM - fm) : WGM;
        const int pm0 = fm + ((wgid % nig) % gsz), pn = (wgid % nig) / gsz; const int pm = rev ? nM - 1 - pm0 : pm0;
        int e = 0;
#pragma unroll
        for (int k = 1; k < 8; ++k) e += (pm >= meta[k]) ? 1 : 0;
        u.pm = pm; u.pn = e * nN + pn; return true;
    }
    __device__ __forceinline__ void a_ready(const Unit&) const {}
    __device__ __forceinline__ void done(const Unit&) const {}
};

constexpr int UL_MAX = 128;
template <class Sched> struct ListOrder {
    const PG8_LAS int* list; int n; Sched S;
    __device__ __forceinline__ bool next(int i, Unit& u) const {
        if (i >= UL_MAX) return S.next(i, u);
        if (i >= n) return false;
        const int a = list[2 * i], b = list[2 * i + 1]; u.pm = __builtin_amdgcn_readfirstlane(a); u.pn = __builtin_amdgcn_readfirstlane(b); return true;
    }
    __device__ __forceinline__ void a_ready(const Unit&) const {}
    __device__ __forceinline__ void done(const Unit&) const {}
};
template <class Sched> __device__ __forceinline__ ListOrder<Sched> unitlist_fill(PG8_LAS unsigned char* mem, const Sched& S, int wid) {
    PG8_LAS int* list = (PG8_LAS int*)mem; PG8_LAS int* cnt = list + 2 * UL_MAX;
    asm volatile("s_waitcnt lgkmcnt(0)" ::: "memory"); __builtin_amdgcn_s_barrier(); asm volatile("" ::: "memory");
    if (wid < 2) { const int i = wid * 64 + pg8_lane(); Unit u; const bool has = S.next(i, u);
        if (has) { list[2 * i] = u.pm; list[2 * i + 1] = u.pn; }
        const int c = __builtin_popcountll(__ballot(has)); if (pg8_lane() == 0) cnt[wid] = c; }
    asm volatile("s_waitcnt lgkmcnt(0)" ::: "memory"); __builtin_amdgcn_s_barrier(); asm volatile("" ::: "memory");
    ListOrder<Sched> L; L.list = list; L.n = __builtin_amdgcn_readfirstlane(cnt[0] + cnt[1]); L.S = S; return L;
}
typedef int v4i_t __attribute__((ext_vector_type(4))); typedef int v8i_t __attribute__((ext_vector_type(8)));
__device__ __forceinline__ v8i_t cat32(bf16x8 lo, bf16x8 hi) { const v4i_t a = __builtin_bit_cast(v4i_t, lo), b = __builtin_bit_cast(v4i_t, hi); return __builtin_shufflevector(a, b, 0, 1, 2, 3, 4, 5, 6, 7); }
template <class Epi, class Sched, bool ALIGN_EPI = false, bool SP2 = false, bool FP8 = false>
__device__ __forceinline__ void gemm_phase(PG8_LAS unsigned char* lds, const Gemm g, const Sched& S, const Epi& E, const int wid  ) {
    const int lane = pg8_lane(), tid = wid * 64 + lane, wr = wid >> 2, wc = wid & 3, fr = lane & 15, fq = lane >> 4;
    const int K = g.K, nt = K / BK;
    unsigned voffA[2], voffB[2];
#pragma unroll
    for (int i = 0; i < 2; ++i) { int R, C; stage_rc(tid * 16 + i * 8192, R, C); const int Rb = Epi::PERM ? ((R & ~31) + perm32(R & 31)) : R;
        voffA[i] = (unsigned)(R * K + C) * 2u; voffB[i] = (unsigned)(Rb * K + C) * 2u; }
    const __amdgpu_buffer_rsrc_t rsA = __builtin_amdgcn_make_buffer_rsrc((void*)g.A, 0, 0x7fffffff, 0x00020000), rsB = __builtin_amdgcn_make_buffer_rsrc((void*)g.Bt, 0, 0x7fffffff, 0x00020000);
    const size_t kstep = (size_t)(BK * 2);
    const size_t hstep = (size_t)HALF * K * 2;
    const size_t tstep = 2 * hstep;
    const unsigned ldsw = (unsigned)wid * 1024u;
    const int aoff = lds_byte(wr * 64 + fr, fq * 8), boff = lds_byte(wc * 32 + fr, fq * 8);
#define PG8_SA(b, h) (((b) * 2 + (h)) * HTB)
#define PG8_SB(b, h) ((4 + (b) * 2 + (h)) * HTB)
#define PG8_RS_voffA rsA
#define PG8_RS_voffB rsB
#define PG8_BASE_voffA ((const char*)g.A)
#define PG8_BASE_voffB ((const char*)g.Bt)
#define PG8_STAGE(bufoff, gbase, voff) do { const unsigned so_ = (unsigned)((const char*)(gbase) - PG8_BASE_##voff); _Pragma("unroll") for (int _i = 0; _i < 2; ++_i) \
        __builtin_amdgcn_raw_ptr_buffer_load_lds(PG8_RS_##voff, (PG8_LAS unsigned*)(lds + (bufoff) + ldsw + _i * 8192), 16, (int)(voff)[_i], (int)so_, 0, 0); } while (0)
#define PG8_LDA(dst, b, h) do { if constexpr (FP8) { _Pragma("unroll") for (int m = 0; m < 4; ++m) dst##8[m] = cat32(*(const PG8_LAS bf16x8*)(lds + PG8_SA(b, h) + aoff + m * 2048), *(const PG8_LAS bf16x8*)(lds + PG8_SA(b, h) + aoff + m * 2048 + 1024)); } \
        else { _Pragma("unroll") for (int m = 0; m < 4; ++m) _Pragma("unroll") for (int k = 0; k < 2; ++k) dst[m][k] = *(const PG8_LAS bf16x8*)(lds + PG8_SA(b, h) + aoff + m * 2048 + k * 1024); } } while (0)
#define PG8_LDB(dst, b, h) do { if constexpr (FP8) { _Pragma("unroll") for (int n = 0; n < 2; ++n) dst##8[n] = cat32(*(const PG8_LAS bf16x8*)(lds + PG8_SB(b, h) + boff + n * 2048), *(const PG8_LAS bf16x8*)(lds + PG8_SB(b, h) + boff + n * 2048 + 1024)); } \
        else { _Pragma("unroll") for (int n = 0; n < 2; ++n) _Pragma("unroll") for (int k = 0; k < 2; ++k) dst[n][k] = *(const PG8_LAS bf16x8*)(lds + PG8_SB(b, h) + boff + n * 2048 + k * 1024); } } while (0)
#define PG8_MMA(ai, bj, At, Bt) do { __builtin_amdgcn_s_setprio(1); if constexpr (FP8) { _Pragma("unroll") for (int m = 0; m < 4; ++m) _Pragma("unroll") for (int n = 0; n < 2; ++n) \
        acc[ai][bj][m][n] = __builtin_amdgcn_mfma_scale_f32_16x16x128_f8f6f4(Bt##8[n], At##8[m], acc[ai][bj][m][n], 0, 0, 0, 0x7f7f7f7f, 0, 0x7f7f7f7f); } else { \
        _Pragma("unroll") for (int m = 0; m < 4; ++m) _Pragma("unroll") for (int n = 0; n < 2; ++n) _Pragma("unroll") for (int k = 0; k < 2; ++k) \
        acc[ai][bj][m][n] = __builtin_amdgcn_mfma_f32_16x16x32_bf16(Bt[n][k], At[m][k], acc[ai][bj][m][n], 0, 0, 0); } __builtin_amdgcn_s_setprio(0); } while (0)
#define PG8_WAIT_V(n) asm volatile("s_waitcnt vmcnt(" #n ")" ::: "memory")
#define PG8_WAIT_L(n) asm volatile("s_waitcnt lgkmcnt(" #n ")" ::: "memory")
#define PG8_BAR __builtin_amdgcn_s_barrier()
#define PG8_SCHED __builtin_amdgcn_sched_barrier(0)
    Unit cur, nxt; int ui = 0;
    if (!S.next(0, cur)) return;
    f32x4 acc[2][2][4][2];
#pragma unroll
    for (int a = 0; a < 2; ++a)
#pragma unroll
        for (int b = 0; b < 2; ++b)
#pragma unroll
            for (int m = 0; m < 4; ++m)
#pragma unroll
                for (int n = 0; n < 2; ++n) acc[a][b][m][n] = (f32x4){0.f, 0.f, 0.f, 0.f};
    bf16x8 At[4][2], B0[2][2], B1[2][2]; v8i_t At8[4], B08[2], B18[2];
    const char* cA = (const char*)g.A + (size_t)cur.pm * tstep; const char* cB = (const char*)g.Bt + (size_t)cur.pn * tstep;
    S.a_ready(cur);
    if constexpr (SP2) {
        PG8_STAGE(PG8_SB(0, 0), cB, voffB); PG8_STAGE(PG8_SB(0, 1), cB + hstep, voffB); PG8_STAGE(PG8_SA(0, 0), cA, voffA); PG8_STAGE(PG8_SA(0, 1), cA + hstep, voffA);
        if (wr == 1) PG8_BAR;
        PG8_WAIT_V(2); PG8_BAR;
        PG8_STAGE(PG8_SB(1, 0), cB + kstep, voffB); PG8_STAGE(PG8_SA(1, 0), cA + kstep, voffA); PG8_STAGE(PG8_SB(1, 1), cB + hstep + kstep, voffB);
        PG8_WAIT_V(6); PG8_BAR;
    } else {
        PG8_STAGE(PG8_SB(0, 0), cB, voffB); PG8_STAGE(PG8_SA(0, 0), cA, voffA); PG8_STAGE(PG8_SB(0, 1), cB + hstep, voffB); PG8_STAGE(PG8_SA(0, 1), cA + hstep, voffA);
        if (wr == 1) PG8_BAR;
        PG8_WAIT_V(4); PG8_BAR;
        PG8_STAGE(PG8_SB(1, 0), cB + kstep, voffB); PG8_STAGE(PG8_SA(1, 0), cA + kstep, voffA); PG8_STAGE(PG8_SB(1, 1), cB + hstep + kstep, voffB);
        PG8_WAIT_V(6); PG8_BAR;
    }
    for (;;) {
        const bool has_next = S.next(ui + 1, nxt);
        const char* nA = has_next ? (const char*)g.A + (size_t)nxt.pm * tstep : cA; const char* nB = has_next ? (const char*)g.Bt + (size_t)nxt.pn * tstep : cB;
#pragma nounroll
        for (int t = 0; t < nt; t += 2) {
            const bool last = (t == nt - 2);
            const char* a1 = cA + (size_t)(t + 1) * kstep;
            const char* a2 = last ? nA : cA + (size_t)(t + 2) * kstep; const char* b2 = last ? nB : cB + (size_t)(t + 2) * kstep;
            const char* a3 = a2 + kstep; const char* b3 = b2 + kstep;
            if (last && has_next) S.a_ready(nxt);
            if constexpr (SP2) {
            PG8_LDB(B0, 0, 0); PG8_LDB(B1, 0, 1); PG8_SCHED; PG8_LDA(At, 0, 0); PG8_STAGE(PG8_SA(1, 1), a1 + hstep, voffA);
            PG8_WAIT_V(8); PG8_WAIT_L(0); PG8_BAR; PG8_MMA(0, 0, At, B0); PG8_MMA(0, 1, At, B1); PG8_BAR; PG8_SCHED;
            PG8_LDA(At, 0, 1); PG8_STAGE(PG8_SB(0, 0), b2, voffB); PG8_STAGE(PG8_SB(0, 1), b2 + hstep, voffB); PG8_STAGE(PG8_SA(0, 0), a2, voffA);
            PG8_WAIT_V(8); PG8_WAIT_L(0); PG8_BAR; PG8_MMA(1, 0, At, B0); PG8_MMA(1, 1, At, B1); PG8_BAR; PG8_SCHED;
            PG8_LDB(B0, 1, 0); PG8_LDB(B1, 1, 1); PG8_SCHED; PG8_LDA(At, 1, 0); PG8_STAGE(PG8_SA(0, 1), a2 + hstep, voffA);
            PG8_WAIT_V(8); PG8_WAIT_L(0); PG8_BAR; PG8_MMA(0, 0, At, B0); PG8_MMA(0, 1, At, B1); PG8_BAR; PG8_SCHED;
            PG8_LDA(At, 1, 1); PG8_STAGE(PG8_SB(1, 0), b3, voffB); PG8_STAGE(PG8_SB(1, 1), b3 + hstep, voffB); PG8_STAGE(PG8_SA(1, 0), a3, voffA);
            PG8_WAIT_V(8); PG8_WAIT_L(0); PG8_BAR; PG8_MMA(1, 0, At, B0); PG8_MMA(1, 1, At, B1); PG8_BAR; PG8_SCHED;
            } else {
            PG8_LDB(B0, 0, 0); PG8_SCHED; PG8_LDA(At, 0, 0); PG8_STAGE(PG8_SA(1, 1), a1 + hstep, voffA);
            PG8_WAIT_L(8); PG8_BAR; PG8_WAIT_L(0); PG8_MMA(0, 0, At, B0); PG8_BAR; PG8_SCHED;
            PG8_LDB(B1, 0, 1); PG8_STAGE(PG8_SB(0, 0), b2, voffB);
            PG8_BAR; PG8_WAIT_L(0); PG8_MMA(0, 1, At, B1); PG8_BAR;
            PG8_LDA(At, 0, 1); PG8_STAGE(PG8_SA(0, 0), a2, voffA);
            PG8_BAR; PG8_WAIT_L(0); PG8_MMA(1, 0, At, B0); PG8_BAR; PG8_SCHED;
            PG8_STAGE(PG8_SB(0, 1), b2 + hstep, voffB);
            PG8_WAIT_V(6); PG8_BAR; PG8_MMA(1, 1, At, B1); PG8_BAR;
            PG8_LDB(B0, 1, 0); PG8_SCHED; PG8_LDA(At, 1, 0); PG8_STAGE(PG8_SA(0, 1), a2 + hstep, voffA);
            PG8_WAIT_L(8); PG8_BAR; PG8_WAIT_L(0); PG8_MMA(0, 0, At, B0); PG8_BAR; PG8_SCHED;
            PG8_LDB(B1, 1, 1); PG8_STAGE(PG8_SB(1, 0), b3, voffB);
            PG8_BAR; PG8_WAIT_L(0); PG8_MMA(0, 1, At, B1); PG8_BAR;
            PG8_LDA(At, 1, 1); PG8_STAGE(PG8_SA(1, 0), a3, voffA);
            PG8_BAR; PG8_WAIT_L(0); PG8_MMA(1, 0, At, B0); PG8_BAR; PG8_SCHED;
            PG8_STAGE(PG8_SB(1, 1), b3 + hstep, voffB);
            PG8_WAIT_V(6); PG8_BAR; PG8_MMA(1, 1, At, B1); PG8_BAR;
            }
        }
        if constexpr (ALIGN_EPI) { if (wr == 0) PG8_BAR; }
        if constexpr (!Epi::AFTER_DRAIN) { const int l2 = pg8_lane(); E(acc, cur, wr, wc, l2 & 15, l2 >> 4); S.done(cur); }
        if (!has_next) break;
#pragma unroll
        for (int a = 0; a < 2; ++a)
#pragma unroll
            for (int b = 0; b < 2; ++b)
#pragma unroll
                for (int m = 0; m < 4; ++m)
#pragma unroll
                    for (int n = 0; n < 2; ++n) acc[a][b][m][n] = (f32x4){0.f, 0.f, 0.f, 0.f};
        cur = nxt; cA = nA; cB = nB; ++ui;
        if constexpr (ALIGN_EPI) { if (wr == 1) PG8_BAR; }
    }
    PG8_WAIT_V(0);
    if constexpr (!ALIGN_EPI) { if (wr == 0) PG8_BAR; }
    PG8_BAR;
    if constexpr (Epi::AFTER_DRAIN) { E.fused(acc, cur, wr, wc, fr, fq, lds, wid, lane); S.done(cur); }
#undef PG8_SA
#undef PG8_SB
#undef PG8_STAGE
#undef PG8_RS_voffA
#undef PG8_RS_voffB
#undef PG8_BASE_voffA
#undef PG8_BASE_voffB
#undef PG8_LDA
#undef PG8_LDB
#undef PG8_MMA
#undef PG8_WAIT_V
#undef PG8_WAIT_L
#undef PG8_BAR
#undef PG8_SCHED
}
}

constexpr int NWAVES = 8;
constexpr int NTOK = 65536, SEQ = 8192, DM = 1024, DFF = 2816;
constexpr float NORM_EPS = 1e-5f;
constexpr float LOG2E = 1.4426950408889634f;
#ifndef MK_ONE_LAUNCH
#define MK_ONE_LAUNCH 1
#endif
constexpr int NPHASE = 16;

constexpr size_t MiB = 1u << 20;
constexpr size_t WS_CTL = 0, CTL_ZERO_BYTES = 1 * MiB;
constexpr size_t WS_W_GLAIN = 1 * MiB, WS_W_GLAOUT = 8 * MiB, WS_W_QKV = 10 * MiB, WS_W_SWAOUT = 13 * MiB, WS_W_DGU = 15 * MiB, WS_W_DDN = 26 * MiB, WS_W_MGU = 32 * MiB, WS_W_MDN = 120 * MiB;
constexpr size_t WS_HB = 164 * MiB;
constexpr size_t WS_XN = 612 * MiB;
constexpr size_t OUT_XB = 0, OUT_OB = 128 * MiB;
constexpr size_t WS_Q0 = 292 * MiB, WS_K0 = 356 * MiB, WS_V0 = 420 * MiB, WS_R0 = 548 * MiB, WS_LR = 676 * MiB;
constexpr size_t WS_QE = 684 * MiB;
constexpr size_t WS_CC = 940 * MiB;
constexpr size_t WS_OF = WS_Q0, WS_G = WS_V0;
constexpr size_t WS_ACT0 = 292 * MiB;
constexpr size_t WS_Q1 = 292 * MiB, WS_K1 = 420 * MiB, WS_V1 = 452 * MiB, WS_O1 = 484 * MiB;
constexpr size_t WS_XS = 292 * MiB;
constexpr size_t WS_ACT1 = 552 * MiB;
constexpr float XSCALE = 16.f, WSCALE = 64.f, ASCALE = 8.f;
constexpr size_t WS_ROUT = 952 * MiB;
constexpr size_t WS_SEL = WS_ROUT, WS_WSEL = WS_ROUT + 1 * MiB, WS_POSTOK = WS_ROUT + 2 * MiB, WS_ROWW = WS_ROUT + 3 * MiB, WS_WCNT = WS_ROUT + 4 * MiB, WS_META = WS_ROUT + 5 * MiB;
constexpr size_t WS_SSP1 = 960 * MiB, WS_SSP2 = 964 * MiB, WS_SSP3 = 968 * MiB, WS_SS0 = 972 * MiB;
constexpr size_t WS_END = 1024 * MiB;
static_assert(WS_W_MDN + (size_t)8 * 1024 * 2816 * 2 <= WS_HB && WS_CC + (size_t)2 * 8 * 128 * 1536 * 4 <= WS_ROUT && WS_ACT0 + (size_t)NTOK * DFF * 2 <= WS_QE + 4 * 64 * MiB, "ws map");
static_assert(WS_ACT1 + (size_t)133120 * DFF <= WS_ROUT && WS_XS + (size_t)133120 * 1024 * 2 <= WS_ACT1, "ws map 2");
constexpr int CW_TMO = 0, CW_BAR = 4096;

constexpr int RING_OFF = 0, RING_BYTES = 131072;
constexpr int LDS_BYTES = 163840;
constexpr int LDSCTL_OFF = LDS_BYTES - 1024, MISC_OFF = LDSCTL_OFF + 320;
constexpr int UL_OFF = RING_BYTES + 15616;
constexpr int TB_OFF = RING_BYTES + 16896;
static_assert(UL_OFF + 128 * 8 + 8 <= TB_OFF && TB_OFF + 128 <= LDSCTL_OFF, "LDS map");
constexpr int AUX_OFF = RING_BYTES;

#define GAS __attribute__((address_space(1)))
#define LAS __attribute__((address_space(3)))
typedef unsigned short bf16;
typedef unsigned v4u __attribute__((ext_vector_type(4)));
typedef float f32x4 __attribute__((ext_vector_type(4)));
typedef short bf16x8 __attribute__((ext_vector_type(8)));
typedef GAS unsigned gu32;
typedef GAS unsigned long long gu64;
#define RLX_AGENT __ATOMIC_RELAXED, __HIP_MEMORY_SCOPE_AGENT
#define LDS_WAIT() asm volatile("s_waitcnt lgkmcnt(0)" ::: "memory")
#define VM_WAIT() asm volatile("s_waitcnt vmcnt(0)" ::: "memory")
__device__ __forceinline__ unsigned long long rt() { return __builtin_amdgcn_s_memrealtime(); }
__device__ __forceinline__ unsigned f2bf(float f) { unsigned u = __builtin_bit_cast(unsigned, f); return (u + 0x7fffu + ((u >> 16) & 1u)) >> 16; }
__device__ __forceinline__ unsigned pk2(float lo, float hi) { return f2bf(lo) | (f2bf(hi) << 16); }

#define XB_TMO      128
#define XB_XCNT(j)  (256  + 64 * (j))
#define XB_XSUB(j)  (1280 + 64 * (j))
#define XB_XGEN(j)  (2304 + 64 * (j))
#define XB_TOP      3328
#define XB_TOPGEN   3392
#define XCD_BAR_WORDS 3456
#define XB_SPIN_CAP (1u << 18)

__device__ __forceinline__ unsigned xb_ld(unsigned* p)              { return __hip_atomic_load(p, __ATOMIC_RELAXED, __HIP_MEMORY_SCOPE_AGENT); }
__device__ __forceinline__ unsigned xb_add(unsigned* p, unsigned v) { return __hip_atomic_fetch_add(p, v, __ATOMIC_RELAXED, __HIP_MEMORY_SCOPE_AGENT); }
__device__ __forceinline__ unsigned xb_xcc_id() { return (unsigned)__builtin_amdgcn_s_getreg((3 << 11) | 20) & 0xFu; }
#define XB_SPIN(cond, bar) do { unsigned _sp = 0; while (cond) { __builtin_amdgcn_s_sleep(1); \
    if ((++_sp & 255u) == 0u) { if (xb_ld(&(bar)[XB_TMO])) break; if (_sp > XB_SPIN_CAP) { atomicAdd(&(bar)[XB_TMO], 1u); break; } } } } while (0)

struct XcdBarrier {
    unsigned* bar; unsigned x;
    volatile LAS unsigned* st;
    unsigned t0;
};

__device__ __forceinline__ XcdBarrier xcd_barrier_post(unsigned* bar, volatile LAS unsigned* st, unsigned t0) {
    XcdBarrier b; b.bar = bar; b.x = xb_xcc_id(); b.st = st; b.t0 = t0;
    if (t0) (void)xb_add(&bar[XB_XCNT(b.x)], 1u);
    return b;
}
__device__ __forceinline__ void xcd_barrier_complete(unsigned* bar, unsigned x, unsigned& nloc, unsigned& nx) {
    const unsigned G = gridDim.x * gridDim.y * gridDim.z;
    unsigned sum, cnt, mine, sp = 0u;
    for (;;) {
        sum = 0u; cnt = 0u; mine = 0u;
#pragma unroll
        for (unsigned j = 0; j < 16; ++j) { const unsigned c = xb_ld(&bar[XB_XCNT(j)]); sum += c; cnt += (c > 0u) ? 1u : 0u; mine = (j == x) ? c : mine; }
        if (sum == G) break;
        __builtin_amdgcn_s_sleep(1);
        if ((++sp & 255u) == 0u) { if (xb_ld(&bar[XB_TMO])) break; if (sp > XB_SPIN_CAP) { atomicAdd(&bar[XB_TMO], 1u); break; } }
    }
    nloc = mine > 0u ? mine : 1u; nx = cnt > 0u ? cnt : 1u;
}

__device__ __forceinline__ void xcd_barrier(const XcdBarrier& b) {
    asm volatile("s_waitcnt vmcnt(0)" ::: "memory");
    __syncthreads();
    if (b.t0) {
        unsigned* bar = b.bar;
        __builtin_amdgcn_s_waitcnt(0);
        unsigned nloc = b.st[0], nx = b.st[1];
        if (nloc == 0u) { xcd_barrier_complete(bar, b.x, nloc, nx); b.st[0] = nloc; b.st[1] = nx; }
        const unsigned old = xb_add(&bar[XB_XSUB(b.x)], 1u);
        const unsigned gen = old / nloc;
        if (old + 1u == (gen + 1u) * nloc) {
            __builtin_amdgcn_fence(__ATOMIC_RELEASE, "agent");
            asm volatile("s_waitcnt vmcnt(0)" ::: "memory");
            const unsigned og = xb_add(&bar[XB_TOP], 1u);
            const unsigned tg = og / nx;
            if (og + 1u == (tg + 1u) * nx) xb_add(&bar[XB_TOPGEN], 1u);
            else XB_SPIN(xb_ld(&bar[XB_TOPGEN]) == tg, bar);
            __builtin_amdgcn_fence(__ATOMIC_ACQUIRE, "agent");
            xb_add(&bar[XB_XGEN(b.x)], 1u);
            asm volatile("s_waitcnt vmcnt(0)" ::: "memory");
        } else {
            XB_SPIN(xb_ld(&bar[XB_XGEN(b.x)]) == gen, bar);
            __builtin_amdgcn_fence(__ATOMIC_ACQUIRE, "agent");
            asm volatile("s_waitcnt vmcnt(0)" ::: "memory");
        }
    }
    __syncthreads();
}
typedef unsigned u32x4 __attribute__((ext_vector_type(4)));

typedef unsigned u32x2 __attribute__((ext_vector_type(2)));
typedef short s16x4 __attribute__((ext_vector_type(4)));
struct Frame {
    LAS unsigned char* lds;
    volatile LAS unsigned* MISC;
    int wave;
    int vcu, G;
    float* out; unsigned char* ws;
    const float* const* in;
};
__device__ __forceinline__ int lane_id() { return pg8::pg8_lane(); }
__device__ __forceinline__ float bf_lo(unsigned u) { return __uint_as_float(u << 16); }
__device__ __forceinline__ float bf_hi(unsigned u) { return __uint_as_float(u & 0xffff0000u); }
typedef float f32x2_t __attribute__((ext_vector_type(2))); typedef __bf16 bf16x2_t __attribute__((ext_vector_type(2)));
__device__ __forceinline__ unsigned cvtpk(float lo, float hi) { f32x2_t v = {lo, hi}; bf16x2_t b = __builtin_convertvector(v, bf16x2_t); return __builtin_bit_cast(unsigned, b); }
__device__ __forceinline__ float wave_sum(float v) {
#pragma unroll
    for (int o = 1; o < 64; o <<= 1) v += __shfl_xor(v, o);
    return v;
}
__device__ __forceinline__ int wave_sum_i(int v) {
#pragma unroll
    for (int o = 1; o < 64; o <<= 1) v += __shfl_xor(v, o);
    return v;
}
#define LBAR() do { asm volatile("s_waitcnt lgkmcnt(0)" ::: "memory"); __builtin_amdgcn_s_barrier(); asm volatile("" ::: "memory"); } while (0)
__device__ __forceinline__ f32x4 mfma16(bf16x8 a, bf16x8 b, f32x4 c) { return __builtin_amdgcn_mfma_f32_16x16x32_bf16(a, b, c, 0, 0, 0); }
typedef short v4i16_t __attribute__((ext_vector_type(4)));
__device__ __forceinline__ s16x4 ldtr(const LAS unsigned char* p) { return __builtin_bit_cast(s16x4, __builtin_amdgcn_ds_read_tr16_b64_v4i16((LAS v4i16_t*)p)); }
__device__ __forceinline__ bf16x8 cat8(s16x4 lo, s16x4 hi) { return (bf16x8){lo[0], lo[1], lo[2], lo[3], hi[0], hi[1], hi[2], hi[3]}; }

__device__ __forceinline__ void conv_item(const float* W, int K, int N, bf16* WT, int drow0, int k0, int n0, LAS float* scr, int lane, const float* gain) {
    const float* gp = gain ? gain : W;
    float wv[32], gv[32];
#pragma unroll
    for (int i = 0; i < 32; ++i) { const int kk = 2 * i + (lane >> 5); wv[i] = W[(size_t)(k0 + kk) * N + n0 + (lane & 31)]; gv[i] = gp[k0 + kk]; }
#pragma unroll
    for (int i = 0; i < 32; ++i) { const int kk = 2 * i + (lane >> 5); scr[kk * 33 + (lane & 31)] = wv[i] * (gain ? gv[i] : 1.0f); }
    LDS_WAIT(); asm volatile("" ::: "memory");
    const int c = lane & 7;
#pragma unroll
    for (int j = 0; j < 4; ++j) { const int n = (lane >> 3) + 8 * j; const LAS float* s = scr + (8 * c) * 33 + n;
        v4u o; o.x = pk2(s[0 * 33], s[1 * 33]); o.y = pk2(s[2 * 33], s[3 * 33]); o.z = pk2(s[4 * 33], s[5 * 33]); o.w = pk2(s[6 * 33], s[7 * 33]);
        *(GAS v4u*)(WT + (size_t)(drow0 + n) * K + k0 + 8 * c) = o; }
    LDS_WAIT(); asm volatile("" ::: "memory");
}
__device__ __forceinline__ unsigned pk4f8(float a, float b, float c, float d) { unsigned r = 0u; r = __builtin_amdgcn_cvt_pk_fp8_f32(a, b, r, false); r = __builtin_amdgcn_cvt_pk_fp8_f32(c, d, r, true); return r; }
__device__ __forceinline__ void conv_item8(const float* W, int K, int N, unsigned char* WT, int drow0, int k0, int n0, LAS float* scr, int lane, float scale) {
#pragma unroll 64
    for (int i = 0; i < 64; ++i) scr[i * 65 + lane] = W[(size_t)(k0 + i) * N + n0 + lane] * scale;
    LDS_WAIT(); asm volatile("" ::: "memory");
    const int c = lane & 3;
#pragma unroll
    for (int j = 0; j < 4; ++j) { const int n = (lane >> 2) + 16 * j; const LAS float* s = scr + (16 * c) * 65 + n;
        v4u o; o.x = pk4f8(s[0 * 65], s[1 * 65], s[2 * 65], s[3 * 65]); o.y = pk4f8(s[4 * 65], s[5 * 65], s[6 * 65], s[7 * 65]); o.z = pk4f8(s[8 * 65], s[9 * 65], s[10 * 65], s[11 * 65]); o.w = pk4f8(s[12 * 65], s[13 * 65], s[14 * 65], s[15 * 65]);
        *(GAS v4u*)(WT + (size_t)(drow0 + n) * K + k0 + 16 * c) = o; }
    LDS_WAIT(); asm volatile("" ::: "memory");
}
constexpr int IT_GLAIN = 16 * 97, IT_SQ = 16 * 32, IT_QKV = 16 * 48, IT_FF = 1408, IT_FF8 = 704;
#ifndef MK_DDN_FP8
#define MK_DDN_FP8 1
#endif
constexpr int N_FF16 = MK_DDN_FP8 ? 2 : 3, N_FF8 = MK_DDN_FP8 ? 25 : 24;
constexpr int NITEMS = IT_GLAIN + 2 * IT_SQ + IT_QKV + N_FF16 * IT_FF + N_FF8 * IT_FF8;
__device__ __forceinline__ void p0_weights(Frame& F, const float* gla_in, const float* gla_out, const float* swa_qkv, const float* swa_out, const float* d_gate, const float* d_up, const float* d_down, const float* m_gate, const float* m_up, const float* m_down, const float* g_mix0, const float* g_ffn0, const float* g_mix1) {
    LAS float* scr = (LAS float*)(F.lds + F.wave * 16640);
    const int gw = F.vcu * NWAVES + F.wave, NGW = F.G * NWAVES, lane = lane_id();
    for (int it = gw; it < NITEMS; it += NGW) {
        int r = it; const float* W; int K = 1024, N; bf16* WT; int mode = 0; bool f8 = false; const float* gain = nullptr;
        if (r < IT_GLAIN) { W = gla_in; N = 3104; WT = (bf16*)(F.ws + WS_W_GLAIN); gain = g_mix0; }
        else if ((r -= IT_GLAIN) < IT_SQ) { W = gla_out; N = 1024; WT = (bf16*)(F.ws + WS_W_GLAOUT); }
        else if ((r -= IT_SQ) < IT_QKV) { W = swa_qkv; N = 1536; WT = (bf16*)(F.ws + WS_W_QKV); gain = g_mix1; }
        else if ((r -= IT_QKV) < IT_SQ) { W = swa_out; N = 1024; WT = (bf16*)(F.ws + WS_W_SWAOUT); }
        else { r -= IT_SQ; int j;
            if (r < N_FF16 * IT_FF) { j = r / IT_FF; r -= j * IT_FF; } else { r -= N_FF16 * IT_FF; const int j8 = r / IT_FF8; r -= j8 * IT_FF8; j = N_FF16 + j8; }
            int kind, e; if (j < 3) { kind = j; e = 0; } else { kind = (j - 3) >> 3; e = (j - 3) & 7; }
            const bool moe = j >= 3;
            f8 = j >= N_FF16;
            if (kind == 2) { W = (moe ? m_down : d_down) + (size_t)e * DFF * 1024; K = DFF; N = 1024; WT = moe ? (bf16*)(F.ws + WS_W_MDN + (size_t)e * 1024 * DFF) : (bf16*)(F.ws + WS_W_DDN); }
            else { W = (kind == 0 ? (moe ? m_gate : d_gate) : (moe ? m_up : d_up)) + (size_t)e * 1024 * DFF; N = DFF; WT = moe ? (bf16*)(F.ws + WS_W_MGU + (size_t)e * 5632 * 1024) : (bf16*)(F.ws + WS_W_DGU); mode = 1 + kind; gain = moe ? nullptr : g_ffn0; }
        }
        const int nsh = f8 ? 6 : 5, nblk = N >> nsh, kb = r / nblk, nb = r - kb * nblk, n0 = nb << nsh;
        const int drow0 = (mode == 0) ? n0 : (((n0 >> 7) << 8) + (n0 & 127) + (mode == 2 ? 128 : 0));
        if (f8) conv_item8(W, K, N, (unsigned char*)WT, drow0, kb * 64, n0, scr, lane, WSCALE);
        else conv_item(W, K, N, WT, drow0, kb * 64, n0, scr, lane, gain);
    }
}
constexpr int CR_PITCH = 2064;
static_assert(32 * CR_PITCH <= RING_BYTES, "convert_rows LDS");
__device__ __forceinline__ void convert_rows(Frame& F, const float* src, bf16* dst, float* ss, const float* Win, const float* gain, float* LR) {
    const int gw = F.vcu * NWAVES + F.wave, NGW = F.G * NWAVES, lane = lane_id(), r16 = lane & 15, g4 = lane >> 4, tid = F.wave * 64 + lane;
    LAS unsigned char* wl = F.lds;
    LBAR();
#pragma unroll 1
    for (int k = tid; k < DM; k += NWAVES * 64) { const GAS f32x4* wp = (const GAS f32x4*)(Win + (size_t)k * 3104 + 3072); const float gk = gain[k];
#pragma unroll
        for (int j = 0; j < 8; ++j) { const f32x4 w4 = wp[j];
#pragma unroll
            for (int e = 0; e < 4; ++e) *(LAS unsigned short*)(wl + (4 * j + e) * CR_PITCH + k * 2) = (unsigned short)(cvtpk(w4[e] * gk, 0.f) & 0xffffu); } }
    LBAR();
    for (int rg = gw; rg < NTOK / 16; rg += NGW) {
        const size_t row = (size_t)rg * 16 + r16;
        const GAS f32x4* xr = (const GAS f32x4*)(src + row * DM + 8 * g4); GAS v4u* orow = (GAS v4u*)(dst + row * DM + 8 * g4);
        f32x4 acc0 = (f32x4){0.f, 0.f, 0.f, 0.f}, acc1 = acc0; float s = 0.f;
#pragma unroll 1
        for (int kb = 0; kb < 32; kb += 8) {
            f32x4 v[8][2];
#pragma unroll
            for (int j = 0; j < 8; ++j) { v[j][0] = xr[(kb + j) * 8]; v[j][1] = xr[(kb + j) * 8 + 1]; }
#pragma unroll
            for (int j = 0; j < 8; ++j) { const int ks = kb + j; const f32x4 a = v[j][0], c = v[j][1];
                s += ((a.x * a.x + a.y * a.y) + (a.z * a.z + a.w * a.w)) + ((c.x * c.x + c.y * c.y) + (c.z * c.z + c.w * c.w));
                const v4u pk = (v4u){cvtpk(a.x, a.y), cvtpk(a.z, a.w), cvtpk(c.x, c.y), cvtpk(c.z, c.w)};
                orow[ks * 4] = pk;
                const bf16x8 af = __builtin_bit_cast(bf16x8, pk);
                const bf16x8 b0 = *(const LAS bf16x8*)(wl + r16 * CR_PITCH + (32 * ks + 8 * g4) * 2), b1 = *(const LAS bf16x8*)(wl + (16 + r16) * CR_PITCH + (32 * ks + 8 * g4) * 2);
                acc0 = mfma16(af, b0, acc0); acc1 = mfma16(af, b1, acc1); }
        }
        s += __shfl_xor(s, 16); s += __shfl_xor(s, 32);
        const float rs = 1.0f / sqrtf(s * (1.f / DM) + NORM_EPS);
        if (g4 == 0) ss[row] = rs;
#pragma unroll
        for (int r = 0; r < 4; ++r) { const float rr = __shfl(rs, 4 * g4 + r); float* lp = LR + ((size_t)rg * 16 + 4 * g4 + r) * 32 + r16; lp[0] = acc0[r] * rr; lp[16] = acc1[r] * rr; }
    }
}

__device__ __forceinline__ float logsig16(float z) { const float e = __expf(-fabsf(z)); return (fminf(z, 0.f) - __logf(1.f + e)) * 0.0625f; }
constexpr int GP_Q = 0, GP_K = 65536, GP_LR = 131072, GP_X0 = GP_LR + 8192, GP_X1 = GP_X0 + 2048;
static_assert(GP_X1 + 4096 <= LDSCTL_OFF, "gla prep LDS");
__device__ __forceinline__ void gla_prep(Frame& F) {
    typedef float f32x2 __attribute__((ext_vector_type(2)));
    LAS unsigned char* L = F.lds;
    LAS float* lrs = (LAS float*)(L + GP_LR);
    LAS f32x2* xch0 = (LAS f32x2*)(L + GP_X0);
    LAS f32x4* xch1 = (LAS f32x4*)(L + GP_X1);
    LAS unsigned* tq = (LAS unsigned*)(L + GP_Q); LAS unsigned* tk = (LAS unsigned*)(L + GP_K);
    const int lane = lane_id(), tid = F.wave * 64 + lane, ph = tid >> 8, cp = tid & 255, col = 2 * cp;
    const bf16* Q0 = (const bf16*)(F.ws + WS_Q0); const bf16* K0 = (const bf16*)(F.ws + WS_K0); const float* LR = (const float*)(F.ws + WS_LR);
    float* CC = (float*)(F.ws + WS_CC);
    f32x2 wgv[16]; f32x2 bgv = (f32x2){0.f, 0.f}; int cur_dir = -1;
#pragma unroll
    for (int r = 0; r < 16; ++r) wgv[r] = (f32x2){0.f, 0.f};
    for (int u = F.vcu; u < 2048; u += F.G) {
        const int b = u >> 8, n = (u >> 1) & 127, dir = u & 1; const size_t row0 = (size_t)b * SEQ + 64 * n;
        bf16* QEd = (bf16*)(F.ws + WS_QE) + (size_t)dir * 2 * NTOK * 512; bf16* KEd = QEd + (size_t)NTOK * 512;
        if (dir != cur_dir) {
            const float* wg = dir ? F.in[6] : F.in[4]; const float* bg = dir ? F.in[7] : F.in[5]; cur_dir = dir;
#pragma unroll
            for (int r = 0; r < 16; ++r) wgv[r] = *(const f32x2*)(wg + r * 512 + col);
            bgv = *(const f32x2*)(bg + col);
            asm volatile("s_waitcnt vmcnt(0)" ::: "memory");
        }
        const f32x4 lrn = *(const f32x4*)(LR + row0 * 32 + tid * 4);
        LBAR();
        *(LAS f32x4*)(lrs + tid * 4) = lrn;
#pragma unroll
        for (int i = 0; i < 8; ++i) {
            __builtin_amdgcn_global_load_lds((const unsigned*)((const char*)(Q0 + row0 * 512) + (i * 8 + F.wave) * 1024 + lane * 16), (LAS unsigned*)(L + GP_Q + (i * 8 + F.wave) * 1024), 16, 0, 0);
            __builtin_amdgcn_global_load_lds((const unsigned*)((const char*)(K0 + row0 * 512) + (i * 8 + F.wave) * 1024 + lane * 16), (LAS unsigned*)(L + GP_K + (i * 8 + F.wave) * 1024), 16, 0, 0); }
        LBAR();
        float bc0[32], bc1[32]; float run0 = 0.f, run1 = 0.f;
#pragma unroll
        for (int i = 0; i < 32; ++i) { const int p = 32 * ph + i; const int tok = dir ? 63 - p : p; const LAS float* lp = lrs + tok * 32 + dir * 16;
            f32x2 z = bgv;
#pragma unroll
            for (int r4 = 0; r4 < 4; ++r4) { const f32x4 l4 = *(const LAS f32x4*)(lp + 4 * r4);
#pragma unroll
                for (int k = 0; k < 4; ++k) z = __builtin_elementwise_fma((f32x2){l4[k], l4[k]}, wgv[4 * r4 + k], z); }
            run0 += logsig16(z.x); run1 += logsig16(z.y); bc0[i] = run0; bc1[i] = run1; }
        if (ph == 0) xch0[cp] = (f32x2){run0, run1};
        LBAR();
        if (ph == 1) { const f32x2 add = xch0[cp];
#pragma unroll
            for (int i = 0; i < 32; ++i) { bc0[i] += add.x; bc1[i] += add.y; }
            xch1[cp] = (f32x4){bc0[31], bc1[31], bc0[31], bc1[31]}; }
        asm volatile("s_waitcnt vmcnt(0)" ::: "memory");
        LBAR();
        const f32x4 rl = xch1[cp]; const float br0 = rl[0], br1 = rl[1], bl0 = rl[2], bl1 = rl[3];
#pragma unroll
        for (int i = 0; i < 32; ++i) { const int p = 32 * ph + i; const int tok = dir ? 63 - p : p;
            const unsigned q2 = tq[tok * 256 + cp], k2 = tk[tok * 256 + cp];
            const float e0 = __expf(bc0[i] - br0), e1 = __expf(bc1[i] - br1), i0 = __builtin_amdgcn_rcpf(e0), i1 = __builtin_amdgcn_rcpf(e1);
            tq[tok * 256 + cp] = cvtpk(bf_lo(q2) * e0, bf_hi(q2) * e1);
            tk[tok * 256 + cp] = cvtpk(bf_lo(k2) * i0, bf_hi(k2) * i1); }
        if (ph == 0) { const int c = dir ? 127 - n : n; float* rec = CC + ((size_t)(dir * 8 + b) * 128 + c) * 512;
            if (c >= 1) *(f32x2*)(rec - 512 + col) = (f32x2){__expf(bl0), __expf(bl1)}; }
        LBAR();
#pragma unroll
        for (int i = 0; i < 8; ++i) { const int off = (i * 512 + tid) * 16;
            *(v4u*)((char*)(QEd + row0 * 512) + off) = *(const LAS v4u*)(L + GP_Q + off); *(v4u*)((char*)(KEd + row0 * 512) + off) = *(const LAS v4u*)(L + GP_K + off); }
    }
}

constexpr int GS_QE = 0, GS_KE = 17408, GS_V = 34816, GS_CC = 44032, GS_BUF = 45568, GS_P = 3 * GS_BUF, GS_PB = 9216;
static_assert(GS_P + 2 * GS_PB <= LDSCTL_OFF, "gla scan LDS");
__device__ __forceinline__ void gla_scan(Frame& F) {
    const int lane = lane_id(), tid = F.wave * 64 + lane, w = F.wave, r16 = lane & 15, g4 = lane >> 4;
    LAS unsigned char* L = F.lds;
    const bf16* V0 = (const bf16*)(F.ws + WS_V0);
    for (int unit = F.vcu; unit < 256; unit += F.G) {
        const int combo = unit >> 2, dvq = unit & 3, dir = combo & 1, h = (combo >> 1) & 3, b = combo >> 3;
        const bf16* QEg = (const bf16*)(F.ws + WS_QE) + (size_t)dir * 2 * NTOK * 512; const bf16* KEg = QEg + (size_t)NTOK * 512;
        const float* CCg = (const float*)(F.ws + WS_CC) + (size_t)(dir * 8 + b) * 128 * 512;
        bf16* Og = dir ? (bf16*)((unsigned char*)F.out + OUT_OB) : (bf16*)(F.ws + WS_OF);
        v4u rqA[4], rkA[4], rvA[2], rcA, rqB[4], rkB[4], rvB[2], rcB;
        const int st = tid & 255, sqrow = st >> 4, sqch = st & 15, svrow = st >> 3, svch = st & 7, sct = st & 31;
        const long tstride = dir ? -64 : 64;
        const bf16* pQ = QEg + ((size_t)b * SEQ + (dir ? 127 * 64 : 0) + sqrow) * 512 + h * 128 + sqch * 8; const bf16* pK = pQ + (size_t)NTOK * 512;
        const bf16* pV = V0 + ((size_t)b * SEQ + (dir ? 127 * 64 : 0) + svrow) * 1024 + h * 256 + dvq * 64 + svch * 8;
        const float* pC = CCg + h * 128 + sct * 4;
#define GS_LOAD(c_, X) do { _Pragma("unroll") for (int k_ = 0; k_ < 4; ++k_) { rq##X[k_] = *(const v4u*)(pQ + k_ * 16 * 512); rk##X[k_] = *(const v4u*)(pK + k_ * 16 * 512); } \
        rv##X[0] = *(const v4u*)pV; rv##X[1] = *(const v4u*)(pV + 32 * 1024); rc##X = *(const v4u*)pC; \
        pQ += tstride * 512; pK += tstride * 512; pV += tstride * 1024; pC += 512; } while (0)
#define GS_STORE(buf_, X) do { LAS unsigned char* B_ = L + (buf_) * GS_BUF; \
        _Pragma("unroll") for (int k_ = 0; k_ < 4; ++k_) { *(LAS v4u*)(B_ + GS_QE + (sqrow + 16 * k_) * 272 + sqch * 16) = rq##X[k_]; *(LAS v4u*)(B_ + GS_KE + (sqrow + 16 * k_) * 272 + sqch * 16) = rk##X[k_]; } \
        *(LAS v4u*)(B_ + GS_V + svrow * 144 + svch * 16) = rv##X[0]; *(LAS v4u*)(B_ + GS_V + (svrow + 32) * 144 + svch * 16) = rv##X[1]; \
        if (st < 32) *(LAS v4u*)(B_ + GS_CC + st * 16) = rc##X; } while (0)
        int sit[3], sjt[3];
        { const int s2 = 2 * (w & 3); const int i0 = (123 >> s2) & 3, i1 = (27 >> s2) & 3, j0 = (48 >> s2) & 3, j1 = (21 >> s2) & 3, j2 = (26 >> s2) & 3;
          sit[0] = dir ? 3 - i0 : i0; sit[1] = dir ? 3 - i1 : i1; sit[2] = sit[1]; sjt[0] = dir ? 3 - j0 : j0; sjt[1] = dir ? 3 - j1 : j1; sjt[2] = dir ? 3 - j2 : j2; }
        bool skeep[4];
#pragma unroll
        for (int r = 0; r < 4; ++r) { const int j_ = 4 * g4 + r; skeep[r] = dir ? (j_ > r16) : (j_ <= r16); }
#define GS_SCORES(tb_, pb_) do { const LAS unsigned char* B_ = L + (tb_) * GS_BUF; LAS unsigned char* P_ = L + GS_P + (pb_) * GS_PB; \
        bf16x8 qf_[2][4], kf_[3][4];                                         \
        _Pragma("unroll") for (int k_ = 0; k_ < 3; ++k_) _Pragma("unroll") for (int ks = 0; ks < 4; ++ks) { \
            if (k_ < 2) qf_[k_][ks] = *(const LAS bf16x8*)(B_ + GS_QE + (16 * sit[k_] + r16) * 272 + ks * 64 + g4 * 16); kf_[k_][ks] = *(const LAS bf16x8*)(B_ + GS_KE + (16 * sjt[k_] + r16) * 272 + ks * 64 + g4 * 16); } \
        __builtin_amdgcn_sched_barrier(0); \
        f32x4 pa_[3]; \
        _Pragma("unroll") for (int k_ = 0; k_ < 3; ++k_) { pa_[k_] = (f32x4){0.f, 0.f, 0.f, 0.f}; _Pragma("unroll") for (int ks = 0; ks < 4; ++ks) pa_[k_] = mfma16(kf_[k_][ks], qf_[k_ < 2 ? k_ : 1][ks], pa_[k_]); } \
        _Pragma("unroll") for (int k_ = 0; k_ < 3; ++k_) { const bool diag_ = sit[k_] == sjt[k_]; \
            _Pragma("unroll") for (int r = 0; r < 4; ++r) pa_[k_][r] = (diag_ && !skeep[r]) ? 0.f : pa_[k_][r]; \
            *(LAS u32x2*)(P_ + (16 * sit[k_] + r16) * 144 + (16 * sjt[k_] + 4 * g4) * 2) = (u32x2){cvtpk(pa_[k_][0], pa_[k_][1]), cvtpk(pa_[k_][2], pa_[k_][3])}; } } while (0)
        LBAR();
#define GS_STEP_SCORE(cc, XS, XL) do { const int c = (cc); const int tbn = (c + 1) % 3, tbw = (c + 2) % 3, pb = c & 1; \
            GS_LOAD(c + 3, XL); if (c + 1 < 128) GS_SCORES(tbn, pb ^ 1); GS_STORE(tbw, XS); LBAR(); } while (0)
#define GS_STEP_STATE(cc) do { const int c = (cc); const int tb = c % 3, pb = c & 1; \
            const LAS unsigned char* B = L + tb * GS_BUF; const LAS unsigned char* P = L + GS_P + pb * GS_PB; \
            const int orig = dir ? 127 - c : c; const size_t row0 = (size_t)b * SEQ + 64 * orig; \
              \
            bf16x8 vf[2]; u32x4 qe[2][2][4]; bf16x8 pf[2][2][2]; bf16x8 kt[2][2][2]; f32x4 decn[2][2]; \
_Pragma("unroll")             for (int kk = 0; kk < 2; ++kk) { const LAS unsigned char* a = B + GS_V + (32 * kk + 8 * g4 + (r16 >> 2)) * 144 + (16 * w + 4 * (r16 & 3)) * 2; vf[kk] = cat8(ldtr(a), ldtr(a + 4 * 144)); } \
            GS_RD_A(0); GS_RD_A(1); GS_RD_B(0, 0); \
            __builtin_amdgcn_sched_barrier(0); \
            GS_CMP_A(0); __builtin_amdgcn_sched_barrier(0); \
            GS_CMP_A(1); __builtin_amdgcn_sched_barrier(0); \
            GS_RD_B(1, 1); __builtin_amdgcn_sched_barrier(0); GS_CMP_B(0, 0); __builtin_amdgcn_sched_barrier(0); \
            GS_RD_B(2, 0); __builtin_amdgcn_sched_barrier(0); GS_CMP_B(1, 1); __builtin_amdgcn_sched_barrier(0); \
            GS_RD_B(3, 1); __builtin_amdgcn_sched_barrier(0); GS_CMP_B(2, 0); __builtin_amdgcn_sched_barrier(0); \
            GS_CMP_B(3, 1); \
            LBAR(); } while (0)
#define GS_RD_A(ih) do { _Pragma("unroll") for (int i2 = 0; i2 < 2; ++i2) { const int it = 2 * (ih) + i2; \
_Pragma("unroll")                 for (int ks = 0; ks < 4; ++ks) { const LAS unsigned char* qa = B + GS_QE + (16 * it + r16) * 272 + (32 * ks + 4 * g4) * 2; \
                    const u32x2 q0 = *(const LAS u32x2*)qa, q1 = *(const LAS u32x2*)(qa + 32); qe[ih][i2][ks] = (u32x4){q0.x, q0.y, q1.x, q1.y}; } \
_Pragma("unroll")                 for (int kk = 0; kk < 2; ++kk) pf[ih][i2][kk] = *(const LAS bf16x8*)(P + (16 * it + r16) * 144 + (32 * kk + 8 * g4) * 2); } } while (0)
#define GS_CMP_A(ih) do { _Pragma("unroll") for (int i2 = 0; i2 < 2; ++i2) { const int it = 2 * (ih) + i2; f32x4 o = (f32x4){0.f, 0.f, 0.f, 0.f}; \
_Pragma("unroll")                 for (int ks = 0; ks < 4; ++ks) o = mfma16(sbf[ks], __builtin_bit_cast(bf16x8, qe[ih][i2][ks]), o); \
_Pragma("unroll")                 for (int kk = 0; kk < 2; ++kk) o = mfma16(vf[kk], pf[ih][i2][kk], o); \
                { u32x2* op_ = (u32x2*)(Og + (row0 + 16 * it + r16) * 1024 + h * 256 + dvq * 64 + 16 * w + 4 * g4); const u32x2 ov_ = (u32x2){cvtpk(o[0], o[1]), cvtpk(o[2], o[3])}; *op_ = ov_; } } } while (0)
#define GS_RD_B(ks, s_) do { _Pragma("unroll") for (int d = 0; d < 2; ++d) { const int dkt = 2 * (ks) + d; \
_Pragma("unroll")                 for (int kk = 0; kk < 2; ++kk) { const LAS unsigned char* a = B + GS_KE + (32 * kk + 8 * g4 + (r16 >> 2)) * 272 + (16 * dkt + 4 * (r16 & 3)) * 2; kt[s_][d][kk] = cat8(ldtr(a), ldtr(a + 4 * 272)); } \
                decn[s_][d] = *(const LAS f32x4*)(B + GS_CC + (16 * dkt + 4 * g4) * 4); } } while (0)
#define GS_CMP_B(ks, s_) do { u32x2 sw[2]; \
_Pragma("unroll")             for (int d = 0; d < 2; ++d) { const int dkt = 2 * (ks) + d; f32x4 ua = (f32x4){0.f, 0.f, 0.f, 0.f}; \
_Pragma("unroll")                 for (int kk = 0; kk < 2; ++kk) ua = mfma16(kt[s_][d][kk], vf[kk], ua); \
                sacc[dkt] = (sacc[dkt] + ua) * decn[s_][d]; \
                const f32x4 sb = sacc[dkt]; sw[d] = (u32x2){cvtpk(sb[0], sb[1]), cvtpk(sb[2], sb[3])}; } \
            sbf[ks] = __builtin_bit_cast(bf16x8, (u32x4){sw[0].x, sw[0].y, sw[1].x, sw[1].y}); } while (0)
        if (w >= 4) {
            GS_LOAD(0, A); GS_LOAD(1, B);
            for (int o = st * 16; o < 2 * GS_PB; o += 4096) *(LAS v4u*)(L + GS_P + o) = (v4u){0u, 0u, 0u, 0u};
            GS_STORE(0, A); GS_STORE(1, B); GS_LOAD(2, A);
            LBAR();
            GS_SCORES(0, 0);
            LBAR();
            for (int c2 = 0; c2 < 128; c2 += 2) { GS_STEP_SCORE(c2, A, B); GS_STEP_SCORE(c2 + 1, B, A); }
        } else {
            f32x4 sacc[8]; bf16x8 sbf[4];
#pragma unroll
            for (int d = 0; d < 8; ++d) sacc[d] = (f32x4){0.f, 0.f, 0.f, 0.f};
#pragma unroll
            for (int ks = 0; ks < 4; ++ks) sbf[ks] = (bf16x8){0, 0, 0, 0, 0, 0, 0, 0};
            LBAR();
            LBAR();
            for (int c2 = 0; c2 < 128; ++c2) GS_STEP_STATE(c2);
        }
#undef GS_STEP_SCORE
#undef GS_STEP_STATE
#undef GS_RD_A
#undef GS_CMP_A
#undef GS_RD_B
#undef GS_CMP_B
#undef GS_LOAD
#undef GS_STORE
#undef GS_SCORES
    }
}

__device__ __forceinline__ void gla_post(Frame& F) {
    const int gw = F.vcu * NWAVES + F.wave, NGW = F.G * NWAVES, lane = lane_id();
    const bf16* OFp = (const bf16*)(F.ws + WS_OF); const bf16* OBp = (const bf16*)((const unsigned char*)F.out + OUT_OB); const bf16* R0 = (const bf16*)(F.ws + WS_R0); bf16* Gp = (bf16*)(F.ws + WS_G);
    float gn[16];
#pragma unroll
    for (int j = 0; j < 4; ++j) { const f32x4 t = *(const f32x4*)(F.in[8] + 16 * lane + 4 * j); gn[4 * j] = t.x; gn[4 * j + 1] = t.y; gn[4 * j + 2] = t.z; gn[4 * j + 3] = t.w; }
    v4u nx[6];
    if (gw < NTOK) { const size_t off = (size_t)gw * 1024 + 16 * lane; nx[0] = *(const v4u*)(OFp + off); nx[1] = *(const v4u*)(OFp + off + 8); nx[2] = *(const v4u*)(OBp + off); nx[3] = *(const v4u*)(OBp + off + 8); nx[4] = *(const v4u*)(R0 + off); nx[5] = *(const v4u*)(R0 + off + 8); }
    for (int m = gw; m < NTOK; m += NGW) {
        const size_t off = (size_t)m * 1024 + 16 * lane;
        const v4u a0 = nx[0], a1 = nx[1], b0 = nx[2], b1 = nx[3], r0 = nx[4], r1 = nx[5];
        { const int mn = (m + NGW < NTOK) ? m + NGW : m; const size_t offn = (size_t)mn * 1024 + 16 * lane;
          nx[0] = *(const v4u*)(OFp + offn); nx[1] = *(const v4u*)(OFp + offn + 8); nx[2] = *(const v4u*)(OBp + offn); nx[3] = *(const v4u*)(OBp + offn + 8); nx[4] = *(const v4u*)(R0 + offn); nx[5] = *(const v4u*)(R0 + offn + 8); }
        float o[16], rr[16]; float ss = 0.f;
#pragma unroll
        for (int j = 0; j < 4; ++j) { o[2 * j] = bf_lo(a0[j]) + bf_lo(b0[j]); o[2 * j + 1] = bf_hi(a0[j]) + bf_hi(b0[j]); o[8 + 2 * j] = bf_lo(a1[j]) + bf_lo(b1[j]); o[8 + 2 * j + 1] = bf_hi(a1[j]) + bf_hi(b1[j]);
            rr[2 * j] = bf_lo(r0[j]); rr[2 * j + 1] = bf_hi(r0[j]); rr[8 + 2 * j] = bf_lo(r1[j]); rr[8 + 2 * j + 1] = bf_hi(r1[j]); }
#pragma unroll
        for (int j = 0; j < 16; ++j) ss += o[j] * o[j];
        ss += __shfl_xor(ss, 1); ss += __shfl_xor(ss, 2); ss += __shfl_xor(ss, 4); ss += __shfl_xor(ss, 8);
        const float rs = 1.0f / sqrtf(ss * (1.f / 256.f) + NORM_EPS);
        float y[16];
#pragma unroll
        for (int j = 0; j < 16; ++j) y[j] = o[j] * rs * gn[j] * pg8::silu_f(rr[j]);
        v4u w0, w1;
#pragma unroll
        for (int j = 0; j < 4; ++j) { w0[j] = cvtpk(y[2 * j], y[2 * j + 1]); w1[j] = cvtpk(y[8 + 2 * j], y[8 + 2 * j + 1]); }
        *(v4u*)(Gp + off) = w0; *(v4u*)(Gp + off + 8) = w1;
    }
}

constexpr int AT_K = 0, AT_V = 55296, AT_STRIDE = 144;
static_assert(2 * 55296 <= RING_BYTES, "attention LDS");
__device__ __forceinline__ void swa_attn(Frame& F) {
    const int lane = lane_id(), tid = F.wave * 64 + lane, w = F.wave, r16 = lane & 15, g4 = lane >> 4;
    LAS unsigned char* L = F.lds + RING_OFF;
    const bf16* Q1 = (const bf16*)(F.ws + WS_Q1); const bf16* K1 = (const bf16*)(F.ws + WS_K1); const bf16* V1 = (const bf16*)(F.ws + WS_V1); bf16* O1 = (bf16*)(F.ws + WS_O1);
    v4u kr[6], vr[6];
#define AT_FETCH(u_) do { const int b_ = (u_) >> 8, g_ = ((u_) >> 6) & 3, kb_ = (((u_) & 63) - 1) * 128; \
        _Pragma("unroll") for (int i = 0; i < 6; ++i) { const int piece = tid + 512 * i, row = piece >> 3, ch = piece & 7; int tok = kb_ + row; tok = tok < 0 ? 0 : (tok >= SEQ ? SEQ - 1 : tok); \
            const size_t go = ((size_t)b_ * SEQ + tok) * 256 + g_ * 64 + ch * 8; kr[i] = *(const v4u*)(K1 + go); vr[i] = *(const v4u*)(V1 + go); } } while (0)
    if (F.vcu < 2048) AT_FETCH(F.vcu);
    for (int u = F.vcu; u < 2048; u += F.G) {
        const int b = u >> 8, g = (u >> 6) & 3, nb = u & 63;
        const int kbase = (nb - 1) * 128;
        LBAR();
#pragma unroll
        for (int i = 0; i < 6; ++i) { const int piece = tid + 512 * i, row = piece >> 3, ch = piece & 7;
            *(LAS v4u*)(L + AT_K + row * AT_STRIDE + ch * 16) = kr[i]; *(LAS v4u*)(L + AT_V + row * AT_STRIDE + ch * 16) = vr[i]; }
        const int hq = 4 * g + (w >> 1), q0w = nb * 128 + 64 * (w & 1);
        bf16x8 qfa[4][2];
#pragma unroll
        for (int qt = 0; qt < 4; ++qt)
#pragma unroll
            for (int ks = 0; ks < 2; ++ks) qfa[qt][ks] = *(const bf16x8*)(Q1 + ((size_t)b * SEQ + q0w + 16 * qt + r16) * 1024 + hq * 64 + 32 * ks + 8 * g4);
        { const int un = (u + F.G < 2048) ? u + F.G : u; AT_FETCH(un); }
        const float slope = exp2f(-0.5f * (float)(hq + 1)) * LOG2E, sink2 = F.in[12][hq] * LOG2E;
        const float clf = (float)(r16 - 4 * g4);
        LBAR();
        for (int pass = 0; pass < 2; ++pass) {
            const int q0 = q0w + 32 * pass;
            bf16x8 qf[2][2];
#pragma unroll
            for (int qt = 0; qt < 2; ++qt)
#pragma unroll
                for (int ks = 0; ks < 2; ++ks) qf[qt][ks] = pass ? qfa[2 + qt][ks] : qfa[qt][ks];
            float mrun[2], lrun[2]; f32x4 oacc[2][4];
#pragma unroll
            for (int qt = 0; qt < 2; ++qt) { mrun[qt] = sink2; lrun[qt] = (g4 == 0) ? 1.f : 0.f;
#pragma unroll
                for (int dt = 0; dt < 4; ++dt) oacc[qt][dt] = (f32x4){0.f, 0.f, 0.f, 0.f}; }
            for (int t = 0; t < 9; ++t) {
                const int ktok0 = q0 - 128 + 32 * t, s0 = ktok0 - kbase;
                if (ktok0 < 0 || ktok0 >= SEQ) continue;
                bf16x8 kf[2][2];
#pragma unroll
                for (int sub = 0; sub < 2; ++sub)
#pragma unroll
                    for (int ks = 0; ks < 2; ++ks) kf[sub][ks] = *(const LAS bf16x8*)(L + AT_K + (s0 + 16 * sub + r16) * AT_STRIDE + ks * 64 + g4 * 16);
                bf16x8 vf[4];
#pragma unroll
                for (int dt = 0; dt < 4; ++dt) { const LAS unsigned char* a = L + AT_V + (s0 + 4 * g4 + (r16 >> 2)) * AT_STRIDE + (16 * dt + 4 * (r16 & 3)) * 2; vf[dt] = cat8(ldtr(a), ldtr(a + 16 * AT_STRIDE)); }
#pragma unroll
                for (int qt = 0; qt < 2; ++qt) {
                    f32x4 s[2];
#pragma unroll
                    for (int sub = 0; sub < 2; ++sub) { s[sub] = (f32x4){0.f, 0.f, 0.f, 0.f};
#pragma unroll
                        for (int ks = 0; ks < 2; ++ks) s[sub] = mfma16(kf[sub][ks], qf[qt][ks], s[sub]); }
                    const int d0 = 128 - 32 * t + 16 * qt; float mx = -INFINITY;
                    if ((d0 >= 31 && d0 <= 113) || (d0 <= -15 && d0 >= -97)) {
                        const float sg = d0 > 0 ? -slope : slope, b0 = -slope * (float)(d0 > 0 ? d0 : -d0) + sg * clf;
#pragma unroll
                        for (int sub = 0; sub < 2; ++sub)
#pragma unroll
                            for (int r = 0; r < 4; ++r) { const float v = s[sub][r] + (b0 - sg * (float)(16 * sub + r)); s[sub][r] = v; mx = fmaxf(mx, v); }
                    } else {
                        const float dlf = clf + (float)d0;
#pragma unroll
                        for (int sub = 0; sub < 2; ++sub)
#pragma unroll
                            for (int r = 0; r < 4; ++r) { const float ad = __builtin_fabsf(dlf - (float)(16 * sub + r));
                                float v = __builtin_fmaf(-slope, ad, s[sub][r]); v = (ad > 128.0f) ? -INFINITY : v; s[sub][r] = v; mx = fmaxf(mx, v); }
                    }
                    if (__any(mx > mrun[qt] + 6.0f)) {
                        mx = fmaxf(mx, __shfl_xor(mx, 16)); mx = fmaxf(mx, __shfl_xor(mx, 32));
                        const float mnew = fmaxf(mrun[qt], mx), alpha = __builtin_amdgcn_exp2f(mrun[qt] - mnew); mrun[qt] = mnew; lrun[qt] *= alpha;
#pragma unroll
                        for (int dt = 0; dt < 4; ++dt) oacc[qt][dt] = oacc[qt][dt] * alpha;
                    }
                    const float off = -mrun[qt]; float ps = 0.f;
#pragma unroll
                    for (int sub = 0; sub < 2; ++sub)
#pragma unroll
                        for (int r = 0; r < 4; ++r) { const float p = __builtin_amdgcn_exp2f(s[sub][r] + off); s[sub][r] = p; ps += p; }
                    lrun[qt] += ps;
                    const u32x4 pw = (u32x4){cvtpk(s[0][0], s[0][1]), cvtpk(s[0][2], s[0][3]), cvtpk(s[1][0], s[1][1]), cvtpk(s[1][2], s[1][3])};
#pragma unroll
                    for (int dt = 0; dt < 4; ++dt) oacc[qt][dt] = mfma16(vf[dt], __builtin_bit_cast(bf16x8, pw), oacc[qt][dt]);
                }
            }
#pragma unroll
            for (int qt = 0; qt < 2; ++qt) { float l = lrun[qt]; l += __shfl_xor(l, 16); l += __shfl_xor(l, 32); const float inv = 1.0f / l;
                bf16* op = O1 + ((size_t)b * SEQ + q0 + 16 * qt + r16) * 1024 + hq * 64 + 4 * g4;
#pragma unroll
                for (int dt = 0; dt < 4; ++dt) { const f32x4 o = oacc[qt][dt] * inv; *(u32x2*)(op + 16 * dt) = (u32x2){cvtpk(o[0], o[1]), cvtpk(o[2], o[3])}; } }
        }
    }
}

#undef AT_FETCH
__device__ __forceinline__ void moe_route(Frame& F, const bf16* HB, const float* ssp, const float* gain) {
    const int gw = F.vcu * NWAVES + F.wave, NGW = F.G * NWAVES, lane = lane_id();
    unsigned char* XN = F.ws + WS_XN; int* sel = (int*)(F.ws + WS_SEL); float* wsel = (float*)(F.ws + WS_WSEL); int* wcnt = (int*)(F.ws + WS_WCNT);
    const float* router = F.in[18];
    f32x4 g[4]; f32x4 rt[4][4][2];
#pragma unroll
    for (int j = 0; j < 4; ++j) { g[j] = ((const f32x4*)gain)[lane + 64 * j];
#pragma unroll
        for (int i = 0; i < 4; ++i) { const float* rp = router + (size_t)(256 * j + 4 * lane + i) * 8; rt[j][i][0] = *(const f32x4*)rp; rt[j][i][1] = *(const f32x4*)(rp + 4); } }
    int cnt[8];
#pragma unroll
    for (int e = 0; e < 8; ++e) cnt[e] = 0;
    u32x2 hvn[4]; float sn = 0.f;
    if (gw < NTOK) { const GAS u32x2* xr = (const GAS u32x2*)(HB + (size_t)gw * DM) + lane;
#pragma unroll
        for (int j = 0; j < 4; ++j) hvn[j] = xr[64 * j];
        sn = ssp[(size_t)gw * 16 + (lane & 15)]; }
    for (int m = gw; m < NTOK; m += NGW) {
        u32x2 hvc[4]; float s = sn;
#pragma unroll
        for (int j = 0; j < 4; ++j) hvc[j] = hvn[j];
        { const int mn = (m + NGW < NTOK) ? m + NGW : m; const GAS u32x2* xr = (const GAS u32x2*)(HB + (size_t)mn * DM) + lane;
#pragma unroll
          for (int j = 0; j < 4; ++j) hvn[j] = xr[64 * j];
          sn = ssp[(size_t)mn * 16 + (lane & 15)]; }
        s += __shfl_xor(s, 1); s += __shfl_xor(s, 2); s += __shfl_xor(s, 4); s += __shfl_xor(s, 8);
        const float rs = 1.0f / sqrtf(s * (1.f / DM) + NORM_EPS);
        GAS unsigned* o4 = (GAS unsigned*)(XN + (size_t)m * DM) + lane;
        float lg[8];
#pragma unroll
        for (int e = 0; e < 8; ++e) lg[e] = 0.f;
#pragma unroll
        for (int j = 0; j < 4; ++j) { const u32x2 hv = hvc[j]; const f32x4 v = (f32x4){bf_lo(hv.x), bf_hi(hv.x), bf_lo(hv.y), bf_hi(hv.y)};
            const f32x4 o = v * rs * g[j]; o4[64 * j] = pk4f8(o.x * XSCALE, o.y * XSCALE, o.z * XSCALE, o.w * XSCALE);
#pragma unroll
            for (int i = 0; i < 4; ++i)
#pragma unroll
                for (int e = 0; e < 8; ++e) lg[e] += o[i] * rt[j][i][e >> 2][e & 3]; }
#pragma unroll
        for (int e = 0; e < 8; ++e) lg[e] = wave_sum(lg[e]);
        int e0 = 0; float l0 = lg[0];
#pragma unroll
        for (int e = 1; e < 8; ++e) if (lg[e] > l0) { l0 = lg[e]; e0 = e; }
        int e1 = -1; float l1 = -INFINITY;
#pragma unroll
        for (int e = 0; e < 8; ++e) if (e != e0 && lg[e] > l1) { l1 = lg[e]; e1 = e; }
        const float w0 = 1.0f / (1.0f + __expf(l1 - l0)), w1 = 1.0f - w0;
        int rk0 = 0, rk1 = 0;
#pragma unroll
        for (int e = 0; e < 8; ++e) { rk0 = (e0 == e) ? cnt[e] : rk0; rk1 = (e1 == e) ? cnt[e] : rk1; cnt[e] += ((e0 == e) ? 1 : 0) + ((e1 == e) ? 1 : 0); }
        if (lane == 0) { *(int4*)(sel + (size_t)m * 4) = make_int4(e0, e1, rk0, rk1); *(float2*)(wsel + (size_t)m * 2) = make_float2(w0, w1); }
    }
    if (lane < 8) { int cv = 0;
#pragma unroll
        for (int e = 0; e < 8; ++e) cv = (lane == e) ? cnt[e] : cv;
        wcnt[(size_t)gw * 8 + lane] = cv; }
}
__device__ __forceinline__ void moe_gather(Frame& F) {
    const int gw = F.vcu * NWAVES + F.wave, NGW = F.G * NWAVES, lane = lane_id();
    const unsigned char* XN = F.ws + WS_XN; unsigned char* XS = F.ws + WS_XS;
    const int* sel = (const int*)(F.ws + WS_SEL); const float* wsel = (const float*)(F.ws + WS_WSEL); const int* wcnt = (const int*)(F.ws + WS_WCNT);
    int* postok = (int*)(F.ws + WS_POSTOK); float* roww = (float*)(F.ws + WS_ROWW); int* meta = (int*)(F.ws + WS_META);
    int base[8], tot[8];
#pragma unroll
    for (int e = 0; e < 8; ++e) { base[e] = 0; tot[e] = 0; }
    for (int w0 = lane; w0 < NGW; w0 += 64 * 8) {
        int4 av[8], cv[8];
#pragma unroll
        for (int j = 0; j < 8; ++j) { const int w2 = w0 + 64 * j, wc = (w2 < NGW) ? w2 : lane; av[j] = *(const int4*)(wcnt + (size_t)wc * 8); cv[j] = *(const int4*)(wcnt + (size_t)wc * 8 + 4); }
#pragma unroll
        for (int j = 0; j < 8; ++j) { const int w2 = w0 + 64 * j; const int vz = (w2 < NGW) ? 1 : 0, lt = (w2 < gw) ? vz : 0; const int4 a = av[j], c = cv[j];
            tot[0] += vz * a.x; tot[1] += vz * a.y; tot[2] += vz * a.z; tot[3] += vz * a.w; tot[4] += vz * c.x; tot[5] += vz * c.y; tot[6] += vz * c.z; tot[7] += vz * c.w;
            base[0] += lt * a.x; base[1] += lt * a.y; base[2] += lt * a.z; base[3] += lt * a.w; base[4] += lt * c.x; base[5] += lt * c.y; base[6] += lt * c.z; base[7] += lt * c.w; } }
    int ts[9]; ts[0] = 0;
#pragma unroll
    for (int e = 0; e < 8; ++e) { tot[e] = wave_sum_i(tot[e]); base[e] = wave_sum_i(base[e]); ts[e + 1] = ts[e] + ((tot[e] + 255) >> 8); base[e] += ts[e] * 256; }
    if (gw == 0 && lane < 9) { int tv = 0;
#pragma unroll
        for (int e = 0; e < 9; ++e) tv = (lane == e) ? ts[e] : tv;
        meta[lane] = tv; }
    for (int m0 = gw; m0 < NTOK; m0 += 4 * NGW) {
        int4 sv[4]; float2 wv[4]; v4u a0[4];
#pragma unroll
        for (int j = 0; j < 4; ++j) { const int m = (m0 + j * NGW < NTOK) ? m0 + j * NGW : m0;
            sv[j] = *(const int4*)(sel + (size_t)m * 4); wv[j] = *(const float2*)(wsel + (size_t)m * 2); a0[j] = *(const v4u*)(XN + (size_t)m * 1024 + 16 * lane); }
#pragma unroll
        for (int j = 0; j < 4; ++j) { const int m = m0 + j * NGW; if (m < NTOK) {
            int p0 = 0, p1 = 0;
#pragma unroll
            for (int e = 0; e < 8; ++e) { p0 = (sv[j].x == e) ? base[e] : p0; p1 = (sv[j].y == e) ? base[e] : p1; }
            p0 += sv[j].z; p1 += sv[j].w;
            *(v4u*)(XS + (size_t)p0 * 1024 + 16 * lane) = a0[j]; *(v4u*)(XS + (size_t)p1 * 1024 + 16 * lane) = a0[j];
            if (lane == 0) { roww[p0] = wv[j].x; roww[p1] = wv[j].y; *(int2*)(postok + (size_t)m * 2) = make_int2(p0, p1); } } }
    }
}
__device__ __forceinline__ bool fr_deferred(const LAS unsigned* bm, int2 pp) { return (((bm[pp.x >> 13] >> ((pp.x >> 8) & 31)) | (bm[pp.y >> 13] >> ((pp.y >> 8) & 31))) & 1u) != 0u; }
template <int MODE> __device__ __forceinline__ void final_rows(Frame& F, const bf16* HB, float* out, const float* gain, int gw, int NGW, const LAS unsigned* bm) {
    const int lane = lane_id();
    const bf16* Y = (const bf16*)(F.ws + WS_XS); const int* postok = (const int*)(F.ws + WS_POSTOK);
    f32x4 g[4];
#pragma unroll
    for (int j = 0; j < 4; ++j) g[j] = ((const f32x4*)gain)[lane + 64 * j];
    if constexpr (MODE == 2) {
        for (int m = gw; m < NTOK; m += NGW) {
            const int2 pp = *(const int2*)(postok + (size_t)m * 2);
            if (!fr_deferred(bm, pp)) continue;
            const GAS u32x2* hr = (const GAS u32x2*)(HB + (size_t)m * DM) + lane; const u32x2* y0 = (const u32x2*)(Y + (size_t)pp.x * 1024) + lane; const u32x2* y1 = (const u32x2*)(Y + (size_t)pp.y * 1024) + lane;
            GAS f32x4* xr = (GAS f32x4*)(out + (size_t)m * DM) + lane;
            f32x4 v[4]; float s = 0.f;
#pragma unroll
            for (int j = 0; j < 4; ++j) { const u32x2 h2 = hr[64 * j], a = y0[64 * j], c = y1[64 * j];
                v[j].x = bf_lo(h2.x) + bf_lo(a.x) + bf_lo(c.x); v[j].y = bf_hi(h2.x) + bf_hi(a.x) + bf_hi(c.x); v[j].z = bf_lo(h2.y) + bf_lo(a.y) + bf_lo(c.y); v[j].w = bf_hi(h2.y) + bf_hi(a.y) + bf_hi(c.y);
                s += (v[j].x * v[j].x + v[j].y * v[j].y) + (v[j].z * v[j].z + v[j].w * v[j].w); }
            const float rs = 1.0f / sqrtf(wave_sum(s) * (1.f / DM) + NORM_EPS);
#pragma unroll
            for (int j = 0; j < 4; ++j) xr[64 * j] = v[j] * rs * g[j];
        }
        return;
    }
    u32x2 hv[4], ya[4], yc[4]; int2 ppn = make_int2(0, 0), ppc = make_int2(0, 0);
    if (gw < NTOK) { const int2 pp = *(const int2*)(postok + (size_t)gw * 2); ppc = pp;
        const GAS u32x2* hr = (const GAS u32x2*)(HB + (size_t)gw * DM) + lane; const u32x2* y0 = (const u32x2*)(Y + (size_t)pp.x * 1024) + lane; const u32x2* y1 = (const u32x2*)(Y + (size_t)pp.y * 1024) + lane;
#pragma unroll
        for (int j = 0; j < 4; ++j) { hv[j] = hr[64 * j]; ya[j] = y0[64 * j]; yc[j] = y1[64 * j]; }
        const int m1 = (gw + NGW < NTOK) ? gw + NGW : gw; ppn = *(const int2*)(postok + (size_t)m1 * 2); }
    for (int m = gw; m < NTOK; m += NGW) {
        u32x2 hvc[4], yac[4], ycc[4]; const int2 pcur = ppc;
#pragma unroll
        for (int j = 0; j < 4; ++j) { hvc[j] = hv[j]; yac[j] = ya[j]; ycc[j] = yc[j]; }
        { const int m1 = (m + NGW < NTOK) ? m + NGW : m, m2 = (m + 2 * NGW < NTOK) ? m + 2 * NGW : m; const int2 pp = ppn; ppc = pp;
          const GAS u32x2* hr = (const GAS u32x2*)(HB + (size_t)m1 * DM) + lane; const u32x2* y0 = (const u32x2*)(Y + (size_t)pp.x * 1024) + lane; const u32x2* y1 = (const u32x2*)(Y + (size_t)pp.y * 1024) + lane;
#pragma unroll
          for (int j = 0; j < 4; ++j) { hv[j] = hr[64 * j]; ya[j] = y0[64 * j]; yc[j] = y1[64 * j]; }
          ppn = *(const int2*)(postok + (size_t)m2 * 2); }
        if (MODE == 1 && fr_deferred(bm, pcur)) continue;
        GAS f32x4* xr = (GAS f32x4*)(out + (size_t)m * DM) + lane;
        f32x4 v[4]; float s = 0.f;
#pragma unroll
        for (int j = 0; j < 4; ++j) { const u32x2 h2 = hvc[j], a = yac[j], c = ycc[j];
            v[j].x = bf_lo(h2.x) + bf_lo(a.x) + bf_lo(c.x); v[j].y = bf_hi(h2.x) + bf_hi(a.x) + bf_hi(c.x); v[j].z = bf_lo(h2.y) + bf_lo(a.y) + bf_lo(c.y); v[j].w = bf_hi(h2.y) + bf_hi(a.y) + bf_hi(c.y);
            s += (v[j].x * v[j].x + v[j].y * v[j].y) + (v[j].z * v[j].z + v[j].w * v[j].w); }
        const float rs = 1.0f / sqrtf(wave_sum(s) * (1.f / DM) + NORM_EPS);
#pragma unroll
        for (int j = 0; j < 4; ++j) xr[64 * j] = v[j] * rs * g[j];
    }
}

struct Args { const float* in[23]; float* out; unsigned char* ws; int ph_lo, ph_hi; };
__global__ void __launch_bounds__(NWAVES * 64, 2) fwd_kernel(Args args) {
    extern __shared__ __attribute__((aligned(16))) unsigned char lds[];
    Frame F;
    F.lds = (LAS unsigned char*)lds;
    F.MISC = (volatile LAS unsigned*)(F.lds + MISC_OFF);
    F.wave = __builtin_amdgcn_readfirstlane((int)threadIdx.x >> 6);
    F.G = gridDim.x; { const int bx = blockIdx.x; F.vcu = (F.G % 8 == 0) ? (bx % 8) * (F.G / 8) + bx / 8 : bx; }
    F.ws = args.ws; F.out = args.out;
    F.in = args.in;
    for (int u = F.wave * 64 + lane_id(); u < (LDS_BYTES - LDSCTL_OFF) / 4; u += NWAVES * 64) ((LAS unsigned*)(F.lds + LDSCTL_OFF))[u] = 0u;
    __syncthreads();
    const int lo = args.ph_lo, hi = args.ph_hi;
    if (hi - lo > 1) (void)xcd_barrier_post((unsigned*)(F.ws + WS_CTL) + CW_BAR, F.MISC + 8, (F.wave == 0 && lane_id() == 0) ? 1u : 0u);
#define MKBAR() do { XcdBarrier bar_; bar_.bar = (unsigned*)(F.ws + WS_CTL) + CW_BAR; bar_.x = xb_xcc_id(); bar_.st = (volatile LAS unsigned*)(F.lds + MISC_OFF) + 8; bar_.t0 = (F.wave == 0 && lane_id() == 0) ? 1u : 0u; xcd_barrier(bar_); } while (0)
#ifndef MK_PHASE_MASK
#define MK_PHASE_MASK 0xFFFFu
#endif
#define IN(k) (((MK_PHASE_MASK >> (k)) & 1u) && lo <= (k) && (k) < hi)
#ifndef MK_BAR_REP
#define MK_BAR_REP 1
#endif
#define SEAM(k) do { if (IN(k) && IN((k) + 1)) { _Pragma("nounroll") for (int r_ = 0; r_ < MK_BAR_REP; ++r_) MKBAR(); } } while (0)
    bf16* XB = (bf16*)((unsigned char*)F.out + OUT_XB); bf16* HB = (bf16*)(F.ws + WS_HB);

#define PH0 do { p0_weights(F, args.in[3], args.in[9], args.in[10], args.in[13], args.in[15], args.in[16], args.in[17], args.in[19], args.in[20], args.in[21], F.in[1], F.in[2], F.in[1] + DM); \
        convert_rows(F, F.in[0], XB, (float*)(F.ws + WS_SS0), args.in[3], F.in[1], (float*)(F.ws + WS_LR)); } while (0)
#define PH1 do { pg8::Gemm g{XB, (const bf16*)(F.ws + WS_W_GLAIN), NTOK, 3072, 1024}; pg8::StaticOrder S0; S0.init(NTOK, 3072, F.G, (int)blockIdx.x); const auto S = pg8::unitlist_fill(F.lds + UL_OFF, S0, F.wave); \
        pg8::rowcache_fill(F.lds + AUX_OFF, S, (const float*)(F.ws + WS_SS0), 1, F.wave); \
        pg8::EpiGlaIn E{(bf16*)(F.ws + WS_Q0), (bf16*)(F.ws + WS_K0), (bf16*)(F.ws + WS_V0), (bf16*)(F.ws + WS_R0), (float*)(F.ws + WS_LR), (const float*)(F.ws + WS_SS0), F.lds + AUX_OFF}; \
        pg8::gemm_phase<pg8::EpiGlaIn, pg8::ListOrder<pg8::StaticOrder>, MK_DENSE_ALIGN, MK_DENSE_SP2>(F.lds + RING_OFF, g, S, E, F.wave); } while (0)
#define PH2 do { gla_prep(F); } while (0)
#define PH3 do { gla_scan(F); } while (0)
#define PH4 do { gla_post(F); } while (0)
#define PH5 do { pg8::Gemm g{(const bf16*)(F.ws + WS_G), (const bf16*)(F.ws + WS_W_GLAOUT), NTOK, 1024, 1024}; pg8::StaticOrder S0; S0.init(NTOK, 1024, F.G, (int)blockIdx.x); const auto S = pg8::unitlist_fill(F.lds + UL_OFF, S0, F.wave); \
        pg8::EpiResBf16 E{XB, HB, nullptr, (float*)(F.ws + WS_SSP1), 1.0f}; \
        pg8::gemm_phase<pg8::EpiResBf16, pg8::ListOrder<pg8::StaticOrder>, MK_DENSE_ALIGN, MK_DENSE_SP2>(F.lds + RING_OFF, g, S, E, F.wave); } while (0)
#define PH6 do { pg8::Gemm g{HB, (const bf16*)(F.ws + WS_W_DGU), NTOK, 5632, 1024}; pg8::StaticOrder S0; S0.init(NTOK, 5632, F.G, (int)blockIdx.x); const auto S = pg8::unitlist_fill(F.lds + UL_OFF, S0, F.wave); \
        pg8::rowcache_fill(F.lds + AUX_OFF, S, (const float*)(F.ws + WS_SSP1), 16, F.wave); \
        pg8::EpiSwiglu E{(bf16*)(F.ws + WS_ACT0), DFF, 22, (const float*)(F.ws + WS_SSP1), F.lds + AUX_OFF, MK_DDN_FP8 ? ASCALE : 0.f}; \
        pg8::gemm_phase<pg8::EpiSwiglu, pg8::ListOrder<pg8::StaticOrder>, MK_DENSE_ALIGN, MK_DENSE_SP2>(F.lds + RING_OFF, g, S, E, F.wave); } while (0)
#define PH7 do { pg8::Gemm g{(const bf16*)(F.ws + WS_ACT0), (const bf16*)(F.ws + WS_W_DDN), NTOK, 1024, MK_DDN_FP8 ? DFF / 2 : DFF}; pg8::StaticOrder S0; S0.init(NTOK, 1024, F.G, (int)blockIdx.x); const auto S = pg8::unitlist_fill(F.lds + UL_OFF, S0, F.wave); \
        pg8::EpiResBf16 E{HB, HB, nullptr, (float*)(F.ws + WS_SSP2), MK_DDN_FP8 ? 1.0f / (ASCALE * WSCALE) : 1.0f}; \
        pg8::gemm_phase<pg8::EpiResBf16, pg8::ListOrder<pg8::StaticOrder>, MK_DENSE_ALIGN, MK_DENSE_SP2, (MK_DDN_FP8 != 0)>(F.lds + RING_OFF, g, S, E, F.wave); } while (0)
#define PH8 do { pg8::Gemm g{HB, (const bf16*)(F.ws + WS_W_QKV), NTOK, 1536, 1024}; pg8::StaticOrder S0; S0.init(NTOK, 1536, F.G, (int)blockIdx.x); const auto S = pg8::unitlist_fill(F.lds + UL_OFF, S0, F.wave); \
        pg8::rowcache_fill(F.lds + AUX_OFF, S, (const float*)(F.ws + WS_SSP2), 16, F.wave); \
        pg8::EpiQkv E{(bf16*)(F.ws + WS_Q1), (bf16*)(F.ws + WS_K1), (bf16*)(F.ws + WS_V1), F.in[11], (const float*)(F.ws + WS_SSP2), F.lds + AUX_OFF}; \
        pg8::gemm_phase<pg8::EpiQkv, pg8::ListOrder<pg8::StaticOrder>, MK_DENSE_ALIGN, MK_DENSE_SP2>(F.lds + RING_OFF, g, S, E, F.wave); } while (0)
#define PH9 do { swa_attn(F); } while (0)
#define PH10 do { pg8::Gemm g{(const bf16*)(F.ws + WS_O1), (const bf16*)(F.ws + WS_W_SWAOUT), NTOK, 1024, 1024}; pg8::StaticOrder S0; S0.init(NTOK, 1024, F.G, (int)blockIdx.x); const auto S = pg8::unitlist_fill(F.lds + UL_OFF, S0, F.wave); \
        pg8::EpiResBf16 E{HB, HB, F.in[14], (float*)(F.ws + WS_SSP3), 1.0f}; \
        pg8::gemm_phase<pg8::EpiResBf16, pg8::ListOrder<pg8::StaticOrder>, MK_DENSE_ALIGN, MK_DENSE_SP2>(F.lds + RING_OFF, g, S, E, F.wave); } while (0)
#define PH11 do { moe_route(F, HB, (const float*)(F.ws + WS_SSP3), F.in[2] + DM); } while (0)
#define PH12 do { moe_gather(F); } while (0)
#define PH13 do { pg8::MoeOrder S0; S0.init((const int*)(F.ws + WS_META), 22, F.G, (int)blockIdx.x); const auto S = pg8::unitlist_fill(F.lds + UL_OFF, S0, F.wave); \
        pg8::Gemm g{(const bf16*)(F.ws + WS_XS), (const bf16*)(F.ws + WS_W_MGU), 0, 0, 512}; \
        pg8::EpiSwiglu8 E{F.ws + WS_ACT1, DFF, 22, 1.0f / (XSCALE * WSCALE), ASCALE}; \
        pg8::gemm_phase<pg8::EpiSwiglu8, pg8::ListOrder<pg8::MoeOrder>, MK_P13_ALIGN, MK_P13_SP2, true>(F.lds + RING_OFF, g, S, E, F.wave); } while (0)
#ifndef MK_P14_SPLIT
#define MK_P14_SPLIT 1
#endif
#ifndef MK_P14_REV
#define MK_P14_REV 0
#endif
#ifndef MK_P14_ALIGN
#define MK_P14_ALIGN true
#endif
#ifndef MK_P14_SP2
#define MK_P14_SP2 true
#endif
#define PH14X(i0_, i1_) do { pg8::MoeOrder S0; S0.init((const int*)(F.ws + WS_META), 4, F.G, (int)blockIdx.x, MK_P14_REV, (i0_), (i1_)); const auto S = pg8::unitlist_fill(F.lds + UL_OFF, S0, F.wave); \
        pg8::Gemm g{(const bf16*)(F.ws + WS_ACT1), (const bf16*)(F.ws + WS_W_MDN), 0, 0, DFF / 2}; \
        pg8::rowcache_fill(F.lds + AUX_OFF, S, (const float*)(F.ws + WS_ROWW), 1, F.wave); \
        pg8::EpiMoeDown E{(bf16*)(F.ws + WS_XS), (const float*)(F.ws + WS_ROWW), 0, 1.0f / (ASCALE * WSCALE), F.lds + AUX_OFF}; \
        pg8::gemm_phase<pg8::EpiMoeDown, pg8::ListOrder<pg8::MoeOrder>, MK_P14_ALIGN, MK_P14_SP2, true>(F.lds + RING_OFF, g, S, E, F.wave); } while (0)
#ifndef MK_DENSE_ALIGN
#define MK_DENSE_ALIGN true
#endif
#ifndef MK_DENSE_SP2
#define MK_DENSE_SP2 true
#endif
#ifndef MK_P13_ALIGN
#define MK_P13_ALIGN true
#endif
#ifndef MK_P13_SP2
#define MK_P13_SP2 true
#endif
#ifndef MK_REP_PHASE
#define MK_REP_PHASE -1
#endif
#define RUN(k) do { if (IN(k)) { PH##k; if (MK_REP_PHASE == (k)) { MKBAR(); PH##k; } } } while (0)
    RUN(0); SEAM(0); RUN(1); SEAM(1); RUN(2); SEAM(2); RUN(3); SEAM(3); RUN(4); SEAM(4); RUN(5); SEAM(5); RUN(6);
    SEAM(6); RUN(7); SEAM(7); RUN(8); SEAM(8);
    RUN(9); SEAM(9); RUN(10); SEAM(10); RUN(11); SEAM(11); RUN(12); SEAM(12); RUN(13); SEAM(13);
    {
        const int* meta_ = (const int*)(F.ws + WS_META); LAS unsigned* bm_ = (LAS unsigned*)(F.lds + TB_OFF);
        int rf_ = 0x7fffffff, rem_ = 0; bool split_ = false;
        if (IN(14) && IN(15) && MK_P14_SPLIT) { const int nwg_ = __builtin_amdgcn_readfirstlane(meta_[8]) * 4; rem_ = nwg_ % F.G; split_ = (rem_ != 0) && (rem_ * 2 <= F.G) && (nwg_ >= F.G); if (split_) rf_ = nwg_ / F.G; }
        if (IN(14)) PH14X(0, rf_);
        if (IN(14) && IN(15)) MKBAR();
        if (split_) {
            const int tid_ = F.wave * 64 + lane_id();
            LBAR(); if (tid_ < 32) bm_[tid_] = 0u; LBAR();
            if (tid_ < rem_) { pg8::MoeOrder T_; T_.init(meta_, 4, F.G, tid_, MK_P14_REV, rf_, rf_ + 1); pg8::Unit u_; if (T_.next(0, u_)) __hip_atomic_fetch_or(&bm_[u_.pm >> 5], 1u << (u_.pm & 31), __ATOMIC_RELAXED, __HIP_MEMORY_SCOPE_WORKGROUP); }
            LBAR();
            PH14X(rf_, rf_ + 1);
            const int nb_ = (int)blockIdx.x - rem_;
            final_rows<1>(F, HB, F.out, F.in[22], nb_ >= 0 ? nb_ * NWAVES + F.wave : NTOK, (F.G - rem_) * NWAVES, bm_);
            MKBAR();
            final_rows<2>(F, HB, F.out, F.in[22], F.vcu * NWAVES + F.wave, F.G * NWAVES, bm_);
        } else if (IN(15)) {
            final_rows<0>(F, HB, F.out, F.in[22], F.vcu * NWAVES + F.wave, F.G * NWAVES, bm_);
        }
    }
#undef IN
#undef SEAM
}

extern "C" void kernel_launch(void* const* d_in, const int* in_sizes, int n_in, void* d_out, int out_size, void* d_ws, size_t ws_size, hipStream_t stream) {
    static int grid = 0;
    if (grid == 0) {
        if (n_in != 23 || in_sizes[0] != NTOK * DM || out_size != NTOK * DM || ws_size < WS_END) {
            fprintf(stderr, "kernel_launch: built for 23 inputs, x/out of %d floats, >= %zu bytes of workspace; got n_in %d, in0 %d, out %d, ws %zu; nothing launched\n", NTOK * DM, (size_t)WS_END, n_in, n_in > 0 ? in_sizes[0] : -1, out_size, ws_size); grid = -1; return; }
        int dev = 0, cus = 0, per_cu = 0;
        if (hipGetDevice(&dev) != hipSuccess || hipDeviceGetAttribute(&cus, hipDeviceAttributeMultiprocessorCount, dev) != hipSuccess) { fprintf(stderr, "kernel_launch: device query failed\n"); grid = -1; return; }
        if (hipFuncSetAttribute((const void*)fwd_kernel, hipFuncAttributeMaxDynamicSharedMemorySize, LDS_BYTES) != hipSuccess) { fprintf(stderr, "kernel_launch: hipFuncSetAttribute failed\n"); grid = -1; return; }
        if (hipOccupancyMaxActiveBlocksPerMultiprocessor(&per_cu, (const void*)fwd_kernel, NWAVES * 64, LDS_BYTES) != hipSuccess || per_cu < 1) {
            fprintf(stderr, "kernel_launch: occupancy query reports %d workgroups per CU\n", per_cu); (void)hipGetLastError(); grid = -1; return; }
        grid = cus;
    }
    if (grid < 0) return;
    if (hipMemsetAsync((char*)d_ws + WS_CTL, 0, CTL_ZERO_BYTES, stream) != hipSuccess) { fprintf(stderr, "kernel_launch: memset failed\n"); return; }
    Args a{};
    for (int i = 0; i < 23; ++i) a.in[i] = (const float*)d_in[i];
    a.out = (float*)d_out; a.ws = (unsigned char*)d_ws;
#if MK_ONE_LAUNCH
    a.ph_lo = 0; a.ph_hi = NPHASE;
    hipLaunchKernelGGL(fwd_kernel, dim3(grid), dim3(NWAVES * 64), LDS_BYTES, stream, a);
#else
    for (int p = 0; p < NPHASE; ++p) { a.ph_lo = p; a.ph_hi = p + 1; hipLaunchKernelGGL(fwd_kernel, dim3(grid), dim3(NWAVES * 64), LDS_BYTES, stream, a); }
#endif
    const hipError_t le = hipPeekAtLastError();
    if (le != hipSuccess) fprintf(stderr, "kernel_launch: launch failed: %s\n", hipGetErrorName(le));
}
```

```cpp
#include <hip/hip_runtime.h>
#include <cstdio>
#include <cstdint>
namespace pg8 {
#define PG8_LAS __attribute__((address_space(3)))
typedef unsigned short bf16_t;
typedef short bf16x8 __attribute__((ext_vector_type(8)));
typedef float f32x4 __attribute__((ext_vector_type(4)));
typedef unsigned u32x4 __attribute__((ext_vector_type(4)));
constexpr int BM = 256, BK = 64, HALF = 128, HTB = HALF * BK * 2  , STAGE_BYTES = 8 * HTB, NXCD = 8,
#ifdef MK_WGM
    WGM = MK_WGM;
#else
    WGM = 8;
#endif

__host__ __device__ __forceinline__ int lds_byte(int r, int c) { const int st = (r >> 4) * 2 + (c >> 5), rr = r & 15, cc = c & 31, ob = rr * 64 + cc * 2; return st * 1024 + (ob ^ (((ob >> 9) & 1) << 5)); }
__host__ __device__ __forceinline__ void stage_rc(int b, int& R, int& C) { const int st = b / 1024, sb = b % 1024, swz = sb ^ (((sb >> 9) & 1) << 5); R = (st >> 1) * 16 + swz / 64; C = (st & 1) * 32 + (swz % 64) / 2; }
__host__ __device__ __forceinline__ int perm32(int rho) { const int n = rho >> 4, i = rho & 15; return 8 * (i >> 2) + 4 * n + (i & 3); }

struct Unit { int pm, pn; };
struct Gemm { const bf16_t* A; const bf16_t* Bt; int M, N, K; };

struct StaticOrder {
    int nM, nN, nwg, G, c;
    __host__ __device__ void init(int M, int N, int G_, int c_) { nM = M / BM; nN = N / BM; nwg = nM * nN; G = G_; c = c_; }
    __host__ __device__ bool next(int i, Unit& u) const {
        const long L = (long)i * G + c; if (L >= nwg) return false;
        int wgid = (int)L; { const int q = nwg / NXCD, r = nwg % NXCD, xcd = wgid % NXCD, off = wgid / NXCD; wgid = (xcd < r ? xcd * (q + 1) : r * (q + 1) + (xcd - r) * q) + off; }
        const int nig = WGM * nN, gid = wgid / nig, fm = gid * WGM, gsz = (nM - fm) < WGM ? (nM - fm) : WGM;
        u.pm = fm + ((wgid % nig) % gsz); u.pn = (wgid % nig) / gsz; return true;
    }
    __device__ __forceinline__ void a_ready(const Unit&) const {}
    __device__ __forceinline__ void done(const Unit&) const {}
};

__device__ __forceinline__ unsigned cvt_pk_bf16(float lo, float hi) { unsigned r; asm volatile("v_cvt_pk_bf16_f32 %0, %1, %2" : "=v"(r) : "v"(lo), "v"(hi)); return r; }
typedef float f32x2 __attribute__((ext_vector_type(2)));

typedef unsigned u32x2 __attribute__((ext_vector_type(2)));
__device__ __forceinline__ int pg8_lane() { int l; asm volatile("v_mbcnt_lo_u32_b32 %0, -1, 0\n\tv_mbcnt_hi_u32_b32 %0, -1, %0" : "=v"(l)); return l; }
typedef float f32x2_t __attribute__((ext_vector_type(2))); typedef __bf16 bf16x2_t __attribute__((ext_vector_type(2)));
__device__ __forceinline__ unsigned cvt2(float lo, float hi) { f32x2_t v = {lo, hi}; bf16x2_t b = __builtin_convertvector(v, bf16x2_t); return __builtin_bit_cast(unsigned, b); }
__device__ __forceinline__ u32x4 pack8(f32x4 a, f32x4 b) { u32x4 w; w.x = cvt2(a[0], a[1]); w.y = cvt2(a[2], a[3]); w.z = cvt2(b[0], b[1]); w.w = cvt2(b[2], b[3]); return w; }

constexpr int RC_MAXP = 15, RC_BYTES = 64 + RC_MAXP * 1024;
__device__ __forceinline__ float rs_from_partials(const float* ssp, int row) {
    const f32x4 a = *(const f32x4*)(ssp + (size_t)row * 16), b = *(const f32x4*)(ssp + (size_t)row * 16 + 4), c = *(const f32x4*)(ssp + (size_t)row * 16 + 8), d = *(const f32x4*)(ssp + (size_t)row * 16 + 12);
    const float s = ((a[0] + a[1]) + (a[2] + a[3])) + ((b[0] + b[1]) + (b[2] + b[3])) + ((c[0] + c[1]) + (c[2] + c[3])) + ((d[0] + d[1]) + (d[2] + d[3]));
    return __builtin_amdgcn_rsqf(s * (1.0f / 1024.0f) + 1e-5f);
}
template <class Sched>
__device__ __forceinline__ void rowcache_fill(PG8_LAS unsigned char* aux, const Sched& S, const float* src, int np, int wid) {
    PG8_LAS int* hdr = (PG8_LAS int*)aux; PG8_LAS float* val = (PG8_LAS float*)(aux + 64);
    const int lane = pg8_lane(), tid = wid * 64 + lane;
    asm volatile("s_waitcnt lgkmcnt(0)" ::: "memory"); __builtin_amdgcn_s_barrier(); asm volatile("" ::: "memory");
    if (wid == 0) {
        Unit u; const bool has = S.next(lane, u); const int pm = has ? u.pm : -1; bool first = has;
        for (int j = 0; j < 63; ++j) { const int pj = __shfl(pm, j); if (j < lane && pj == pm) first = false; }
        const unsigned long long mask = __ballot(first);
        const int pos = __builtin_popcountll(mask & ((1ull << lane) - 1ull));
        if (first && pos < RC_MAXP) hdr[1 + pos] = pm;
        if (lane == 0) { const int n = __builtin_popcountll(mask); hdr[0] = n < RC_MAXP ? n : RC_MAXP; }
    }
    asm volatile("s_waitcnt lgkmcnt(0)" ::: "memory"); __builtin_amdgcn_s_barrier(); asm volatile("" ::: "memory");
    const int n = hdr[0];
    for (int s = (tid >> 8); s < n; s += 2) { const int row = hdr[1 + s] * BM + (tid & 255);
        val[s * 256 + (tid & 255)] = (np == 16) ? rs_from_partials(src, row) : src[row]; }
    asm volatile("s_waitcnt vmcnt(0) lgkmcnt(0)" ::: "memory"); __builtin_amdgcn_s_barrier(); asm volatile("" ::: "memory");
}
__device__ __forceinline__ void rowcache_get8(const PG8_LAS unsigned char* aux, const float* src, int np, int pm, int rr0, float (&v)[2][4]) {
    const PG8_LAS int* hdr = (const PG8_LAS int*)aux; const PG8_LAS float* val = (const PG8_LAS float*)(aux + 64);
    const int n = hdr[0]; int slot = -1;
#pragma unroll
    for (int k = 0; k < RC_MAXP; ++k) slot = (k < n && hdr[1 + k] == pm) ? k : slot;
    slot = __builtin_amdgcn_readfirstlane(slot);
    if (slot >= 0) {
#pragma unroll
        for (int ai = 0; ai < 2; ++ai)
#pragma unroll
            for (int m = 0; m < 4; ++m) v[ai][m] = val[slot * 256 + rr0 + ai * HALF + m * 16];
    } else {
#pragma unroll
        for (int ai = 0; ai < 2; ++ai)
#pragma unroll
            for (int m = 0; m < 4; ++m) { const int row = pm * BM + rr0 + ai * HALF + m * 16; v[ai][m] = (np == 16) ? rs_from_partials(src, row) : src[row]; }
    }
}
struct EpiGlaIn {
    static constexpr bool PERM = true, AFTER_DRAIN = false;
    bf16_t *Q0, *K0, *V0, *R0; float* LR; const float* rs0; const PG8_LAS unsigned char* aux;
    __device__ __forceinline__ void operator()(const f32x4 (&acc)[2][2][4][2], const Unit& u, int wr, int wc, int fr, int fq) const {
        const int pn = u.pn; const int row0 = u.pm * BM + wr * 64 + fr; const int cw = wc * 32 + 8 * fq;
        float rs[2][4]; rowcache_get8(aux, rs0, 1, u.pm, wr * 64 + fr, rs);
        if (pn < 12) {
            bf16_t* base; int ld, c0; float sc = 1.f;
            if (pn < 2) { base = Q0; ld = 512; c0 = pn * 256; sc = 0.08838834764831845f; }
            else if (pn < 4) { base = K0; ld = 512; c0 = (pn - 2) * 256; }
            else if (pn < 8) { base = V0; ld = 1024; c0 = (pn - 4) * 256; }
            else { base = R0; ld = 1024; c0 = (pn - 8) * 256; }
#pragma unroll
            for (int ai = 0; ai < 2; ++ai)
#pragma unroll
                for (int m = 0; m < 4; ++m) { bf16_t* rowp = base + (size_t)(row0 + ai * HALF + m * 16) * ld + c0 + cw;
#pragma unroll
                    for (int bj = 0; bj < 2; ++bj) *(u32x4*)(rowp + bj * HALF) = pack8(acc[ai][bj][m][0] * (sc * rs[ai][m]), acc[ai][bj][m][1] * (sc * rs[ai][m])); }
        } else if (wc == 0) {
#pragma unroll
            for (int ai = 0; ai < 2; ++ai)
#pragma unroll
                for (int m = 0; m < 4; ++m) { float* p = LR + (size_t)(row0 + ai * HALF + m * 16) * 32 + 8 * fq;
                    *(f32x4*)p = acc[ai][0][m][0] * rs[ai][m]; *(f32x4*)(p + 4) = acc[ai][0][m][1] * rs[ai][m]; }
        }
    }
};
struct EpiResBf16 {
    static constexpr bool PERM = true, AFTER_DRAIN = false;
    const bf16_t* base; bf16_t* out; const float* bias; float* ssp; float accs;
    __device__ __forceinline__ void operator()(const f32x4 (&acc)[2][2][4][2], const Unit& u, int wr, int wc, int fr, int fq) const {
        const int row0 = u.pm * BM + wr * 64 + fr; const int col0 = u.pn * BM + wc * 32 + 8 * fq;
        f32x4 bv[2][2];
#pragma unroll
        for (int bj = 0; bj < 2; ++bj)
#pragma unroll
            for (int n = 0; n < 2; ++n) bv[bj][n] = bias ? *(const f32x4*)(bias + col0 + bj * HALF + 4 * n) : (f32x4){0.f, 0.f, 0.f, 0.f};
#pragma unroll
        for (int ai = 0; ai < 2; ++ai) {
            u32x4 bbv[4][2];
#pragma unroll
            for (int m = 0; m < 4; ++m)
#pragma unroll
                for (int bj = 0; bj < 2; ++bj) bbv[m][bj] = *(const u32x4*)(base + (size_t)(row0 + ai * HALF + m * 16) * 1024 + col0 + bj * HALF);
#pragma unroll
            for (int m = 0; m < 4; ++m) { const int row = row0 + ai * HALF + m * 16; const size_t off = (size_t)row * 1024 + col0; float s = 0.f;
#pragma unroll
                for (int bj = 0; bj < 2; ++bj) { const u32x4 bb = bbv[m][bj]; f32x4 v0, v1;
#pragma unroll
                    for (int j = 0; j < 2; ++j) { v0[2 * j] = __uint_as_float(bb[j] << 16); v0[2 * j + 1] = __uint_as_float(bb[j] & 0xffff0000u); v1[2 * j] = __uint_as_float(bb[2 + j] << 16); v1[2 * j + 1] = __uint_as_float(bb[2 + j] & 0xffff0000u); }
                    v0 = v0 + acc[ai][bj][m][0] * accs + bv[bj][0]; v1 = v1 + acc[ai][bj][m][1] * accs + bv[bj][1];
                    s += (v0[0] * v0[0] + v0[1] * v0[1]) + (v0[2] * v0[2] + v0[3] * v0[3]) + (v1[0] * v1[0] + v1[1] * v1[1]) + (v1[2] * v1[2] + v1[3] * v1[3]);
                    *(u32x4*)(out + off + bj * HALF) = pack8(v0, v1); }
                s += __shfl_xor(s, 16); s += __shfl_xor(s, 32);
                if (fq == 0) ssp[(size_t)row * 16 + 4 * u.pn + wc] = s; }
        }
    }
};
__device__ __forceinline__ float silu_f(float g) { return g * __builtin_amdgcn_rcpf(1.0f + __builtin_amdgcn_exp2f(-1.4426950408889634f * g)); }
__device__ __forceinline__ unsigned pk4_fp8(float a, float b, float c, float d) {
    a = __builtin_amdgcn_fmed3f(a, -448.f, 448.f); b = __builtin_amdgcn_fmed3f(b, -448.f, 448.f); c = __builtin_amdgcn_fmed3f(c, -448.f, 448.f); d = __builtin_amdgcn_fmed3f(d, -448.f, 448.f);
    unsigned r = 0u; r = __builtin_amdgcn_cvt_pk_fp8_f32(a, b, r, false); r = __builtin_amdgcn_cvt_pk_fp8_f32(c, d, r, true); return r;
}
struct EpiSwiglu {
    static constexpr bool PERM = true, AFTER_DRAIN = false;
    bf16_t* O; int ldo; int ntn; const float* ssp; const PG8_LAS unsigned char* aux; float f8scale;
    __device__ __forceinline__ void operator()(const f32x4 (&acc)[2][2][4][2], const Unit& u, int wr, int wc, int fr, int fq) const {
        const int row0 = u.pm * BM + wr * 64 + fr; const int col0 = (u.pn % ntn) * HALF + wc * 32 + 8 * fq;
        float rsv[2][4]; rowcache_get8(aux, ssp, 16, u.pm, wr * 64 + fr, rsv);
#pragma unroll
        for (int ai = 0; ai < 2; ++ai)
#pragma unroll
            for (int m = 0; m < 4; ++m) { f32x4 v0, v1; const float rs = rsv[ai][m];
                { const float c0 = -1.4426950408889634f * rs, c1 = rs * rs; const f32x4 g0 = acc[ai][0][m][0], g1 = acc[ai][0][m][1]; f32x4 t0 = g0 * c0, t1 = g1 * c0;
#pragma unroll
                  for (int j = 0; j < 4; ++j) { t0[j] = __builtin_amdgcn_rcpf(1.0f + __builtin_amdgcn_exp2f(t0[j])); t1[j] = __builtin_amdgcn_rcpf(1.0f + __builtin_amdgcn_exp2f(t1[j])); }
                  v0 = (g0 * acc[ai][1][m][0]) * (t0 * c1); v1 = (g1 * acc[ai][1][m][1]) * (t1 * c1); }
                if (f8scale > 0.f) { v0 = v0 * f8scale; v1 = v1 * f8scale; *(u32x2*)((unsigned char*)O + (size_t)(row0 + ai * HALF + m * 16) * ldo + col0) = (u32x2){pk4_fp8(v0[0], v0[1], v0[2], v0[3]), pk4_fp8(v1[0], v1[1], v1[2], v1[3])}; }
                else *(u32x4*)(O + (size_t)(row0 + ai * HALF + m * 16) * ldo + col0) = pack8(v0, v1); }
    }
};
struct EpiSwiglu8 {
    static constexpr bool PERM = true, AFTER_DRAIN = false;
    unsigned char* O; int ldo; int ntn; float inv, oscale;
    __device__ __forceinline__ void operator()(const f32x4 (&acc)[2][2][4][2], const Unit& u, int wr, int wc, int fr, int fq) const {
        const int row0 = u.pm * BM + wr * 64 + fr; const int col0 = (u.pn % ntn) * HALF + wc * 32 + 8 * fq;
#pragma unroll
        for (int ai = 0; ai < 2; ++ai)
#pragma unroll
            for (int m = 0; m < 4; ++m) { f32x4 v0, v1;
                { const float c0 = -1.4426950408889634f * inv, c1 = inv * inv * oscale; const f32x4 g0 = acc[ai][0][m][0], g1 = acc[ai][0][m][1]; f32x4 t0 = g0 * c0, t1 = g1 * c0;
#pragma unroll
                  for (int j = 0; j < 4; ++j) { t0[j] = __builtin_amdgcn_rcpf(1.0f + __builtin_amdgcn_exp2f(t0[j])); t1[j] = __builtin_amdgcn_rcpf(1.0f + __builtin_amdgcn_exp2f(t1[j])); }
                  v0 = (g0 * acc[ai][1][m][0]) * (t0 * c1); v1 = (g1 * acc[ai][1][m][1]) * (t1 * c1); }
                *(u32x2*)(O + (size_t)(row0 + ai * HALF + m * 16) * ldo + col0) = (u32x2){pk4_fp8(v0[0], v0[1], v0[2], v0[3]), pk4_fp8(v1[0], v1[1], v1[2], v1[3])}; }
    }
};
struct EpiMoeDown {
    static constexpr bool PERM = true, AFTER_DRAIN = false;
    bf16_t* Y; const float* roww; int row_base; float inv; const PG8_LAS unsigned char* aux;
    __device__ __forceinline__ void operator()(const f32x4 (&acc)[2][2][4][2], const Unit& u, int wr, int wc, int fr, int fq) const {
        const int row0 = row_base + u.pm * BM + wr * 64 + fr; const int col0 = (u.pn & 3) * BM + wc * 32 + 8 * fq;
        float wv[2][4]; rowcache_get8(aux, roww, 1, u.pm, wr * 64 + fr, wv);
#pragma unroll
        for (int ai = 0; ai < 2; ++ai)
#pragma unroll
            for (int m = 0; m < 4; ++m) wv[ai][m] *= inv;
#pragma unroll
        for (int ai = 0; ai < 2; ++ai)
#pragma unroll
            for (int m = 0; m < 4; ++m) { const int row = row0 + ai * HALF + m * 16; const float w = wv[ai][m]; bf16_t* rowp = Y + (size_t)row * 1024 + col0;
#pragma unroll
                for (int bj = 0; bj < 2; ++bj) *(u32x4*)(rowp + bj * HALF) = pack8(acc[ai][bj][m][0] * w, acc[ai][bj][m][1] * w); }
    }
};
struct EpiQkv {
    static constexpr bool PERM = true, AFTER_DRAIN = false;
    bf16_t *Q1, *K1, *V1; const float* bias; const float* ssp; const PG8_LAS unsigned char* aux;
    __device__ __forceinline__ void operator()(const f32x4 (&acc)[2][2][4][2], const Unit& u, int wr, int wc, int fr, int fq) const {
        const int pn = u.pn; const int row0 = u.pm * BM + wr * 64 + fr; const int cw = wc * 32 + 8 * fq;
        bf16_t* base; int ld, c0; float sc = 1.f;
        if (pn < 4) { base = Q1; ld = 1024; c0 = pn * 256; sc = 0.125f * 1.4426950408889634f; }
        else if (pn == 4) { base = K1; ld = 256; c0 = 0; }
        else { base = V1; ld = 256; c0 = 0; }
        f32x4 bv[2][2];
#pragma unroll
        for (int bj = 0; bj < 2; ++bj)
#pragma unroll
            for (int n = 0; n < 2; ++n) bv[bj][n] = *(const f32x4*)(bias + pn * 256 + bj * HALF + cw + 4 * n);
        float rsv[2][4]; rowcache_get8(aux, ssp, 16, u.pm, wr * 64 + fr, rsv);
#pragma unroll
        for (int ai = 0; ai < 2; ++ai)
#pragma unroll
            for (int m = 0; m < 4; ++m) { bf16_t* rowp = base + (size_t)(row0 + ai * HALF + m * 16) * ld + c0 + cw; const float rs = rsv[ai][m];
#pragma unroll
                for (int bj = 0; bj < 2; ++bj) *(u32x4*)(rowp + bj * HALF) = pack8((acc[ai][bj][m][0] * rs + bv[bj][0]) * sc, (acc[ai][bj][m][1] * rs + bv[bj][1]) * sc); }
    }
};
struct MoeOrder {
    int nM, nN, nwg, G, c, rev, i0, i1; const int* meta;
    __device__ __forceinline__ void init(const int* meta_, int nN_, int G_, int c_, int rev_ = 0, int i0_ = 0, int i1_ = 0x7fffffff) { meta = meta_; nM = meta_[8]; nN = nN_; nwg = nM * nN; G = G_; c = c_; rev = rev_; i0 = i0_; i1 = i1_; }
    __device__ __forceinline__ bool next(int i, Unit& u) const {
        const int ii = i + i0; if (ii >= i1) return false;
        const long L = (long)ii * G + c; if (L >= nwg) return false;
        int wgid = (int)L; { const int q = nwg / NXCD, r = nwg % NXCD, xcd = wgid % NXCD, off = wgid / NXCD; wgid = (xcd < r ? xcd * (q + 1) : r * (q + 1) + (xcd - r) * q) + off; }
        const int nig = WGM * nN, gid = wgid / nig, fm = gid * WGM, gsz = (nM - fm) < WGM ? (nM - fm) : WGM;
        const int pm0 = fm + ((wgid % nig) % gsz), pn = (wgid % nig) / gsz; const int pm = rev ? nM - 1 - pm0 : pm0;
        int e = 0;
#pragma unroll
        for (int k = 1; k < 8; ++k) e += (pm >= meta[k]) ? 1 : 0;
        u.pm = pm; u.pn = e * nN + pn; return true;
    }
    __device__ __forceinline__ void a_ready(const Unit&) const {}
    __device__ __forceinline__ void done(const Unit&) const {}
};

constexpr int UL_MAX = 128;
template <class Sched> struct ListOrder {
    const PG8_LAS int* list; int n; Sched S;
    __device__ __forceinline__ bool next(int i, Unit& u) const {
        if (i >= UL_MAX) return S.next(i, u);
        if (i >= n) return false;
        const int a = list[2 * i], b = list[2 * i + 1]; u.pm = __builtin_amdgcn_readfirstlane(a); u.pn = __builtin_amdgcn_readfirstlane(b); return true;
    }
    __device__ __forceinline__ void a_ready(const Unit&) const {}
    __device__ __forceinline__ void done(const Unit&) const {}
};
template <class Sched> __device__ __forceinline__ ListOrder<Sched> unitlist_fill(PG8_LAS unsigned char* mem, const Sched& S, int wid) {
    PG8_LAS int* list = (PG8_LAS int*)mem; PG8_LAS int* cnt = list + 2 * UL_MAX;
    asm volatile("s_waitcnt lgkmcnt(0)" ::: "memory"); __builtin_amdgcn_s_barrier(); asm volatile("" ::: "memory");
    if (wid < 2) { const int i = wid * 64 + pg8_lane(); Unit u; const bool has = S.next(i, u);
        if (has) { list[2 * i] = u.pm; list[2 * i + 1] = u.pn; }
        const int c = __builtin_popcountll(__ballot(has)); if (pg8_lane() == 0) cnt[wid] = c; }
    asm volatile("s_waitcnt lgkmcnt(0)" ::: "memory"); __builtin_amdgcn_s_barrier(); asm volatile("" ::: "memory");
    ListOrder<Sched> L; L.list = list; L.n = __builtin_amdgcn_readfirstlane(cnt[0] + cnt[1]); L.S = S; return L;
}
typedef int v4i_t __attribute__((ext_vector_type(4))); typedef int v8i_t __attribute__((ext_vector_type(8)));
__device__ __forceinline__ v8i_t cat32(bf16x8 lo, bf16x8 hi) { const v4i_t a = __builtin_bit_cast(v4i_t, lo), b = __builtin_bit_cast(v4i_t, hi); return __builtin_shufflevector(a, b, 0, 1, 2, 3, 4, 5, 6, 7); }
template <class Epi, class Sched, bool ALIGN_EPI = false, bool SP2 = false, bool FP8 = false>
__device__ __forceinline__ void gemm_phase(PG8_LAS unsigned char* lds, const Gemm g, const Sched& S, const Epi& E, const int wid  ) {
    const int lane = pg8_lane(), tid = wid * 64 + lane, wr = wid >> 2, wc = wid & 3, fr = lane & 15, fq = lane >> 4;
    const int K = g.K, nt = K / BK;
    unsigned voffA[2], voffB[2];
#pragma unroll
    for (int i = 0; i < 2; ++i) { int R, C; stage_rc(tid * 16 + i * 8192, R, C); const int Rb = Epi::PERM ? ((R & ~31) + perm32(R & 31)) : R;
        voffA[i] = (unsigned)(R * K + C) * 2u; voffB[i] = (unsigned)(Rb * K + C) * 2u; }
    const __amdgpu_buffer_rsrc_t rsA = __builtin_amdgcn_make_buffer_rsrc((void*)g.A, 0, 0x7fffffff, 0x00020000), rsB = __builtin_amdgcn_make_buffer_rsrc((void*)g.Bt, 0, 0x7fffffff, 0x00020000);
    const size_t kstep = (size_t)(BK * 2);
    const size_t hstep = (size_t)HALF * K * 2;
    const size_t tstep = 2 * hstep;
    const unsigned ldsw = (unsigned)wid * 1024u;
    const int aoff = lds_byte(wr * 64 + fr, fq * 8), boff = lds_byte(wc * 32 + fr, fq * 8);
#define PG8_SA(b, h) (((b) * 2 + (h)) * HTB)
#define PG8_SB(b, h) ((4 + (b) * 2 + (h)) * HTB)
#define PG8_RS_voffA rsA
#define PG8_RS_voffB rsB
#define PG8_BASE_voffA ((const char*)g.A)
#define PG8_BASE_voffB ((const char*)g.Bt)
#define PG8_STAGE(bufoff, gbase, voff) do { const unsigned so_ = (unsigned)((const char*)(gbase) - PG8_BASE_##voff); _Pragma("unroll") for (int _i = 0; _i < 2; ++_i) \
        __builtin_amdgcn_raw_ptr_buffer_load_lds(PG8_RS_##voff, (PG8_LAS unsigned*)(lds + (bufoff) + ldsw + _i * 8192), 16, (int)(voff)[_i], (int)so_, 0, 0); } while (0)
#define PG8_LDA(dst, b, h) do { if constexpr (FP8) { _Pragma("unroll") for (int m = 0; m < 4; ++m) dst##8[m] = cat32(*(const PG8_LAS bf16x8*)(lds + PG8_SA(b, h) + aoff + m * 2048), *(const PG8_LAS bf16x8*)(lds + PG8_SA(b, h) + aoff + m * 2048 + 1024)); } \
        else { _Pragma("unroll") for (int m = 0; m < 4; ++m) _Pragma("unroll") for (int k = 0; k < 2; ++k) dst[m][k] = *(const PG8_LAS bf16x8*)(lds + PG8_SA(b, h) + aoff + m * 2048 + k * 1024); } } while (0)
#define PG8_LDB(dst, b, h) do { if constexpr (FP8) { _Pragma("unroll") for (int n = 0; n < 2; ++n) dst##8[n] = cat32(*(const PG8_LAS bf16x8*)(lds + PG8_SB(b, h) + boff + n * 2048), *(const PG8_LAS bf16x8*)(lds + PG8_SB(b, h) + boff + n * 2048 + 1024)); } \
        else { _Pragma("unroll") for (int n = 0; n < 2; ++n) _Pragma("unroll") for (int k = 0; k < 2; ++k) dst[n][k] = *(const PG8_LAS bf16x8*)(lds + PG8_SB(b, h) + boff + n * 2048 + k * 1024); } } while (0)
#define PG8_MMA(ai, bj, At, Bt) do { __builtin_amdgcn_s_setprio(1); if constexpr (FP8) { _Pragma("unroll") for (int m = 0; m < 4; ++m) _Pragma("unroll") for (int n = 0; n < 2; ++n) \
        acc[ai][bj][m][n] = __builtin_amdgcn_mfma_scale_f32_16x16x128_f8f6f4(Bt##8[n], At##8[m], acc[ai][bj][m][n], 0, 0, 0, 0x7f7f7f7f, 0, 0x7f7f7f7f); } else { \
        _Pragma("unroll") for (int m = 0; m < 4; ++m) _Pragma("unroll") for (int n = 0; n < 2; ++n) _Pragma("unroll") for (int k = 0; k < 2; ++k) \
        acc[ai][bj][m][n] = __builtin_amdgcn_mfma_f32_16x16x32_bf16(Bt[n][k], At[m][k], acc[ai][bj][m][n], 0, 0, 0); } __builtin_amdgcn_s_setprio(0); } while (0)
#define PG8_WAIT_V(n) asm volatile("s_waitcnt vmcnt(" #n ")" ::: "memory")
#define PG8_WAIT_L(n) asm volatile("s_waitcnt lgkmcnt(" #n ")" ::: "memory")
#define PG8_BAR __builtin_amdgcn_s_barrier()
#define PG8_SCHED __builtin_amdgcn_sched_barrier(0)
    Unit cur, nxt; int ui = 0;
    if (!S.next(0, cur)) return;
    f32x4 acc[2][2][4][2];
#pragma unroll
    for (int a = 0; a < 2; ++a)
#pragma unroll
        for (int b = 0; b < 2; ++b)
#pragma unroll
            for (int m = 0; m < 4; ++m)
#pragma unroll
                for (int n = 0; n < 2; ++n) acc[a][b][m][n] = (f32x4){0.f, 0.f, 0.f, 0.f};
    bf16x8 At[4][2], B0[2][2], B1[2][2]; v8i_t At8[4], B08[2], B18[2];
    const char* cA = (const char*)g.A + (size_t)cur.pm * tstep; const char* cB = (const char*)g.Bt + (size_t)cur.pn * tstep;
    S.a_ready(cur);
    if constexpr (SP2) {
        PG8_STAGE(PG8_SB(0, 0), cB, voffB); PG8_STAGE(PG8_SB(0, 1), cB + hstep, voffB); PG8_STAGE(PG8_SA(0, 0), cA, voffA); PG8_STAGE(PG8_SA(0, 1), cA + hstep, voffA);
        if (wr == 1) PG8_BAR;
        PG8_WAIT_V(2); PG8_BAR;
        PG8_STAGE(PG8_SB(1, 0), cB + kstep, voffB); PG8_STAGE(PG8_SA(1, 0), cA + kstep, voffA); PG8_STAGE(PG8_SB(1, 1), cB + hstep + kstep, voffB);
        PG8_WAIT_V(6); PG8_BAR;
    } else {
        PG8_STAGE(PG8_SB(0, 0), cB, voffB); PG8_STAGE(PG8_SA(0, 0), cA, voffA); PG8_STAGE(PG8_SB(0, 1), cB + hstep, voffB); PG8_STAGE(PG8_SA(0, 1), cA + hstep, voffA);
        if (wr == 1) PG8_BAR;
        PG8_WAIT_V(4); PG8_BAR;
        PG8_STAGE(PG8_SB(1, 0), cB + kstep, voffB); PG8_STAGE(PG8_SA(1, 0), cA + kstep, voffA); PG8_STAGE(PG8_SB(1, 1), cB + hstep + kstep, voffB);
        PG8_WAIT_V(6); PG8_BAR;
    }
    for (;;) {
        const bool has_next = S.next(ui + 1, nxt);
        const char* nA = has_next ? (const char*)g.A + (size_t)nxt.pm * tstep : cA; const char* nB = has_next ? (const char*)g.Bt + (size_t)nxt.pn * tstep : cB;
#pragma nounroll
        for (int t = 0; t < nt; t += 2) {
            const bool last = (t == nt - 2);
            const char* a1 = cA + (size_t)(t + 1) * kstep;
            const char* a2 = last ? nA : cA + (size_t)(t + 2) * kstep; const char* b2 = last ? nB : cB + (size_t)(t + 2) * kstep;
            const char* a3 = a2 + kstep; const char* b3 = b2 + kstep;
            if (last && has_next) S.a_ready(nxt);
            if constexpr (SP2) {
            PG8_LDB(B0, 0, 0); PG8_LDB(B1, 0, 1); PG8_SCHED; PG8_LDA(At, 0, 0); PG8_STAGE(PG8_SA(1, 1), a1 + hstep, voffA);
            PG8_WAIT_V(8); PG8_WAIT_L(0); PG8_BAR; PG8_MMA(0, 0, At, B0); PG8_MMA(0, 1, At, B1); PG8_BAR; PG8_SCHED;
            PG8_LDA(At, 0, 1); PG8_STAGE(PG8_SB(0, 0), b2, voffB); PG8_STAGE(PG8_SB(0, 1), b2 + hstep, voffB); PG8_STAGE(PG8_SA(0, 0), a2, voffA);
            PG8_WAIT_V(8); PG8_WAIT_L(0); PG8_BAR; PG8_MMA(1, 0, At, B0); PG8_MMA(1, 1, At, B1); PG8_BAR; PG8_SCHED;
            PG8_LDB(B0, 1, 0); PG8_LDB(B1, 1, 1); PG8_SCHED; PG8_LDA(At, 1, 0); PG8_STAGE(PG8_SA(0, 1), a2 + hstep, voffA);
            PG8_WAIT_V(8); PG8_WAIT_L(0); PG8_BAR; PG8_MMA(0, 0, At, B0); PG8_MMA(0, 1, At, B1); PG8_BAR; PG8_SCHED;
            PG8_LDA(At, 1, 1); PG8_STAGE(PG8_SB(1, 0), b3, voffB); PG8_STAGE(PG8_SB(1, 1), b3 + hstep, voffB); PG8_STAGE(PG8_SA(1, 0), a3, voffA);
            PG8_WAIT_V(8); PG8_WAIT_L(0); PG8_BAR; PG8_MMA(1, 0, At, B0); PG8_MMA(1, 1, At, B1); PG8_BAR; PG8_SCHED;
            } else {
            PG8_LDB(B0, 0, 0); PG8_SCHED; PG8_LDA(At, 0, 0); PG8_STAGE(PG8_SA(1, 1), a1 + hstep, voffA);
            PG8_WAIT_L(8); PG8_BAR; PG8_WAIT_L(0); PG8_MMA(0, 0, At, B0); PG8_BAR; PG8_SCHED;
            PG8_LDB(B1, 0, 1); PG8_STAGE(PG8_SB(0, 0), b2, voffB);
            PG8_BAR; PG8_WAIT_L(0); PG8_MMA(0, 1, At, B1); PG8_BAR;
            PG8_LDA(At, 0, 1); PG8_STAGE(PG8_SA(0, 0), a2, voffA);
            PG8_BAR; PG8_WAIT_L(0); PG8_MMA(1, 0, At, B0); PG8_BAR; PG8_SCHED;
            PG8_STAGE(PG8_SB(0, 1), b2 + hstep, voffB);
            PG8_WAIT_V(6); PG8_BAR; PG8_MMA(1, 1, At, B1); PG8_BAR;
            PG8_LDB(B0, 1, 0); PG8_SCHED; PG8_LDA(At, 1, 0); PG8_STAGE(PG8_SA(0, 1), a2 + hstep, voffA);
            PG8_WAIT_L(8); PG8_BAR; PG8_WAIT_L(0); PG8_MMA(0, 0, At, B0); PG8_BAR; PG8_SCHED;
            PG8_LDB(B1, 1, 1); PG8_STAGE(PG8_SB(1, 0), b3, voffB);
            PG8_BAR; PG8_WAIT_L(0); PG8_MMA(0, 1, At, B1); PG8_BAR;
            PG8_LDA(At, 1, 1); PG8_STAGE(PG8_SA(1, 0), a3, voffA);
            PG8_BAR; PG8_WAIT_L(0); PG8_MMA(1, 0, At, B0); PG8_BAR; PG8_SCHED;
            PG8_STAGE(PG8_SB(1, 1), b3 + hstep, voffB);
            PG8_WAIT_V(6); PG8_BAR; PG8_MMA(1, 1, At, B1); PG8_BAR;
            }
        }
        if constexpr (ALIGN_EPI) { if (wr == 0) PG8_BAR; }
        if constexpr (!Epi::AFTER_DRAIN) { const int l2 = pg8_lane(); E(acc, cur, wr, wc, l2 & 15, l2 >> 4); S.done(cur); }
        if (!has_next) break;
#pragma unroll
        for (int a = 0; a < 2; ++a)
#pragma unroll
            for (int b = 0; b < 2; ++b)
#pragma unroll
                for (int m = 0; m < 4; ++m)
#pragma unroll
                    for (int n = 0; n < 2; ++n) acc[a][b][m][n] = (f32x4){0.f, 0.f, 0.f, 0.f};
        cur = nxt; cA = nA; cB = nB; ++ui;
        if constexpr (ALIGN_EPI) { if (wr == 1) PG8_BAR; }
    }
    PG8_WAIT_V(0);
    if constexpr (!ALIGN_EPI) { if (wr == 0) PG8_BAR; }
    PG8_BAR;
    if constexpr (Epi::AFTER_DRAIN) { E.fused(acc, cur, wr, wc, fr, fq, lds, wid, lane); S.done(cur); }
#undef PG8_SA
#undef PG8_SB
#undef PG8_STAGE
#undef PG8_RS_voffA
#undef PG8_RS_voffB
#undef PG8_BASE_voffA
#undef PG8_BASE_voffB
#undef PG8_LDA
#undef PG8_LDB
#undef PG8_MMA
#undef PG8_WAIT_V
#undef PG8_WAIT_L
#undef PG8_BAR
#undef PG8_SCHED
}
}

constexpr int NWAVES = 8;
constexpr int NTOK = 65536, SEQ = 8192, DM = 1024, DFF = 2816;
constexpr float NORM_EPS = 1e-5f;
constexpr float LOG2E = 1.4426950408889634f;
#ifndef MK_ONE_LAUNCH
#define MK_ONE_LAUNCH 1
#endif
constexpr int NPHASE = 16;

constexpr size_t MiB = 1u << 20;
constexpr size_t WS_CTL = 0, CTL_ZERO_BYTES = 1 * MiB;
constexpr size_t WS_W_GLAIN = 1 * MiB, WS_W_GLAOUT = 8 * MiB, WS_W_QKV = 10 * MiB, WS_W_SWAOUT = 13 * MiB, WS_W_DGU = 15 * MiB, WS_W_DDN = 26 * MiB, WS_W_MGU = 32 * MiB, WS_W_MDN = 120 * MiB;
constexpr size_t WS_HB = 164 * MiB;
constexpr size_t WS_XN = 612 * MiB;
constexpr size_t OUT_XB = 0, OUT_OB = 128 * MiB;
constexpr size_t WS_Q0 = 292 * MiB, WS_K0 = 356 * MiB, WS_V0 = 420 * MiB, WS_R0 = 548 * MiB, WS_LR = 676 * MiB;
constexpr size_t WS_QE = 684 * MiB;
constexpr size_t WS_CC = 940 * MiB;
constexpr size_t WS_OF = WS_Q0, WS_G = WS_V0;
constexpr size_t WS_ACT0 = 292 * MiB;
constexpr size_t WS_Q1 = 292 * MiB, WS_K1 = 420 * MiB, WS_V1 = 452 * MiB, WS_O1 = 484 * MiB;
constexpr size_t WS_XS = 292 * MiB;
constexpr size_t WS_ACT1 = 552 * MiB;
constexpr float XSCALE = 16.f, WSCALE = 64.f, ASCALE = 8.f;
constexpr size_t WS_ROUT = 952 * MiB;
constexpr size_t WS_SEL = WS_ROUT, WS_WSEL = WS_ROUT + 1 * MiB, WS_POSTOK = WS_ROUT + 2 * MiB, WS_ROWW = WS_ROUT + 3 * MiB, WS_WCNT = WS_ROUT + 4 * MiB, WS_META = WS_ROUT + 5 * MiB;
constexpr size_t WS_SSP1 = 960 * MiB, WS_SSP2 = 964 * MiB, WS_SSP3 = 968 * MiB, WS_SS0 = 972 * MiB;
constexpr size_t WS_END = 1024 * MiB;
static_assert(WS_W_MDN + (size_t)8 * 1024 * 2816 * 2 <= WS_HB && WS_CC + (size_t)2 * 8 * 128 * 1536 * 4 <= WS_ROUT && WS_ACT0 + (size_t)NTOK * DFF * 2 <= WS_QE + 4 * 64 * MiB, "ws map");
static_assert(WS_ACT1 + (size_t)133120 * DFF <= WS_ROUT && WS_XS + (size_t)133120 * 1024 * 2 <= WS_ACT1, "ws map 2");
constexpr int CW_TMO = 0, CW_BAR = 4096;

constexpr int RING_OFF = 0, RING_BYTES = 131072;
constexpr int LDS_BYTES = 163840;
constexpr int LDSCTL_OFF = LDS_BYTES - 1024, MISC_OFF = LDSCTL_OFF + 320;
constexpr int UL_OFF = RING_BYTES + 15616;
constexpr int TB_OFF = RING_BYTES + 16896;
static_assert(UL_OFF + 128 * 8 + 8 <= TB_OFF && TB_OFF + 128 <= LDSCTL_OFF, "LDS map");
constexpr int AUX_OFF = RING_BYTES;

#define GAS __attribute__((address_space(1)))
#define LAS __attribute__((address_space(3)))
typedef unsigned short bf16;
typedef unsigned v4u __attribute__((ext_vector_type(4)));
typedef float f32x4 __attribute__((ext_vector_type(4)));
typedef short bf16x8 __attribute__((ext_vector_type(8)));
typedef GAS unsigned gu32;
typedef GAS unsigned long long gu64;
#define RLX_AGENT __ATOMIC_RELAXED, __HIP_MEMORY_SCOPE_AGENT
#define LDS_WAIT() asm volatile("s_waitcnt lgkmcnt(0)" ::: "memory")
#define VM_WAIT() asm volatile("s_waitcnt vmcnt(0)" ::: "memory")
__device__ __forceinline__ unsigned long long rt() { return __builtin_amdgcn_s_memrealtime(); }
__device__ __forceinline__ unsigned f2bf(float f) { unsigned u = __builtin_bit_cast(unsigned, f); return (u + 0x7fffu + ((u >> 16) & 1u)) >> 16; }
__device__ __forceinline__ unsigned pk2(float lo, float hi) { return f2bf(lo) | (f2bf(hi) << 16); }

#define XB_TMO      128
#define XB_XCNT(j)  (256  + 64 * (j))
#define XB_XSUB(j)  (1280 + 64 * (j))
#define XB_XGEN(j)  (2304 + 64 * (j))
#define XB_TOP      3328
#define XB_TOPGEN   3392
#define XCD_BAR_WORDS 3456
#define XB_SPIN_CAP (1u << 18)

__device__ __forceinline__ unsigned xb_ld(unsigned* p)              { return __hip_atomic_load(p, __ATOMIC_RELAXED, __HIP_MEMORY_SCOPE_AGENT); }
__device__ __forceinline__ unsigned xb_add(unsigned* p, unsigned v) { return __hip_atomic_fetch_add(p, v, __ATOMIC_RELAXED, __HIP_MEMORY_SCOPE_AGENT); }
__device__ __forceinline__ unsigned xb_xcc_id() { return (unsigned)__builtin_amdgcn_s_getreg((3 << 11) | 20) & 0xFu; }
#define XB_SPIN(cond, bar) do { unsigned _sp = 0; while (cond) { __builtin_amdgcn_s_sleep(1); \
    if ((++_sp & 255u) == 0u) { if (xb_ld(&(bar)[XB_TMO])) break; if (_sp > XB_SPIN_CAP) { atomicAdd(&(bar)[XB_TMO], 1u); break; } } } } while (0)

struct XcdBarrier {
    unsigned* bar; unsigned x;
    volatile LAS unsigned* st;
    unsigned t0;
};

__device__ __forceinline__ XcdBarrier xcd_barrier_post(unsigned* bar, volatile LAS unsigned* st, unsigned t0) {
    XcdBarrier b; b.bar = bar; b.x = xb_xcc_id(); b.st = st; b.t0 = t0;
    if (t0) (void)xb_add(&bar[XB_XCNT(b.x)], 1u);
    return b;
}
__device__ __forceinline__ void xcd_barrier_complete(unsigned* bar, unsigned x, unsigned& nloc, unsigned& nx) {
    const unsigned G = gridDim.x * gridDim.y * gridDim.z;
    unsigned sum, cnt, mine, sp = 0u;
    for (;;) {
        sum = 0u; cnt = 0u; mine = 0u;
#pragma unroll
        for (unsigned j = 0; j < 16; ++j) { const unsigned c = xb_ld(&bar[XB_XCNT(j)]); sum += c; cnt += (c > 0u) ? 1u : 0u; mine = (j == x) ? c : mine; }
        if (sum == G) break;
        __builtin_amdgcn_s_sleep(1);
        if ((++sp & 255u) == 0u) { if (xb_ld(&bar[XB_TMO])) break; if (sp > XB_SPIN_CAP) { atomicAdd(&bar[XB_TMO], 1u); break; } }
    }
    nloc = mine > 0u ? mine : 1u; nx = cnt > 0u ? cnt : 1u;
}

__device__ __forceinline__ void xcd_barrier(const XcdBarrier& b) {
    asm volatile("s_waitcnt vmcnt(0)" ::: "memory");
    __syncthreads();
    if (b.t0) {
        unsigned* bar = b.bar;
        __builtin_amdgcn_s_waitcnt(0);
        unsigned nloc = b.st[0], nx = b.st[1];
        if (nloc == 0u) { xcd_barrier_complete(bar, b.x, nloc, nx); b.st[0] = nloc; b.st[1] = nx; }
        const unsigned old = xb_add(&bar[XB_XSUB(b.x)], 1u);
        const unsigned gen = old / nloc;
        if (old + 1u == (gen + 1u) * nloc) {
            __builtin_amdgcn_fence(__ATOMIC_RELEASE, "agent");
            asm volatile("s_waitcnt vmcnt(0)" ::: "memory");
            const unsigned og = xb_add(&bar[XB_TOP], 1u);
            const unsigned tg = og / nx;
            if (og + 1u == (tg + 1u) * nx) xb_add(&bar[XB_TOPGEN], 1u);
            else XB_SPIN(xb_ld(&bar[XB_TOPGEN]) == tg, bar);
            __builtin_amdgcn_fence(__ATOMIC_ACQUIRE, "agent");
            xb_add(&bar[XB_XGEN(b.x)], 1u);
            asm volatile("s_waitcnt vmcnt(0)" ::: "memory");
        } else {
            XB_SPIN(xb_ld(&bar[XB_XGEN(b.x)]) == gen, bar);
            __builtin_amdgcn_fence(__ATOMIC_ACQUIRE, "agent");
            asm volatile("s_waitcnt vmcnt(0)" ::: "memory");
        }
    }
    __syncthreads();
}
typedef unsigned u32x4 __attribute__((ext_vector_type(4)));

typedef unsigned u32x2 __attribute__((ext_vector_type(2)));
typedef short s16x4 __attribute__((ext_vector_type(4)));
struct Frame {
    LAS unsigned char* lds;
    volatile LAS unsigned* MISC;
    int wave;
    int vcu, G;
    float* out; unsigned char* ws;
    const float* const* in;
};
__device__ __forceinline__ int lane_id() { return pg8::pg8_lane(); }
__device__ __forceinline__ float bf_lo(unsigned u) { return __uint_as_float(u << 16); }
__device__ __forceinline__ float bf_hi(unsigned u) { return __uint_as_float(u & 0xffff0000u); }
typedef float f32x2_t __attribute__((ext_vector_type(2))); typedef __bf16 bf16x2_t __attribute__((ext_vector_type(2)));
__device__ __forceinline__ unsigned cvtpk(float lo, float hi) { f32x2_t v = {lo, hi}; bf16x2_t b = __builtin_convertvector(v, bf16x2_t); return __builtin_bit_cast(unsigned, b); }
__device__ __forceinline__ float wave_sum(float v) {
#pragma unroll
    for (int o = 1; o < 64; o <<= 1) v += __shfl_xor(v, o);
    return v;
}
__device__ __forceinline__ int wave_sum_i(int v) {
#pragma unroll
    for (int o = 1; o < 64; o <<= 1) v += __shfl_xor(v, o);
    return v;
}
#define LBAR() do { asm volatile("s_waitcnt lgkmcnt(0)" ::: "memory"); __builtin_amdgcn_s_barrier(); asm volatile("" ::: "memory"); } while (0)
__device__ __forceinline__ f32x4 mfma16(bf16x8 a, bf16x8 b, f32x4 c) { return __builtin_amdgcn_mfma_f32_16x16x32_bf16(a, b, c, 0, 0, 0); }
typedef short v4i16_t __attribute__((ext_vector_type(4)));
__device__ __forceinline__ s16x4 ldtr(const LAS unsigned char* p) { return __builtin_bit_cast(s16x4, __builtin_amdgcn_ds_read_tr16_b64_v4i16((LAS v4i16_t*)p)); }
__device__ __forceinline__ bf16x8 cat8(s16x4 lo, s16x4 hi) { return (bf16x8){lo[0], lo[1], lo[2], lo[3], hi[0], hi[1], hi[2], hi[3]}; }

__device__ __forceinline__ void conv_item(const float* W, int K, int N, bf16* WT, int drow0, int k0, int n0, LAS float* scr, int lane, const float* gain) {
    const float* gp = gain ? gain : W;
    float wv[32], gv[32];
#pragma unroll
    for (int i = 0; i < 32; ++i) { const int kk = 2 * i + (lane >> 5); wv[i] = W[(size_t)(k0 + kk) * N + n0 + (lane & 31)]; gv[i] = gp[k0 + kk]; }
#pragma unroll
    for (int i = 0; i < 32; ++i) { const int kk = 2 * i + (lane >> 5); scr[kk * 33 + (lane & 31)] = wv[i] * (gain ? gv[i] : 1.0f); }
    LDS_WAIT(); asm volatile("" ::: "memory");
    const int c = lane & 7;
#pragma unroll
    for (int j = 0; j < 4; ++j) { const int n = (lane >> 3) + 8 * j; const LAS float* s = scr + (8 * c) * 33 + n;
        v4u o; o.x = pk2(s[0 * 33], s[1 * 33]); o.y = pk2(s[2 * 33], s[3 * 33]); o.z = pk2(s[4 * 33], s[5 * 33]); o.w = pk2(s[6 * 33], s[7 * 33]);
        *(GAS v4u*)(WT + (size_t)(drow0 + n) * K + k0 + 8 * c) = o; }
    LDS_WAIT(); asm volatile("" ::: "memory");
}
__device__ __forceinline__ unsigned pk4f8(float a, float b, float c, float d) { unsigned r = 0u; r = __builtin_amdgcn_cvt_pk_fp8_f32(a, b, r, false); r = __builtin_amdgcn_cvt_pk_fp8_f32(c, d, r, true); return r; }
__device__ __forceinline__ void conv_item8(const float* W, int K, int N, unsigned char* WT, int drow0, int k0, int n0, LAS float* scr, int lane, float scale) {
#pragma unroll 64
    for (int i = 0; i < 64; ++i) scr[i * 65 + lane] = W[(size_t)(k0 + i) * N + n0 + lane] * scale;
    LDS_WAIT(); asm volatile("" ::: "memory");
    const int c = lane & 3;
#pragma unroll
    for (int j = 0; j < 4; ++j) { const int n = (lane >> 2) + 16 * j; const LAS float* s = scr + (16 * c) * 65 + n;
        v4u o; o.x = pk4f8(s[0 * 65], s[1 * 65], s[2 * 65], s[3 * 65]); o.y = pk4f8(s[4 * 65], s[5 * 65], s[6 * 65], s[7 * 65]); o.z = pk4f8(s[8 * 65], s[9 * 65], s[10 * 65], s[11 * 65]); o.w = pk4f8(s[12 * 65], s[13 * 65], s[14 * 65], s[15 * 65]);
        *(GAS v4u*)(WT + (size_t)(drow0 + n) * K + k0 + 16 * c) = o; }
    LDS_WAIT(); asm volatile("" ::: "memory");
}
constexpr int IT_GLAIN = 16 * 97, IT_SQ = 16 * 32, IT_QKV = 16 * 48, IT_FF = 1408, IT_FF8 = 704;
#ifndef MK_DDN_FP8
#define MK_DDN_FP8 1
#endif
constexpr int N_FF16 = MK_DDN_FP8 ? 2 : 3, N_FF8 = MK_DDN_FP8 ? 25 : 24;
constexpr int NITEMS = IT_GLAIN + 2 * IT_SQ + IT_QKV + N_FF16 * IT_FF + N_FF8 * IT_FF8;
__device__ __forceinline__ void p0_weights(Frame& F, const float* gla_in, const float* gla_out, const float* swa_qkv, const float* swa_out, const float* d_gate, const float* d_up, const float* d_down, const float* m_gate, const float* m_up, const float* m_down, const float* g_mix0, const float* g_ffn0, const float* g_mix1) {
    LAS float* scr = (LAS float*)(F.lds + F.wave * 16640);
    const int gw = F.vcu * NWAVES + F.wave, NGW = F.G * NWAVES, lane = lane_id();
    for (int it = gw; it < NITEMS; it += NGW) {
        int r = it; const float* W; int K = 1024, N; bf16* WT; int mode = 0; bool f8 = false; const float* gain = nullptr;
        if (r < IT_GLAIN) { W = gla_in; N = 3104; WT = (bf16*)(F.ws + WS_W_GLAIN); gain = g_mix0; }
        else if ((r -= IT_GLAIN) < IT_SQ) { W = gla_out; N = 1024; WT = (bf16*)(F.ws + WS_W_GLAOUT); }
        else if ((r -= IT_SQ) < IT_QKV) { W = swa_qkv; N = 1536; WT = (bf16*)(F.ws + WS_W_QKV); gain = g_mix1; }
        else if ((r -= IT_QKV) < IT_SQ) { W = swa_out; N = 1024; WT = (bf16*)(F.ws + WS_W_SWAOUT); }
        else { r -= IT_SQ; int j;
            if (r < N_FF16 * IT_FF) { j = r / IT_FF; r -= j * IT_FF; } else { r -= N_FF16 * IT_FF; const int j8 = r / IT_FF8; r -= j8 * IT_FF8; j = N_FF16 + j8; }
            int kind, e; if (j < 3) { kind = j; e = 0; } else { kind = (j - 3) >> 3; e = (j - 3) & 7; }
            const bool moe = j >= 3;
            f8 = j >= N_FF16;
            if (kind == 2) { W = (moe ? m_down : d_down) + (size_t)e * DFF * 1024; K = DFF; N = 1024; WT = moe ? (bf16*)(F.ws + WS_W_MDN + (size_t)e * 1024 * DFF) : (bf16*)(F.ws + WS_W_DDN); }
            else { W = (kind == 0 ? (moe ? m_gate : d_gate) : (moe ? m_up : d_up)) + (size_t)e * 1024 * DFF; N = DFF; WT = moe ? (bf16*)(F.ws + WS_W_MGU + (size_t)e * 5632 * 1024) : (bf16*)(F.ws + WS_W_DGU); mode = 1 + kind; gain = moe ? nullptr : g_ffn0; }
        }
        const int nsh = f8 ? 6 : 5, nblk = N >> nsh, kb = r / nblk, nb = r - kb * nblk, n0 = nb << nsh;
        const int drow0 = (mode == 0) ? n0 : (((n0 >> 7) << 8) + (n0 & 127) + (mode == 2 ? 128 : 0));
        if (f8) conv_item8(W, K, N, (unsigned char*)WT, drow0, kb * 64, n0, scr, lane, WSCALE);
        else conv_item(W, K, N, WT, drow0, kb * 64, n0, scr, lane, gain);
    }
}
constexpr int CR_PITCH = 2064;
static_assert(32 * CR_PITCH <= RING_BYTES, "convert_rows LDS");
__device__ __forceinline__ void convert_rows(Frame& F, const float* src, bf16* dst, float* ss, const float* Win, const float* gain, float* LR) {
    const int gw = F.vcu * NWAVES + F.wave, NGW = F.G * NWAVES, lane = lane_id(), r16 = lane & 15, g4 = lane >> 4, tid = F.wave * 64 + lane;
    LAS unsigned char* wl = F.lds;
    LBAR();
#pragma unroll 1
    for (int k = tid; k < DM; k += NWAVES * 64) { const GAS f32x4* wp = (const GAS f32x4*)(Win + (size_t)k * 3104 + 3072); const float gk = gain[k];
#pragma unroll
        for (int j = 0; j < 8; ++j) { const f32x4 w4 = wp[j];
#pragma unroll
            for (int e = 0; e < 4; ++e) *(LAS unsigned short*)(wl + (4 * j + e) * CR_PITCH + k * 2) = (unsigned short)(cvtpk(w4[e] * gk, 0.f) & 0xffffu); } }
    LBAR();
    for (int rg = gw; rg < NTOK / 16; rg += NGW) {
        const size_t row = (size_t)rg * 16 + r16;
        const GAS f32x4* xr = (const GAS f32x4*)(src + row * DM + 8 * g4); GAS v4u* orow = (GAS v4u*)(dst + row * DM + 8 * g4);
        f32x4 acc0 = (f32x4){0.f, 0.f, 0.f, 0.f}, acc1 = acc0; float s = 0.f;
#pragma unroll 1
        for (int kb = 0; kb < 32; kb += 8) {
            f32x4 v[8][2];
#pragma unroll
            for (int j = 0; j < 8; ++j) { v[j][0] = xr[(kb + j) * 8]; v[j][1] = xr[(kb + j) * 8 + 1]; }
#pragma unroll
            for (int j = 0; j < 8; ++j) { const int ks = kb + j; const f32x4 a = v[j][0], c = v[j][1];
                s += ((a.x * a.x + a.y * a.y) + (a.z * a.z + a.w * a.w)) + ((c.x * c.x + c.y * c.y) + (c.z * c.z + c.w * c.w));
                const v4u pk = (v4u){cvtpk(a.x, a.y), cvtpk(a.z, a.w), cvtpk(c.x, c.y), cvtpk(c.z, c.w)};
                orow[ks * 4] = pk;
                const bf16x8 af = __builtin_bit_cast(bf16x8, pk);
                const bf16x8 b0 = *(const LAS bf16x8*)(wl + r16 * CR_PITCH + (32 * ks + 8 * g4) * 2), b1 = *(const LAS bf16x8*)(wl + (16 + r16) * CR_PITCH + (32 * ks + 8 * g4) * 2);
                acc0 = mfma16(af, b0, acc0); acc1 = mfma16(af, b1, acc1); }
        }
        s += __shfl_xor(s, 16); s += __shfl_xor(s, 32);
        const float rs = 1.0f / sqrtf(s * (1.f / DM) + NORM_EPS);
        if (g4 == 0) ss[row] = rs;
#pragma unroll
        for (int r = 0; r < 4; ++r) { const float rr = __shfl(rs, 4 * g4 + r); float* lp = LR + ((size_t)rg * 16 + 4 * g4 + r) * 32 + r16; lp[0] = acc0[r] * rr; lp[16] = acc1[r] * rr; }
    }
}

__device__ __forceinline__ float logsig16(float z) { const float e = __expf(-fabsf(z)); return (fminf(z, 0.f) - __logf(1.f + e)) * 0.0625f; }
constexpr int GP_Q = 0, GP_K = 65536, GP_LR = 131072, GP_X0 = GP_LR + 8192, GP_X1 = GP_X0 + 2048;
static_assert(GP_X1 + 4096 <= LDSCTL_OFF, "gla prep LDS");
__device__ __forceinline__ void gla_prep(Frame& F) {
    typedef float f32x2 __attribute__((ext_vector_type(2)));
    LAS unsigned char* L = F.lds;
    LAS float* lrs = (LAS float*)(L + GP_LR);
    LAS f32x2* xch0 = (LAS f32x2*)(L + GP_X0);
    LAS f32x4* xch1 = (LAS f32x4*)(L + GP_X1);
    LAS unsigned* tq = (LAS unsigned*)(L + GP_Q); LAS unsigned* tk = (LAS unsigned*)(L + GP_K);
    const int lane = lane_id(), tid = F.wave * 64 + lane, ph = tid >> 8, cp = tid & 255, col = 2 * cp;
    const bf16* Q0 = (const bf16*)(F.ws + WS_Q0); const bf16* K0 = (const bf16*)(F.ws + WS_K0); const float* LR = (const float*)(F.ws + WS_LR);
    float* CC = (float*)(F.ws + WS_CC);
    f32x2 wgv[16]; f32x2 bgv = (f32x2){0.f, 0.f}; int cur_dir = -1;
#pragma unroll
    for (int r = 0; r < 16; ++r) wgv[r] = (f32x2){0.f, 0.f};
    for (int u = F.vcu; u < 2048; u += F.G) {
        const int b = u >> 8, n = (u >> 1) & 127, dir = u & 1; const size_t row0 = (size_t)b * SEQ + 64 * n;
        bf16* QEd = (bf16*)(F.ws + WS_QE) + (size_t)dir * 2 * NTOK * 512; bf16* KEd = QEd + (size_t)NTOK * 512;
        if (dir != cur_dir) {
            const float* wg = dir ? F.in[6] : F.in[4]; const float* bg = dir ? F.in[7] : F.in[5]; cur_dir = dir;
#pragma unroll
            for (int r = 0; r < 16; ++r) wgv[r] = *(const f32x2*)(wg + r * 512 + col);
            bgv = *(const f32x2*)(bg + col);
            asm volatile("s_waitcnt vmcnt(0)" ::: "memory");
        }
        const f32x4 lrn = *(const f32x4*)(LR + row0 * 32 + tid * 4);
        LBAR();
        *(LAS f32x4*)(lrs + tid * 4) = lrn;
#pragma unroll
        for (int i = 0; i < 8; ++i) {
            __builtin_amdgcn_global_load_lds((const unsigned*)((const char*)(Q0 + row0 * 512) + (i * 8 + F.wave) * 1024 + lane * 16), (LAS unsigned*)(L + GP_Q + (i * 8 + F.wave) * 1024), 16, 0, 0);
            __builtin_amdgcn_global_load_lds((const unsigned*)((const char*)(K0 + row0 * 512) + (i * 8 + F.wave) * 1024 + lane * 16), (LAS unsigned*)(L + GP_K + (i * 8 + F.wave) * 1024), 16, 0, 0); }
        LBAR();
        float bc0[32], bc1[32]; float run0 = 0.f, run1 = 0.f;
#pragma unroll
        for (int i = 0; i < 32; ++i) { const int p = 32 * ph + i; const int tok = dir ? 63 - p : p; const LAS float* lp = lrs + tok * 32 + dir * 16;
            f32x2 z = bgv;
#pragma unroll
            for (int r4 = 0; r4 < 4; ++r4) { const f32x4 l4 = *(const LAS f32x4*)(lp + 4 * r4);
#pragma unroll
                for (int k = 0; k < 4; ++k) z = __builtin_elementwise_fma((f32x2){l4[k], l4[k]}, wgv[4 * r4 + k], z); }
            run0 += logsig16(z.x); run1 += logsig16(z.y); bc0[i] = run0; bc1[i] = run1; }
        if (ph == 0) xch0[cp] = (f32x2){run0, run1};
        LBAR();
        if (ph == 1) { const f32x2 add = xch0[cp];
#pragma unroll
            for (int i = 0; i < 32; ++i) { bc0[i] += add.x; bc1[i] += add.y; }
            xch1[cp] = (f32x4){bc0[31], bc1[31], bc0[31], bc1[31]}; }
        asm volatile("s_waitcnt vmcnt(0)" ::: "memory");
        LBAR();
        const f32x4 rl = xch1[cp]; const float br0 = rl[0], br1 = rl[1], bl0 = rl[2], bl1 = rl[3];
#pragma unroll
        for (int i = 0; i < 32; ++i) { const int p = 32 * ph + i; const int tok = dir ? 63 - p : p;
            const unsigned q2 = tq[tok * 256 + cp], k2 = tk[tok * 256 + cp];
            const float e0 = __expf(bc0[i] - br0), e1 = __expf(bc1[i] - br1), i0 = __builtin_amdgcn_rcpf(e0), i1 = __builtin_amdgcn_rcpf(e1);
            tq[tok * 256 + cp] = cvtpk(bf_lo(q2) * e0, bf_hi(q2) * e1);
            tk[tok * 256 + cp] = cvtpk(bf_lo(k2) * i0, bf_hi(k2) * i1); }
        if (ph == 0) { const int c = dir ? 127 - n : n; float* rec = CC + ((size_t)(dir * 8 + b) * 128 + c) * 512;
            if (c >= 1) *(f32x2*)(rec - 512 + col) = (f32x2){__expf(bl0), __expf(bl1)}; }
        LBAR();
#pragma unroll
        for (int i = 0; i < 8; ++i) { const int off = (i * 512 + tid) * 16;
            *(v4u*)((char*)(QEd + row0 * 512) + off) = *(const LAS v4u*)(L + GP_Q + off); *(v4u*)((char*)(KEd + row0 * 512) + off) = *(const LAS v4u*)(L + GP_K + off); }
    }
}

constexpr int GS_QE = 0, GS_KE = 17408, GS_V = 34816, GS_CC = 44032, GS_BUF = 45568, GS_P = 3 * GS_BUF, GS_PB = 9216;
static_assert(GS_P + 2 * GS_PB <= LDSCTL_OFF, "gla scan LDS");
__device__ __forceinline__ void gla_scan(Frame& F) {
    const int lane = lane_id(), tid = F.wave * 64 + lane, w = F.wave, r16 = lane & 15, g4 = lane >> 4;
    LAS unsigned char* L = F.lds;
    const bf16* V0 = (const bf16*)(F.ws + WS_V0);
    for (int unit = F.vcu; unit < 256; unit += F.G) {
        const int combo = unit >> 2, dvq = unit & 3, dir = combo & 1, h = (combo >> 1) & 3, b = combo >> 3;
        const bf16* QEg = (const bf16*)(F.ws + WS_QE) + (size_t)dir * 2 * NTOK * 512; const bf16* KEg = QEg + (size_t)NTOK * 512;
        const float* CCg = (const float*)(F.ws + WS_CC) + (size_t)(dir * 8 + b) * 128 * 512;
        bf16* Og = dir ? (bf16*)((unsigned char*)F.out + OUT_OB) : (bf16*)(F.ws + WS_OF);
        v4u rqA[4], rkA[4], rvA[2], rcA, rqB[4], rkB[4], rvB[2], rcB;
        const int st = tid & 255, sqrow = st >> 4, sqch = st & 15, svrow = st >> 3, svch = st & 7, sct = st & 31;
        const long tstride = dir ? -64 : 64;
        const bf16* pQ = QEg + ((size_t)b * SEQ + (dir ? 127 * 64 : 0) + sqrow) * 512 + h * 128 + sqch * 8; const bf16* pK = pQ + (size_t)NTOK * 512;
        const bf16* pV = V0 + ((size_t)b * SEQ + (dir ? 127 * 64 : 0) + svrow) * 1024 + h * 256 + dvq * 64 + svch * 8;
        const float* pC = CCg + h * 128 + sct * 4;
#define GS_LOAD(c_, X) do { _Pragma("unroll") for (int k_ = 0; k_ < 4; ++k_) { rq##X[k_] = *(const v4u*)(pQ + k_ * 16 * 512); rk##X[k_] = *(const v4u*)(pK + k_ * 16 * 512); } \
        rv##X[0] = *(const v4u*)pV; rv##X[1] = *(const v4u*)(pV + 32 * 1024); rc##X = *(const v4u*)pC; \
        pQ += tstride * 512; pK += tstride * 512; pV += tstride * 1024; pC += 512; } while (0)
#define GS_STORE(buf_, X) do { LAS unsigned char* B_ = L + (buf_) * GS_BUF; \
        _Pragma("unroll") for (int k_ = 0; k_ < 4; ++k_) { *(LAS v4u*)(B_ + GS_QE + (sqrow + 16 * k_) * 272 + sqch * 16) = rq##X[k_]; *(LAS v4u*)(B_ + GS_KE + (sqrow + 16 * k_) * 272 + sqch * 16) = rk##X[k_]; } \
        *(LAS v4u*)(B_ + GS_V + svrow * 144 + svch * 16) = rv##X[0]; *(LAS v4u*)(B_ + GS_V + (svrow + 32) * 144 + svch * 16) = rv##X[1]; \
        if (st < 32) *(LAS v4u*)(B_ + GS_CC + st * 16) = rc##X; } while (0)
        int sit[3], sjt[3];
        { const int s2 = 2 * (w & 3); const int i0 = (123 >> s2) & 3, i1 = (27 >> s2) & 3, j0 = (48 >> s2) & 3, j1 = (21 >> s2) & 3, j2 = (26 >> s2) & 3;
          sit[0] = dir ? 3 - i0 : i0; sit[1] = dir ? 3 - i1 : i1; sit[2] = sit[1]; sjt[0] = dir ? 3 - j0 : j0; sjt[1] = dir ? 3 - j1 : j1; sjt[2] = dir ? 3 - j2 : j2; }
        bool skeep[4];
#pragma unroll
        for (int r = 0; r < 4; ++r) { const int j_ = 4 * g4 + r; skeep[r] = dir ? (j_ > r16) : (j_ <= r16); }
#define GS_SCORES(tb_, pb_) do { const LAS unsigned char* B_ = L + (tb_) * GS_BUF; LAS unsigned char* P_ = L + GS_P + (pb_) * GS_PB; \
        bf16x8 qf_[2][4], kf_[3][4];                                         \
        _Pragma("unroll") for (int k_ = 0; k_ < 3; ++k_) _Pragma("unroll") for (int ks = 0; ks < 4; ++ks) { \
            if (k_ < 2) qf_[k_][ks] = *(const LAS bf16x8*)(B_ + GS_QE + (16 * sit[k_] + r16) * 272 + ks * 64 + g4 * 16); kf_[k_][ks] = *(const LAS bf16x8*)(B_ + GS_KE + (16 * sjt[k_] + r16) * 272 + ks * 64 + g4 * 16); } \
        __builtin_amdgcn_sched_barrier(0); \
        f32x4 pa_[3]; \
        _Pragma("unroll") for (int k_ = 0; k_ < 3; ++k_) { pa_[k_] = (f32x4){0.f, 0.f, 0.f, 0.f}; _Pragma("unroll") for (int ks = 0; ks < 4; ++ks) pa_[k_] = mfma16(kf_[k_][ks], qf_[k_ < 2 ? k_ : 1][ks], pa_[k_]); } \
        _Pragma("unroll") for (int k_ = 0; k_ < 3; ++k_) { const bool diag_ = sit[k_] == sjt[k_]; \
            _Pragma("unroll") for (int r = 0; r < 4; ++r) pa_[k_][r] = (diag_ && !skeep[r]) ? 0.f : pa_[k_][r]; \
            *(LAS u32x2*)(P_ + (16 * sit[k_] + r16) * 144 + (16 * sjt[k_] + 4 * g4) * 2) = (u32x2){cvtpk(pa_[k_][0], pa_[k_][1]), cvtpk(pa_[k_][2], pa_[k_][3])}; } } while (0)
        LBAR();
#define GS_STEP_SCORE(cc, XS, XL) do { const int c = (cc); const int tbn = (c + 1) % 3, tbw = (c + 2) % 3, pb = c & 1; \
            GS_LOAD(c + 3, XL); if (c + 1 < 128) GS_SCORES(tbn, pb ^ 1); GS_STORE(tbw, XS); LBAR(); } while (0)
#define GS_STEP_STATE(cc) do { const int c = (cc); const int tb = c % 3, pb = c & 1; \
            const LAS unsigned char* B = L + tb * GS_BUF; const LAS unsigned char* P = L + GS_P + pb * GS_PB; \
            const int orig = dir ? 127 - c : c; const size_t row0 = (size_t)b * SEQ + 64 * orig; \
              \
            bf16x8 vf[2]; u32x4 qe[2][2][4]; bf16x8 pf[2][2][2]; bf16x8 kt[2][2][2]; f32x4 decn[2][2]; \
_Pragma("unroll")             for (int kk = 0; kk < 2; ++kk) { const LAS unsigned char* a = B + GS_V + (32 * kk + 8 * g4 + (r16 >> 2)) * 144 + (16 * w + 4 * (r16 & 3)) * 2; vf[kk] = cat8(ldtr(a), ldtr(a + 4 * 144)); } \
            GS_RD_A(0); GS_RD_A(1); GS_RD_B(0, 0); \
            __builtin_amdgcn_sched_barrier(0); \
            GS_CMP_A(0); __builtin_amdgcn_sched_barrier(0); \
            GS_CMP_A(1); __builtin_amdgcn_sched_barrier(0); \
            GS_RD_B(1, 1); __builtin_amdgcn_sched_barrier(0); GS_CMP_B(0, 0); __builtin_amdgcn_sched_barrier(0); \
            GS_RD_B(2, 0); __builtin_amdgcn_sched_barrier(0); GS_CMP_B(1, 1); __builtin_amdgcn_sched_barrier(0); \
            GS_RD_B(3, 1); __builtin_amdgcn_sched_barrier(0); GS_CMP_B(2, 0); __builtin_amdgcn_sched_barrier(0); \
            GS_CMP_B(3, 1); \
            LBAR(); } while (0)
#define GS_RD_A(ih) do { _Pragma("unroll") for (int i2 = 0; i2 < 2; ++i2) { const int it = 2 * (ih) + i2; \
_Pragma("unroll")                 for (int ks = 0; ks < 4; ++ks) { const LAS unsigned char* qa = B + GS_QE + (16 * it + r16) * 272 + (32 * ks + 4 * g4) * 2; \
                    const u32x2 q0 = *(const LAS u32x2*)qa, q1 = *(const LAS u32x2*)(qa + 32); qe[ih][i2][ks] = (u32x4){q0.x, q0.y, q1.x, q1.y}; } \
_Pragma("unroll")                 for (int kk = 0; kk < 2; ++kk) pf[ih][i2][kk] = *(const LAS bf16x8*)(P + (16 * it + r16) * 144 + (32 * kk + 8 * g4) * 2); } } while (0)
#define GS_CMP_A(ih) do { _Pragma("unroll") for (int i2 = 0; i2 < 2; ++i2) { const int it = 2 * (ih) + i2; f32x4 o = (f32x4){0.f, 0.f, 0.f, 0.f}; \
_Pragma("unroll")                 for (int ks = 0; ks < 4; ++ks) o = mfma16(sbf[ks], __builtin_bit_cast(bf16x8, qe[ih][i2][ks]), o); \
_Pragma("unroll")                 for (int kk = 0; kk < 2; ++kk) o = mfma16(vf[kk], pf[ih][i2][kk], o); \
                { u32x2* op_ = (u32x2*)(Og + (row0 + 16 * it + r16) * 1024 + h * 256 + dvq * 64 + 16 * w + 4 * g4); const u32x2 ov_ = (u32x2){cvtpk(o[0], o[1]), cvtpk(o[2], o[3])}; *op_ = ov_; } } } while (0)
#define GS_RD_B(ks, s_) do { _Pragma("unroll") for (int d = 0; d < 2; ++d) { const int dkt = 2 * (ks) + d; \
_Pragma("unroll")                 for (int kk = 0; kk < 2; ++kk) { const LAS unsigned char* a = B + GS_KE + (32 * kk + 8 * g4 + (r16 >> 2)) * 272 + (16 * dkt + 4 * (r16 & 3)) * 2; kt[s_][d][kk] = cat8(ldtr(a), ldtr(a + 4 * 272)); } \
                decn[s_][d] = *(const LAS f32x4*)(B + GS_CC + (16 * dkt + 4 * g4) * 4); } } while (0)
#define GS_CMP_B(ks, s_) do { u32x2 sw[2]; \
_Pragma("unroll")             for (int d = 0; d < 2; ++d) { const int dkt = 2 * (ks) + d; f32x4 ua = (f32x4){0.f, 0.f, 0.f, 0.f}; \
_Pragma("unroll")                 for (int kk = 0; kk < 2; ++kk) ua = mfma16(kt[s_][d][kk], vf[kk], ua); \
                sacc[dkt] = (sacc[dkt] + ua) * decn[s_][d]; \
                const f32x4 sb = sacc[dkt]; sw[d] = (u32x2){cvtpk(sb[0], sb[1]), cvtpk(sb[2], sb[3])}; } \
            sbf[ks] = __builtin_bit_cast(bf16x8, (u32x4){sw[0].x, sw[0].y, sw[1].x, sw[1].y}); } while (0)
        if (w >= 4) {
            GS_LOAD(0, A); GS_LOAD(1, B);
            for (int o = st * 16; o < 2 * GS_PB; o += 4096) *(LAS v4u*)(L + GS_P + o) = (v4u){0u, 0u, 0u, 0u};
            GS_STORE(0, A); GS_STORE(1, B); GS_LOAD(2, A);
            LBAR();
            GS_SCORES(0, 0);
            LBAR();
            for (int c2 = 0; c2 < 128; c2 += 2) { GS_STEP_SCORE(c2, A, B); GS_STEP_SCORE(c2 + 1, B, A); }
        } else {
            f32x4 sacc[8]; bf16x8 sbf[4];
#pragma unroll
            for (int d = 0; d < 8; ++d) sacc[d] = (f32x4){0.f, 0.f, 0.f, 0.f};
#pragma unroll
            for (int ks = 0; ks < 4; ++ks) sbf[ks] = (bf16x8){0, 0, 0, 0, 0, 0, 0, 0};
            LBAR();
            LBAR();
            for (int c2 = 0; c2 < 128; ++c2) GS_STEP_STATE(c2);
        }
#undef GS_STEP_SCORE
#undef GS_STEP_STATE
#undef GS_RD_A
#undef GS_CMP_A
#undef GS_RD_B
#undef GS_CMP_B
#undef GS_LOAD
#undef GS_STORE
#undef GS_SCORES
    }
}

__device__ __forceinline__ void gla_post(Frame& F) {
    const int gw = F.vcu * NWAVES + F.wave, NGW = F.G * NWAVES, lane = lane_id();
    const bf16* OFp = (const bf16*)(F.ws + WS_OF); const bf16* OBp = (const bf16*)((const unsigned char*)F.out + OUT_OB); const bf16* R0 = (const bf16*)(F.ws + WS_R0); bf16* Gp = (bf16*)(F.ws + WS_G);
    float gn[16];
#pragma unroll
    for (int j = 0; j < 4; ++j) { const f32x4 t = *(const f32x4*)(F.in[8] + 16 * lane + 4 * j); gn[4 * j] = t.x; gn[4 * j + 1] = t.y; gn[4 * j + 2] = t.z; gn[4 * j + 3] = t.w; }
    v4u nx[6];
    if (gw < NTOK) { const size_t off = (size_t)gw * 1024 + 16 * lane; nx[0] = *(const v4u*)(OFp + off); nx[1] = *(const v4u*)(OFp + off + 8); nx[2] = *(const v4u*)(OBp + off); nx[3] = *(const v4u*)(OBp + off + 8); nx[4] = *(const v4u*)(R0 + off); nx[5] = *(const v4u*)(R0 + off + 8); }
    for (int m = gw; m < NTOK; m += NGW) {
        const size_t off = (size_t)m * 1024 + 16 * lane;
        const v4u a0 = nx[0], a1 = nx[1], b0 = nx[2], b1 = nx[3], r0 = nx[4], r1 = nx[5];
        { const int mn = (m + NGW < NTOK) ? m + NGW : m; const size_t offn = (size_t)mn * 1024 + 16 * lane;
          nx[0] = *(const v4u*)(OFp + offn); nx[1] = *(const v4u*)(OFp + offn + 8); nx[2] = *(const v4u*)(OBp + offn); nx[3] = *(const v4u*)(OBp + offn + 8); nx[4] = *(const v4u*)(R0 + offn); nx[5] = *(const v4u*)(R0 + offn + 8); }
        float o[16], rr[16]; float ss = 0.f;
#pragma unroll
        for (int j = 0; j < 4; ++j) { o[2 * j] = bf_lo(a0[j]) + bf_lo(b0[j]); o[2 * j + 1] = bf_hi(a0[j]) + bf_hi(b0[j]); o[8 + 2 * j] = bf_lo(a1[j]) + bf_lo(b1[j]); o[8 + 2 * j + 1] = bf_hi(a1[j]) + bf_hi(b1[j]);
            rr[2 * j] = bf_lo(r0[j]); rr[2 * j + 1] = bf_hi(r0[j]); rr[8 + 2 * j] = bf_lo(r1[j]); rr[8 + 2 * j + 1] = bf_hi(r1[j]); }
#pragma unroll
        for (int j = 0; j < 16; ++j) ss += o[j] * o[j];
        ss += __shfl_xor(ss, 1); ss += __shfl_xor(ss, 2); ss += __shfl_xor(ss, 4); ss += __shfl_xor(ss, 8);
        const float rs = 1.0f / sqrtf(ss * (1.f / 256.f) + NORM_EPS);
        float y[16];
#pragma unroll
        for (int j = 0; j < 16; ++j) y[j] = o[j] * rs * gn[j] * pg8::silu_f(rr[j]);
        v4u w0, w1;
#pragma unroll
        for (int j = 0; j < 4; ++j) { w0[j] = cvtpk(y[2 * j], y[2 * j + 1]); w1[j] = cvtpk(y[8 + 2 * j], y[8 + 2 * j + 1]); }
        *(v4u*)(Gp + off) = w0; *(v4u*)(Gp + off + 8) = w1;
    }
}

constexpr int AT_K = 0, AT_V = 55296, AT_STRIDE = 144;
static_assert(2 * 55296 <= RING_BYTES, "attention LDS");
__device__ __forceinline__ void swa_attn(Frame& F) {
    const int lane = lane_id(), tid = F.wave * 64 + lane, w = F.wave, r16 = lane & 15, g4 = lane >> 4;
    LAS unsigned char* L = F.lds + RING_OFF;
    const bf16* Q1 = (const bf16*)(F.ws + WS_Q1); const bf16* K1 = (const bf16*)(F.ws + WS_K1); const bf16* V1 = (const bf16*)(F.ws + WS_V1); bf16* O1 = (bf16*)(F.ws + WS_O1);
    v4u kr[6], vr[6];
#define AT_FETCH(u_) do { const int b_ = (u_) >> 8, g_ = ((u_) >> 6) & 3, kb_ = (((u_) & 63) - 1) * 128; \
        _Pragma("unroll") for (int i = 0; i < 6; ++i) { const int piece = tid + 512 * i, row = piece >> 3, ch = piece & 7; int tok = kb_ + row; tok = tok < 0 ? 0 : (tok >= SEQ ? SEQ - 1 : tok); \
            const size_t go = ((size_t)b_ * SEQ + tok) * 256 + g_ * 64 + ch * 8; kr[i] = *(const v4u*)(K1 + go); vr[i] = *(const v4u*)(V1 + go); } } while (0)
    if (F.vcu < 2048) AT_FETCH(F.vcu);
    for (int u = F.vcu; u < 2048; u += F.G) {
        const int b = u >> 8, g = (u >> 6) & 3, nb = u & 63;
        const int kbase = (nb - 1) * 128;
        LBAR();
#pragma unroll
        for (int i = 0; i < 6; ++i) { const int piece = tid + 512 * i, row = piece >> 3, ch = piece & 7;
            *(LAS v4u*)(L + AT_K + row * AT_STRIDE + ch * 16) = kr[i]; *(LAS v4u*)(L + AT_V + row * AT_STRIDE + ch * 16) = vr[i]; }
        const int hq = 4 * g + (w >> 1), q0w = nb * 128 + 64 * (w & 1);
        bf16x8 qfa[4][2];
#pragma unroll
        for (int qt = 0; qt < 4; ++qt)
#pragma unroll
            for (int ks = 0; ks < 2; ++ks) qfa[qt][ks] = *(const bf16x8*)(Q1 + ((size_t)b * SEQ + q0w + 16 * qt + r16) * 1024 + hq * 64 + 32 * ks + 8 * g4);
        { const int un = (u + F.G < 2048) ? u + F.G : u; AT_FETCH(un); }
        const float slope = exp2f(-0.5f * (float)(hq + 1)) * LOG2E, sink2 = F.in[12][hq] * LOG2E;
        const float clf = (float)(r16 - 4 * g4);
        LBAR();
        for (int pass = 0; pass < 2; ++pass) {
            const int q0 = q0w + 32 * pass;
            bf16x8 qf[2][2];
#pragma unroll
            for (int qt = 0; qt < 2; ++qt)
#pragma unroll
                for (int ks = 0; ks < 2; ++ks) qf[qt][ks] = pass ? qfa[2 + qt][ks] : qfa[qt][ks];
            float mrun[2], lrun[2]; f32x4 oacc[2][4];
#pragma unroll
            for (int qt = 0; qt < 2; ++qt) { mrun[qt] = sink2; lrun[qt] = (g4 == 0) ? 1.f : 0.f;
#pragma unroll
                for (int dt = 0; dt < 4; ++dt) oacc[qt][dt] = (f32x4){0.f, 0.f, 0.f, 0.f}; }
            for (int t = 0; t < 9; ++t) {
                const int ktok0 = q0 - 128 + 32 * t, s0 = ktok0 - kbase;
                if (ktok0 < 0 || ktok0 >= SEQ) continue;
                bf16x8 kf[2][2];
#pragma unroll
                for (int sub = 0; sub < 2; ++sub)
#pragma unroll
                    for (int ks = 0; ks < 2; ++ks) kf[sub][ks] = *(const LAS bf16x8*)(L + AT_K + (s0 + 16 * sub + r16) * AT_STRIDE + ks * 64 + g4 * 16);
                bf16x8 vf[4];
#pragma unroll
                for (int dt = 0; dt < 4; ++dt) { const LAS unsigned char* a = L + AT_V + (s0 + 4 * g4 + (r16 >> 2)) * AT_STRIDE + (16 * dt + 4 * (r16 & 3)) * 2; vf[dt] = cat8(ldtr(a), ldtr(a + 16 * AT_STRIDE)); }
#pragma unroll
                for (int qt = 0; qt < 2; ++qt) {
                    f32x4 s[2];
#pragma unroll
                    for (int sub = 0; sub < 2; ++sub) { s[sub] = (f32x4){0.f, 0.f, 0.f, 0.f};
#pragma unroll
                        for (int ks = 0; ks < 2; ++ks) s[sub] = mfma16(kf[sub][ks], qf[qt][ks], s[sub]); }
                    const int d0 = 128 - 32 * t + 16 * qt; float mx = -INFINITY;
                    if ((d0 >= 31 && d0 <= 113) || (d0 <= -15 && d0 >= -97)) {
                        const float sg = d0 > 0 ? -slope : slope, b0 = -slope * (float)(d0 > 0 ? d0 : -d0) + sg * clf;
#pragma unroll
                        for (int sub = 0; sub < 2; ++sub)
#pragma unroll
                            for (int r = 0; r < 4; ++r) { const float v = s[sub][r] + (b0 - sg * (float)(16 * sub + r)); s[sub][r] = v; mx = fmaxf(mx, v); }
                    } else {
                        const float dlf = clf + (float)d0;
#pragma unroll
                        for (int sub = 0; sub < 2; ++sub)
#pragma unroll
                            for (int r = 0; r < 4; ++r) { const float ad = __builtin_fabsf(dlf - (float)(16 * sub + r));
                                float v = __builtin_fmaf(-slope, ad, s[sub][r]); v = (ad > 128.0f) ? -INFINITY : v; s[sub][r] = v; mx = fmaxf(mx, v); }
                    }
                    if (__any(mx > mrun[qt] + 6.0f)) {
                        mx = fmaxf(mx, __shfl_xor(mx, 16)); mx = fmaxf(mx, __shfl_xor(mx, 32));
                        const float mnew = fmaxf(mrun[qt], mx), alpha = __builtin_amdgcn_exp2f(mrun[qt] - mnew); mrun[qt] = mnew; lrun[qt] *= alpha;
#pragma unroll
                        for (int dt = 0; dt < 4; ++dt) oacc[qt][dt] = oacc[qt][dt] * alpha;
                    }
                    const float off = -mrun[qt]; float ps = 0.f;
#pragma unroll
                    for (int sub = 0; sub < 2; ++sub)
#pragma unroll
                        for (int r = 0; r < 4; ++r) { const float p = __builtin_amdgcn_exp2f(s[sub][r] + off); s[sub][r] = p; ps += p; }
                    lrun[qt] += ps;
                    const u32x4 pw = (u32x4){cvtpk(s[0][0], s[0][1]), cvtpk(s[0][2], s[0][3]), cvtpk(s[1][0], s[1][1]), cvtpk(s[1][2], s[1][3])};
#pragma unroll
                    for (int dt = 0; dt < 4; ++dt) oacc[qt][dt] = mfma16(vf[dt], __builtin_bit_cast(bf16x8, pw), oacc[qt][dt]);
                }
            }
#pragma unroll
            for (int qt = 0; qt < 2; ++qt) { float l = lrun[qt]; l += __shfl_xor(l, 16); l += __shfl_xor(l, 32); const float inv = 1.0f / l;
                bf16* op = O1 + ((size_t)b * SEQ + q0 + 16 * qt + r16) * 1024 + hq * 64 + 4 * g4;
#pragma unroll
                for (int dt = 0; dt < 4; ++dt) { const f32x4 o = oacc[qt][dt] * inv; *(u32x2*)(op + 16 * dt) = (u32x2){cvtpk(o[0], o[1]), cvtpk(o[2], o[3])}; } }
        }
    }
}

#undef AT_FETCH
__device__ __forceinline__ void moe_route(Frame& F, const bf16* HB, const float* ssp, const float* gain) {
    const int gw = F.vcu * NWAVES + F.wave, NGW = F.G * NWAVES, lane = lane_id();
    unsigned char* XN = F.ws + WS_XN; int* sel = (int*)(F.ws + WS_SEL); float* wsel = (float*)(F.ws + WS_WSEL); int* wcnt = (int*)(F.ws + WS_WCNT);
    const float* router = F.in[18];
    f32x4 g[4]; f32x4 rt[4][4][2];
#pragma unroll
    for (int j = 0; j < 4; ++j) { g[j] = ((const f32x4*)gain)[lane + 64 * j];
#pragma unroll
        for (int i = 0; i < 4; ++i) { const float* rp = router + (size_t)(256 * j + 4 * lane + i) * 8; rt[j][i][0] = *(const f32x4*)rp; rt[j][i][1] = *(const f32x4*)(rp + 4); } }
    int cnt[8];
#pragma unroll
    for (int e = 0; e < 8; ++e) cnt[e] = 0;
    u32x2 hvn[4]; float sn = 0.f;
    if (gw < NTOK) { const GAS u32x2* xr = (const GAS u32x2*)(HB + (size_t)gw * DM) + lane;
#pragma unroll
        for (int j = 0; j < 4; ++j) hvn[j] = xr[64 * j];
        sn = ssp[(size_t)gw * 16 + (lane & 15)]; }
    for (int m = gw; m < NTOK; m += NGW) {
        u32x2 hvc[4]; float s = sn;
#pragma unroll
        for (int j = 0; j < 4; ++j) hvc[j] = hvn[j];
        { const int mn = (m + NGW < NTOK) ? m + NGW : m; const GAS u32x2* xr = (const GAS u32x2*)(HB + (size_t)mn * DM) + lane;
#pragma unroll
          for (int j = 0; j < 4; ++j) hvn[j] = xr[64 * j];
          sn = ssp[(size_t)mn * 16 + (lane & 15)]; }
        s += __shfl_xor(s, 1); s += __shfl_xor(s, 2); s += __shfl_xor(s, 4); s += __shfl_xor(s, 8);
        const float rs = 1.0f / sqrtf(s * (1.f / DM) + NORM_EPS);
        GAS unsigned* o4 = (GAS unsigned*)(XN + (size_t)m * DM) + lane;
        float lg[8];
#pragma unroll
        for (int e = 0; e < 8; ++e) lg[e] = 0.f;
#pragma unroll
        for (int j = 0; j < 4; ++j) { const u32x2 hv = hvc[j]; const f32x4 v = (f32x4){bf_lo(hv.x), bf_hi(hv.x), bf_lo(hv.y), bf_hi(hv.y)};
            const f32x4 o = v * rs * g[j]; o4[64 * j] = pk4f8(o.x * XSCALE, o.y * XSCALE, o.z * XSCALE, o.w * XSCALE);
#pragma unroll
            for (int i = 0; i < 4; ++i)
#pragma unroll
                for (int e = 0; e < 8; ++e) lg[e] += o[i] * rt[j][i][e >> 2][e & 3]; }
#pragma unroll
        for (int e = 0; e < 8; ++e) lg[e] = wave_sum(lg[e]);
        int e0 = 0; float l0 = lg[0];
#pragma unroll
        for (int e = 1; e < 8; ++e) if (lg[e] > l0) { l0 = lg[e]; e0 = e; }
        int e1 = -1; float l1 = -INFINITY;
#pragma unroll
        for (int e = 0; e < 8; ++e) if (e != e0 && lg[e] > l1) { l1 = lg[e]; e1 = e; }
        const float w0 = 1.0f / (1.0f + __expf(l1 - l0)), w1 = 1.0f - w0;
        int rk0 = 0, rk1 = 0;
#pragma unroll
        for (int e = 0; e < 8; ++e) { rk0 = (e0 == e) ? cnt[e] : rk0; rk1 = (e1 == e) ? cnt[e] : rk1; cnt[e] += ((e0 == e) ? 1 : 0) + ((e1 == e) ? 1 : 0); }
        if (lane == 0) { *(int4*)(sel + (size_t)m * 4) = make_int4(e0, e1, rk0, rk1); *(float2*)(wsel + (size_t)m * 2) = make_float2(w0, w1); }
    }
    if (lane < 8) { int cv = 0;
#pragma unroll
        for (int e = 0; e < 8; ++e) cv = (lane == e) ? cnt[e] : cv;
        wcnt[(size_t)gw * 8 + lane] = cv; }
}
__device__ __forceinline__ void moe_gather(Frame& F) {
    const int gw = F.vcu * NWAVES + F.wave, NGW = F.G * NWAVES, lane = lane_id();
    const unsigned char* XN = F.ws + WS_XN; unsigned char* XS = F.ws + WS_XS;
    const int* sel = (const int*)(F.ws + WS_SEL); const float* wsel = (const float*)(F.ws + WS_WSEL); const int* wcnt = (const int*)(F.ws + WS_WCNT);
    int* postok = (int*)(F.ws + WS_POSTOK); float* roww = (float*)(F.ws + WS_ROWW); int* meta = (int*)(F.ws + WS_META);
    int base[8], tot[8];
#pragma unroll
    for (int e = 0; e < 8; ++e) { base[e] = 0; tot[e] = 0; }
    for (int w0 = lane; w0 < NGW; w0 += 64 * 8) {
        int4 av[8], cv[8];
#pragma unroll
        for (int j = 0; j < 8; ++j) { const int w2 = w0 + 64 * j, wc = (w2 < NGW) ? w2 : lane; av[j] = *(const int4*)(wcnt + (size_t)wc * 8); cv[j] = *(const int4*)(wcnt + (size_t)wc * 8 + 4); }
#pragma unroll
        for (int j = 0; j < 8; ++j) { const int w2 = w0 + 64 * j; const int vz = (w2 < NGW) ? 1 : 0, lt = (w2 < gw) ? vz : 0; const int4 a = av[j], c = cv[j];
            tot[0] += vz * a.x; tot[1] += vz * a.y; tot[2] += vz * a.z; tot[3] += vz * a.w; tot[4] += vz * c.x; tot[5] += vz * c.y; tot[6] += vz * c.z; tot[7] += vz * c.w;
            base[0] += lt * a.x; base[1] += lt * a.y; base[2] += lt * a.z; base[3] += lt * a.w; base[4] += lt * c.x; base[5] += lt * c.y; base[6] += lt * c.z; base[7] += lt * c.w; } }
    int ts[9]; ts[0] = 0;
#pragma unroll
    for (int e = 0; e < 8; ++e) { tot[e] = wave_sum_i(tot[e]); base[e] = wave_sum_i(base[e]); ts[e + 1] = ts[e] + ((tot[e] + 255) >> 8); base[e] += ts[e] * 256; }
    if (gw == 0 && lane < 9) { int tv = 0;
#pragma unroll
        for (int e = 0; e < 9; ++e) tv = (lane == e) ? ts[e] : tv;
        meta[lane] = tv; }
    for (int m0 = gw; m0 < NTOK; m0 += 4 * NGW) {
        int4 sv[4]; float2 wv[4]; v4u a0[4];
#pragma unroll
        for (int j = 0; j < 4; ++j) { const int m = (m0 + j * NGW < NTOK) ? m0 + j * NGW : m0;
            sv[j] = *(const int4*)(sel + (size_t)m * 4); wv[j] = *(const float2*)(wsel + (size_t)m * 2); a0[j] = *(const v4u*)(XN + (size_t)m * 1024 + 16 * lane); }
#pragma unroll
        for (int j = 0; j < 4; ++j) { const int m = m0 + j * NGW; if (m < NTOK) {
            int p0 = 0, p1 = 0;
#pragma unroll
            for (int e = 0; e < 8; ++e) { p0 = (sv[j].x == e) ? base[e] : p0; p1 = (sv[j].y == e) ? base[e] : p1; }
            p0 += sv[j].z; p1 += sv[j].w;
            *(v4u*)(XS + (size_t)p0 * 1024 + 16 * lane) = a0[j]; *(v4u*)(XS + (size_t)p1 * 1024 + 16 * lane) = a0[j];
            if (lane == 0) { roww[p0] = wv[j].x; roww[p1] = wv[j].y; *(int2*)(postok + (size_t)m * 2) = make_int2(p0, p1); } } }
    }
}
__device__ __forceinline__ bool fr_deferred(const LAS unsigned* bm, int2 pp) { return (((bm[pp.x >> 13] >> ((pp.x >> 8) & 31)) | (bm[pp.y >> 13] >> ((pp.y >> 8) & 31))) & 1u) != 0u; }
template <int MODE> __device__ __forceinline__ void final_rows(Frame& F, const bf16* HB, float* out, const float* gain, int gw, int NGW, const LAS unsigned* bm) {
    const int lane = lane_id();
    const bf16* Y = (const bf16*)(F.ws + WS_XS); const int* postok = (const int*)(F.ws + WS_POSTOK);
    f32x4 g[4];
#pragma unroll
    for (int j = 0; j < 4; ++j) g[j] = ((const f32x4*)gain)[lane + 64 * j];
    if constexpr (MODE == 2) {
        for (int mb = gw; mb < NTOK; mb += 64 * NGW) {
          const int ml = mb + lane * NGW; int2 ppl = make_int2(0, 0); bool dl = false;
          if (ml < NTOK) { ppl = *(const int2*)(postok + (size_t)ml * 2); dl = fr_deferred(bm, ppl); }
          unsigned long long todo = __ballot(dl);
          while (todo) { const int l = __builtin_ctzll(todo); todo &= todo - 1ull; const int m = mb + l * NGW; const int2 pp = make_int2(__shfl(ppl.x, l), __shfl(ppl.y, l));
            const GAS u32x2* hr = (const GAS u32x2*)(HB + (size_t)m * DM) + lane; const u32x2* y0 = (const u32x2*)(Y + (size_t)pp.x * 1024) + lane; const u32x2* y1 = (const u32x2*)(Y + (size_t)pp.y * 1024) + lane;
            GAS f32x4* xr = (GAS f32x4*)(out + (size_t)m * DM) + lane;
            f32x4 v[4]; float s = 0.f;
#pragma unroll
            for (int j = 0; j < 4; ++j) { const u32x2 h2 = hr[64 * j], a = y0[64 * j], c = y1[64 * j];
                v[j].x = bf_lo(h2.x) + bf_lo(a.x) + bf_lo(c.x); v[j].y = bf_hi(h2.x) + bf_hi(a.x) + bf_hi(c.x); v[j].z = bf_lo(h2.y) + bf_lo(a.y) + bf_lo(c.y); v[j].w = bf_hi(h2.y) + bf_hi(a.y) + bf_hi(c.y);
                s += (v[j].x * v[j].x + v[j].y * v[j].y) + (v[j].z * v[j].z + v[j].w * v[j].w); }
            const float rs = 1.0f / sqrtf(wave_sum(s) * (1.f / DM) + NORM_EPS);
#pragma unroll
            for (int j = 0; j < 4; ++j) xr[64 * j] = v[j] * rs * g[j];
          }
        }
        return;
    }
    u32x2 hv[4], ya[4], yc[4]; int2 ppn = make_int2(0, 0), ppc = make_int2(0, 0);
    if (gw < NTOK) { const int2 pp = *(const int2*)(postok + (size_t)gw * 2); ppc = pp;
        const GAS u32x2* hr = (const GAS u32x2*)(HB + (size_t)gw * DM) + lane; const u32x2* y0 = (const u32x2*)(Y + (size_t)pp.x * 1024) + lane; const u32x2* y1 = (const u32x2*)(Y + (size_t)pp.y * 1024) + lane;
#pragma unroll
        for (int j = 0; j < 4; ++j) { hv[j] = hr[64 * j]; ya[j] = y0[64 * j]; yc[j] = y1[64 * j]; }
        const int m1 = (gw + NGW < NTOK) ? gw + NGW : gw; ppn = *(const int2*)(postok + (size_t)m1 * 2); }
    for (int m = gw; m < NTOK; m += NGW) {
        u32x2 hvc[4], yac[4], ycc[4]; const int2 pcur = ppc;
#pragma unroll
        for (int j = 0; j < 4; ++j) { hvc[j] = hv[j]; yac[j] = ya[j]; ycc[j] = yc[j]; }
        { const int m1 = (m + NGW < NTOK) ? m + NGW : m, m2 = (m + 2 * NGW < NTOK) ? m + 2 * NGW : m; const int2 pp = ppn; ppc = pp;
          const GAS u32x2* hr = (const GAS u32x2*)(HB + (size_t)m1 * DM) + lane; const u32x2* y0 = (const u32x2*)(Y + (size_t)pp.x * 1024) + lane; const u32x2* y1 = (const u32x2*)(Y + (size_t)pp.y * 1024) + lane;
#pragma unroll
          for (int j = 0; j < 4; ++j) { hv[j] = hr[64 * j]; ya[j] = y0[64 * j]; yc[j] = y1[64 * j]; }
          ppn = *(const int2*)(postok + (size_t)m2 * 2); }
        if (MODE == 1 && fr_deferred(bm, pcur)) continue;
        GAS f32x4* xr = (GAS f32x4*)(out + (size_t)m * DM) + lane;
        f32x4 v[4]; float s = 0.f;
#pragma unroll
        for (int j = 0; j < 4; ++j) { const u32x2 h2 = hvc[j], a = yac[j], c = ycc[j];
            v[j].x = bf_lo(h2.x) + bf_lo(a.x) + bf_lo(c.x); v[j].y = bf_hi(h2.x) + bf_hi(a.x) + bf_hi(c.x); v[j].z = bf_lo(h2.y) + bf_lo(a.y) + bf_lo(c.y); v[j].w = bf_hi(h2.y) + bf_hi(a.y) + bf_hi(c.y);
            s += (v[j].x * v[j].x + v[j].y * v[j].y) + (v[j].z * v[j].z + v[j].w * v[j].w); }
        const float rs = 1.0f / sqrtf(wave_sum(s) * (1.f / DM) + NORM_EPS);
#pragma unroll
        for (int j = 0; j < 4; ++j) xr[64 * j] = v[j] * rs * g[j];
    }
}

struct Args { const float* in[23]; float* out; unsigned char* ws; int ph_lo, ph_hi; };
__global__ void __launch_bounds__(NWAVES * 64, 2) fwd_kernel(Args args) {
    extern __shared__ __attribute__((aligned(16))) unsigned char lds[];
    Frame F;
    F.lds = (LAS unsigned char*)lds;
    F.MISC = (volatile LAS unsigned*)(F.lds + MISC_OFF);
    F.wave = __builtin_amdgcn_readfirstlane((int)threadIdx.x >> 6);
    F.G = gridDim.x; { const int bx = blockIdx.x; F.vcu = (F.G % 8 == 0) ? (bx % 8) * (F.G / 8) + bx / 8 : bx; }
    F.ws = args.ws; F.out = args.out;
    F.in = args.in;
    for (int u = F.wave * 64 + lane_id(); u < (LDS_BYTES - LDSCTL_OFF) / 4; u += NWAVES * 64) ((LAS unsigned*)(F.lds + LDSCTL_OFF))[u] = 0u;
    __syncthreads();
    const int lo = args.ph_lo, hi = args.ph_hi;
    if (hi - lo > 1) (void)xcd_barrier_post((unsigned*)(F.ws + WS_CTL) + CW_BAR, F.MISC + 8, (F.wave == 0 && lane_id() == 0) ? 1u : 0u);
#define MKBAR() do { XcdBarrier bar_; bar_.bar = (unsigned*)(F.ws + WS_CTL) + CW_BAR; bar_.x = xb_xcc_id(); bar_.st = (volatile LAS unsigned*)(F.lds + MISC_OFF) + 8; bar_.t0 = (F.wave == 0 && lane_id() == 0) ? 1u : 0u; xcd_barrier(bar_); } while (0)
#ifndef MK_PHASE_MASK
#define MK_PHASE_MASK 0xFFFFu
#endif
#define IN(k) (((MK_PHASE_MASK >> (k)) & 1u) && lo <= (k) && (k) < hi)
#ifndef MK_BAR_REP
#define MK_BAR_REP 1
#endif
#define SEAM(k) do { if (IN(k) && IN((k) + 1)) { _Pragma("nounroll") for (int r_ = 0; r_ < MK_BAR_REP; ++r_) MKBAR(); } } while (0)
    bf16* XB = (bf16*)((unsigned char*)F.out + OUT_XB); bf16* HB = (bf16*)(F.ws + WS_HB);

#define PH0 do { p0_weights(F, args.in[3], args.in[9], args.in[10], args.in[13], args.in[15], args.in[16], args.in[17], args.in[19], args.in[20], args.in[21], F.in[1], F.in[2], F.in[1] + DM); \
        convert_rows(F, F.in[0], XB, (float*)(F.ws + WS_SS0), args.in[3], F.in[1], (float*)(F.ws + WS_LR)); } while (0)
#define PH1 do { pg8::Gemm g{XB, (const bf16*)(F.ws + WS_W_GLAIN), NTOK, 3072, 1024}; pg8::StaticOrder S0; S0.init(NTOK, 3072, F.G, (int)blockIdx.x); const auto S = pg8::unitlist_fill(F.lds + UL_OFF, S0, F.wave); \
        pg8::rowcache_fill(F.lds + AUX_OFF, S, (const float*)(F.ws + WS_SS0), 1, F.wave); \
        pg8::EpiGlaIn E{(bf16*)(F.ws + WS_Q0), (bf16*)(F.ws + WS_K0), (bf16*)(F.ws + WS_V0), (bf16*)(F.ws + WS_R0), (float*)(F.ws + WS_LR), (const float*)(F.ws + WS_SS0), F.lds + AUX_OFF}; \
        pg8::gemm_phase<pg8::EpiGlaIn, pg8::ListOrder<pg8::StaticOrder>, MK_DENSE_ALIGN, MK_DENSE_SP2>(F.lds + RING_OFF, g, S, E, F.wave); } while (0)
#define PH2 do { gla_prep(F); } while (0)
#define PH3 do { gla_scan(F); } while (0)
#define PH4 do { gla_post(F); } while (0)
#define PH5 do { pg8::Gemm g{(const bf16*)(F.ws + WS_G), (const bf16*)(F.ws + WS_W_GLAOUT), NTOK, 1024, 1024}; pg8::StaticOrder S0; S0.init(NTOK, 1024, F.G, (int)blockIdx.x); const auto S = pg8::unitlist_fill(F.lds + UL_OFF, S0, F.wave); \
        pg8::EpiResBf16 E{XB, HB, nullptr, (float*)(F.ws + WS_SSP1), 1.0f}; \
        pg8::gemm_phase<pg8::EpiResBf16, pg8::ListOrder<pg8::StaticOrder>, MK_DENSE_ALIGN, MK_DENSE_SP2>(F.lds + RING_OFF, g, S, E, F.wave); } while (0)
#define PH6 do { pg8::Gemm g{HB, (const bf16*)(F.ws + WS_W_DGU), NTOK, 5632, 1024}; pg8::StaticOrder S0; S0.init(NTOK, 5632, F.G, (int)blockIdx.x); const auto S = pg8::unitlist_fill(F.lds + UL_OFF, S0, F.wave); \
        pg8::rowcache_fill(F.lds + AUX_OFF, S, (const float*)(F.ws + WS_SSP1), 16, F.wave); \
        pg8::EpiSwiglu E{(bf16*)(F.ws + WS_ACT0), DFF, 22, (const float*)(F.ws + WS_SSP1), F.lds + AUX_OFF, MK_DDN_FP8 ? ASCALE : 0.f}; \
        pg8::gemm_phase<pg8::EpiSwiglu, pg8::ListOrder<pg8::StaticOrder>, MK_DENSE_ALIGN, MK_DENSE_SP2>(F.lds + RING_OFF, g, S, E, F.wave); } while (0)
#define PH7 do { pg8::Gemm g{(const bf16*)(F.ws + WS_ACT0), (const bf16*)(F.ws + WS_W_DDN), NTOK, 1024, MK_DDN_FP8 ? DFF / 2 : DFF}; pg8::StaticOrder S0; S0.init(NTOK, 1024, F.G, (int)blockIdx.x); const auto S = pg8::unitlist_fill(F.lds + UL_OFF, S0, F.wave); \
        pg8::EpiResBf16 E{HB, HB, nullptr, (float*)(F.ws + WS_SSP2), MK_DDN_FP8 ? 1.0f / (ASCALE * WSCALE) : 1.0f}; \
        pg8::gemm_phase<pg8::EpiResBf16, pg8::ListOrder<pg8::StaticOrder>, MK_DENSE_ALIGN, MK_DENSE_SP2, (MK_DDN_FP8 != 0)>(F.lds + RING_OFF, g, S, E, F.wave); } while (0)
#define PH8 do { pg8::Gemm g{HB, (const bf16*)(F.ws + WS_W_QKV), NTOK, 1536, 1024}; pg8::StaticOrder S0; S0.init(NTOK, 1536, F.G, (int)blockIdx.x); const auto S = pg8::unitlist_fill(F.lds + UL_OFF, S0, F.wave); \
        pg8::rowcache_fill(F.lds + AUX_OFF, S, (const float*)(F.ws + WS_SSP2), 16, F.wave); \
        pg8::EpiQkv E{(bf16*)(F.ws + WS_Q1), (bf16*)(F.ws + WS_K1), (bf16*)(F.ws + WS_V1), F.in[11], (const float*)(F.ws + WS_SSP2), F.lds + AUX_OFF}; \
        pg8::gemm_phase<pg8::EpiQkv, pg8::ListOrder<pg8::StaticOrder>, MK_DENSE_ALIGN, MK_DENSE_SP2>(F.lds + RING_OFF, g, S, E, F.wave); } while (0)
#define PH9 do { swa_attn(F); } while (0)
#define PH10 do { pg8::Gemm g{(const bf16*)(F.ws + WS_O1), (const bf16*)(F.ws + WS_W_SWAOUT), NTOK, 1024, 1024}; pg8::StaticOrder S0; S0.init(NTOK, 1024, F.G, (int)blockIdx.x); const auto S = pg8::unitlist_fill(F.lds + UL_OFF, S0, F.wave); \
        pg8::EpiResBf16 E{HB, HB, F.in[14], (float*)(F.ws + WS_SSP3), 1.0f}; \
        pg8::gemm_phase<pg8::EpiResBf16, pg8::ListOrder<pg8::StaticOrder>, MK_DENSE_ALIGN, MK_DENSE_SP2>(F.lds + RING_OFF, g, S, E, F.wave); } while (0)
#define PH11 do { moe_route(F, HB, (const float*)(F.ws + WS_SSP3), F.in[2] + DM); } while (0)
#define PH12 do { moe_gather(F); } while (0)
#define PH13 do { pg8::MoeOrder S0; S0.init((const int*)(F.ws + WS_META), 22, F.G, (int)blockIdx.x); const auto S = pg8::unitlist_fill(F.lds + UL_OFF, S0, F.wave); \
        pg8::Gemm g{(const bf16*)(F.ws + WS_XS), (const bf16*)(F.ws + WS_W_MGU), 0, 0, 512}; \
        pg8::EpiSwiglu8 E{F.ws + WS_ACT1, DFF, 22, 1.0f / (XSCALE * WSCALE), ASCALE}; \
        pg8::gemm_phase<pg8::EpiSwiglu8, pg8::ListOrder<pg8::MoeOrder>, MK_P13_ALIGN, MK_P13_SP2, true>(F.lds + RING_OFF, g, S, E, F.wave); } while (0)
#ifndef MK_P14_SPLIT
#define MK_P14_SPLIT 1
#endif
#ifndef MK_P14_REV
#define MK_P14_REV 0
#endif
#ifndef MK_P14_ALIGN
#define MK_P14_ALIGN true
#endif
#ifndef MK_P14_SP2
#define MK_P14_SP2 true
#endif
#define PH14X(i0_, i1_) do { pg8::MoeOrder S0; S0.init((const int*)(F.ws + WS_META), 4, F.G, (int)blockIdx.x, MK_P14_REV, (i0_), (i1_)); const auto S = pg8::unitlist_fill(F.lds + UL_OFF, S0, F.wave); \
        pg8::Gemm g{(const bf16*)(F.ws + WS_ACT1), (const bf16*)(F.ws + WS_W_MDN), 0, 0, DFF / 2}; \
        pg8::rowcache_fill(F.lds + AUX_OFF, S, (const float*)(F.ws + WS_ROWW), 1, F.wave); \
        pg8::EpiMoeDown E{(bf16*)(F.ws + WS_XS), (const float*)(F.ws + WS_ROWW), 0, 1.0f / (ASCALE * WSCALE), F.lds + AUX_OFF}; \
        pg8::gemm_phase<pg8::EpiMoeDown, pg8::ListOrder<pg8::MoeOrder>, MK_P14_ALIGN, MK_P14_SP2, true>(F.lds + RING_OFF, g, S, E, F.wave); } while (0)
#ifndef MK_DENSE_ALIGN
#define MK_DENSE_ALIGN true
#endif
#ifndef MK_DENSE_SP2
#define MK_DENSE_SP2 true
#endif
#ifndef MK_P13_ALIGN
#define MK_P13_ALIGN true
#endif
#ifndef MK_P13_SP2
#define MK_P13_SP2 true
#endif
#ifndef MK_REP_PHASE
#define MK_REP_PHASE -1
#endif
#define RUN(k) do { if (IN(k)) { PH##k; if (MK_REP_PHASE == (k)) { MKBAR(); PH##k; } } } while (0)
    RUN(0); SEAM(0); RUN(1); SEAM(1); RUN(2); SEAM(2); RUN(3); SEAM(3); RUN(4); SEAM(4); RUN(5); SEAM(5); RUN(6);
    SEAM(6); RUN(7); SEAM(7); RUN(8); SEAM(8);
    RUN(9); SEAM(9); RUN(10); SEAM(10); RUN(11); SEAM(11); RUN(12); SEAM(12); RUN(13); SEAM(13);
    {
        const int* meta_ = (const int*)(F.ws + WS_META); LAS unsigned* bm_ = (LAS unsigned*)(F.lds + TB_OFF);
        int rf_ = 0x7fffffff, rem_ = 0; bool split_ = false;
        if (IN(14) && IN(15) && MK_P14_SPLIT) { const int nwg_ = __builtin_amdgcn_readfirstlane(meta_[8]) * 4; rem_ = nwg_ % F.G; split_ = (rem_ != 0) && (rem_ * 2 <= F.G) && (nwg_ >= F.G); if (split_) rf_ = nwg_ / F.G; }
        if (IN(14)) PH14X(0, rf_);
        if (IN(14) && IN(15)) MKBAR();
        if (split_) {
            const int tid_ = F.wave * 64 + lane_id();
            LBAR(); if (tid_ < 32) bm_[tid_] = 0u; LBAR();
            if (tid_ < rem_) { pg8::MoeOrder T_; T_.init(meta_, 4, F.G, tid_, MK_P14_REV, rf_, rf_ + 1); pg8::Unit u_; if (T_.next(0, u_)) __hip_atomic_fetch_or(&bm_[u_.pm >> 5], 1u << (u_.pm & 31), __ATOMIC_RELAXED, __HIP_MEMORY_SCOPE_WORKGROUP); }
            LBAR();
            PH14X(rf_, rf_ + 1);
            const int nb_ = (int)blockIdx.x - rem_;
            final_rows<1>(F, HB, F.out, F.in[22], nb_ >= 0 ? nb_ * NWAVES + F.wave : NTOK, (F.G - rem_) * NWAVES, bm_);
            MKBAR();
            final_rows<2>(F, HB, F.out, F.in[22], F.vcu * NWAVES + F.wave, F.G * NWAVES, bm_);
        } else if (IN(15)) {
            final_rows<0>(F, HB, F.out, F.in[22], F.vcu * NWAVES + F.wave, F.G * NWAVES, bm_);
        }
    }
#undef IN
#undef SEAM
}

extern "C" void kernel_launch(void* const* d_in, const int* in_sizes, int n_in, void* d_out, int out_size, void* d_ws, size_t ws_size, hipStream_t stream) {
    static int grid = 0;
    if (grid == 0) {
        if (n_in != 23 || in_sizes[0] != NTOK * DM || out_size != NTOK * DM || ws_size < WS_END) {
            fprintf(stderr, "kernel_launch: built for 23 inputs, x/out of %d floats, >= %zu bytes of workspace; got n_in %d, in0 %d, out %d, ws %zu; nothing launched\n", NTOK * DM, (size_t)WS_END, n_in, n_in > 0 ? in_sizes[0] : -1, out_size, ws_size); grid = -1; return; }
        int dev = 0, cus = 0, per_cu = 0;
        if (hipGetDevice(&dev) != hipSuccess || hipDeviceGetAttribute(&cus, hipDeviceAttributeMultiprocessorCount, dev) != hipSuccess) { fprintf(stderr, "kernel_launch: device query failed\n"); grid = -1; return; }
        if (hipFuncSetAttribute((const void*)fwd_kernel, hipFuncAttributeMaxDynamicSharedMemorySize, LDS_BYTES) != hipSuccess) { fprintf(stderr, "kernel_launch: hipFuncSetAttribute failed\n"); grid = -1; return; }
        if (hipOccupancyMaxActiveBlocksPerMultiprocessor(&per_cu, (const void*)fwd_kernel, NWAVES * 64, LDS_BYTES) != hipSuccess || per_cu < 1) {
            fprintf(stderr, "kernel_launch: occupancy query reports %d workgroups per CU\n", per_cu); (void)hipGetLastError(); grid = -1; return; }
        grid = cus;
    }
    if (grid < 0) return;
    if (hipMemsetAsync((char*)d_ws + WS_CTL, 0, CTL_ZERO_BYTES, stream) != hipSuccess) { fprintf(stderr, "kernel_launch: memset failed\n"); return; }
    Args a{};
    for (int i = 0; i < 23; ++i) a.in[i] = (const float*)d_in[i];
    a.out = (float*)d_out; a.ws = (unsigned char*)d_ws;
#if MK_ONE_LAUNCH
    a.ph_lo = 0; a.ph_hi = NPHASE;
    hipLaunchKernelGGL(fwd_kernel, dim3(grid), dim3(NWAVES * 64), LDS_BYTES, stream, a);
#else
    for (int p = 0; p < NPHASE; ++p) { a.ph_lo = p; a.ph_hi = p + 1; hipLaunchKernelGGL(fwd_kernel, dim3(grid), dim3(NWAVES * 64), LDS_BYTES, stream, a); }
#endif
    const hipError_t le = hipPeekAtLastError();
    if (le != hipSuccess) fprintf(stderr, "kernel_launch: launch failed: %s\n", hipGetErrorName(le));
}
```

```cpp
#include <hip/hip_runtime.h>
#include <cstdio>
#include <cstdint>
namespace pg8 {
#define PG8_LAS __attribute__((address_space(3)))
typedef unsigned short bf16_t;
typedef short bf16x8 __attribute__((ext_vector_type(8)));
typedef float f32x4 __attribute__((ext_vector_type(4)));
typedef unsigned u32x4 __attribute__((ext_vector_type(4)));
constexpr int BM = 256, BK = 64, HALF = 128, HTB = HALF * BK * 2  , STAGE_BYTES = 8 * HTB, NXCD = 8,
#ifdef MK_WGM
    WGM = MK_WGM;
#else
    WGM = 8;
#endif

__host__ __device__ __forceinline__ int lds_byte(int r, int c) { const int st = (r >> 4) * 2 + (c >> 5), rr = r & 15, cc = c & 31, ob = rr * 64 + cc * 2; return st * 1024 + (ob ^ (((ob >> 9) & 1) << 5)); }
__host__ __device__ __forceinline__ void stage_rc(int b, int& R, int& C) { const int st = b / 1024, sb = b % 1024, swz = sb ^ (((sb >> 9) & 1) << 5); R = (st >> 1) * 16 + swz / 64; C = (st & 1) * 32 + (swz % 64) / 2; }
__host__ __device__ __forceinline__ int perm32(int rho) { const int n = rho >> 4, i = rho & 15; return 8 * (i >> 2) + 4 * n + (i & 3); }

struct Unit { int pm, pn; };
struct Gemm { const bf16_t* A; const bf16_t* Bt; int M, N, K; };

struct StaticOrder {
    int nM, nN, nwg, G, c;
    __host__ __device__ void init(int M, int N, int G_, int c_) { nM = M / BM; nN = N / BM; nwg = nM * nN; G = G_; c = c_; }
    __host__ __device__ bool next(int i, Unit& u) const {
        const long L = (long)i * G + c; if (L >= nwg) return false;
        int wgid = (int)L; { const int q = nwg / NXCD, r = nwg % NXCD, xcd = wgid % NXCD, off = wgid / NXCD; wgid = (xcd < r ? xcd * (q + 1) : r * (q + 1) + (xcd - r) * q) + off; }
        const int nig = WGM * nN, gid = wgid / nig, fm = gid * WGM, gsz = (nM - fm) < WGM ? (nM - fm) : WGM;
        u.pm = fm + ((wgid % nig) % gsz); u.pn = (wgid % nig) / gsz; return true;
    }
    __device__ __forceinline__ void a_ready(const Unit&) const {}
    __device__ __forceinline__ void done(const Unit&) const {}
};

__device__ __forceinline__ unsigned cvt_pk_bf16(float lo, float hi) { unsigned r; asm volatile("v_cvt_pk_bf16_f32 %0, %1, %2" : "=v"(r) : "v"(lo), "v"(hi)); return r; }
typedef float f32x2 __attribute__((ext_vector_type(2)));

typedef unsigned u32x2 __attribute__((ext_vector_type(2)));
__device__ __forceinline__ int pg8_lane() { int l; asm volatile("v_mbcnt_lo_u32_b32 %0, -1, 0\n\tv_mbcnt_hi_u32_b32 %0, -1, %0" : "=v"(l)); return l; }
typedef float f32x2_t __attribute__((ext_vector_type(2))); typedef __bf16 bf16x2_t __attribute__((ext_vector_type(2)));
__device__ __forceinline__ unsigned cvt2(float lo, float hi) { f32x2_t v = {lo, hi}; bf16x2_t b = __builtin_convertvector(v, bf16x2_t); return __builtin_bit_cast(unsigned, b); }
__device__ __forceinline__ u32x4 pack8(f32x4 a, f32x4 b) { u32x4 w; w.x = cvt2(a[0], a[1]); w.y = cvt2(a[2], a[3]); w.z = cvt2(b[0], b[1]); w.w = cvt2(b[2], b[3]); return w; }

constexpr int RC_MAXP = 15, RC_BYTES = 64 + RC_MAXP * 1024;
__device__ __forceinline__ float rs_from_partials(const float* ssp, int row) {
    const f32x4 a = *(const f32x4*)(ssp + (size_t)row * 16), b = *(const f32x4*)(ssp + (size_t)row * 16 + 4), c = *(const f32x4*)(ssp + (size_t)row * 16 + 8), d = *(const f32x4*)(ssp + (size_t)row * 16 + 12);
    const float s = ((a[0] + a[1]) + (a[2] + a[3])) + ((b[0] + b[1]) + (b[2] + b[3])) + ((c[0] + c[1]) + (c[2] + c[3])) + ((d[0] + d[1]) + (d[2] + d[3]));
    return __builtin_amdgcn_rsqf(s * (1.0f / 1024.0f) + 1e-5f);
}
template <class Sched>
__device__ __forceinline__ void rowcache_fill(PG8_LAS unsigned char* aux, const Sched& S, const float* src, int np, int wid) {
    PG8_LAS int* hdr = (PG8_LAS int*)aux; PG8_LAS float* val = (PG8_LAS float*)(aux + 64);
    const int lane = pg8_lane(), tid = wid * 64 + lane;
    asm volatile("s_waitcnt lgkmcnt(0)" ::: "memory"); __builtin_amdgcn_s_barrier(); asm volatile("" ::: "memory");
    if (wid == 0) {
        Unit u; const bool has = S.next(lane, u); const int pm = has ? u.pm : -1; bool first = has;
        for (int j = 0; j < 63; ++j) { const int pj = __shfl(pm, j); if (j < lane && pj == pm) first = false; }
        const unsigned long long mask = __ballot(first);
        const int pos = __builtin_popcountll(mask & ((1ull << lane) - 1ull));
        if (first && pos < RC_MAXP) hdr[1 + pos] = pm;
        if (lane == 0) { const int n = __builtin_popcountll(mask); hdr[0] = n < RC_MAXP ? n : RC_MAXP; }
    }
    asm volatile("s_waitcnt lgkmcnt(0)" ::: "memory"); __builtin_amdgcn_s_barrier(); asm volatile("" ::: "memory");
    const int n = hdr[0];
    for (int s = (tid >> 8); s < n; s += 2) { const int row = hdr[1 + s] * BM + (tid & 255);
        val[s * 256 + (tid & 255)] = (np == 16) ? rs_from_partials(src, row) : src[row]; }
    asm volatile("s_waitcnt vmcnt(0) lgkmcnt(0)" ::: "memory"); __builtin_amdgcn_s_barrier(); asm volatile("" ::: "memory");
}
__device__ __forceinline__ void rowcache_get8(const PG8_LAS unsigned char* aux, const float* src, int np, int pm, int rr0, float (&v)[2][4]) {
    const PG8_LAS int* hdr = (const PG8_LAS int*)aux; const PG8_LAS float* val = (const PG8_LAS float*)(aux + 64);
    const int n = hdr[0]; int slot = -1;
#pragma unroll
    for (int k = 0; k < RC_MAXP; ++k) slot = (k < n && hdr[1 + k] == pm) ? k : slot;
    slot = __builtin_amdgcn_readfirstlane(slot);
    if (slot >= 0) {
#pragma unroll
        for (int ai = 0; ai < 2; ++ai)
#pragma unroll
            for (int m = 0; m < 4; ++m) v[ai][m] = val[slot * 256 + rr0 + ai * HALF + m * 16];
    } else {
#pragma unroll
        for (int ai = 0; ai < 2; ++ai)
#pragma unroll
            for (int m = 0; m < 4; ++m) { const int row = pm * BM + rr0 + ai * HALF + m * 16; v[ai][m] = (np == 16) ? rs_from_partials(src, row) : src[row]; }
    }
}
struct EpiGlaIn {
    static constexpr bool PERM = true, AFTER_DRAIN = false;
    bf16_t *Q0, *K0, *V0, *R0; float* LR; const float* rs0; const PG8_LAS unsigned char* aux;
    __device__ __forceinline__ void operator()(const f32x4 (&acc)[2][2][4][2], const Unit& u, int wr, int wc, int fr, int fq) const {
        const int pn = u.pn; const int row0 = u.pm * BM + wr * 64 + fr; const int cw = wc * 32 + 8 * fq;
        float rs[2][4]; rowcache_get8(aux, rs0, 1, u.pm, wr * 64 + fr, rs);
        if (pn < 12) {
            bf16_t* base; int ld, c0; float sc = 1.f;
            if (pn < 2) { base = Q0; ld = 512; c0 = pn * 256; sc = 0.08838834764831845f; }
            else if (pn < 4) { base = K0; ld = 512; c0 = (pn - 2) * 256; }
            else if (pn < 8) { base = V0; ld = 1024; c0 = (pn - 4) * 256; }
            else { base = R0; ld = 1024; c0 = (pn - 8) * 256; }
#pragma unroll
            for (int ai = 0; ai < 2; ++ai)
#pragma unroll
                for (int m = 0; m < 4; ++m) { bf16_t* rowp = base + (size_t)(row0 + ai * HALF + m * 16) * ld + c0 + cw;
#pragma unroll
                    for (int bj = 0; bj < 2; ++bj) *(u32x4*)(rowp + bj * HALF) = pack8(acc[ai][bj][m][0] * (sc * rs[ai][m]), acc[ai][bj][m][1] * (sc * rs[ai][m])); }
        } else if (wc == 0) {
#pragma unroll
            for (int ai = 0; ai < 2; ++ai)
#pragma unroll
                for (int m = 0; m < 4; ++m) { float* p = LR + (size_t)(row0 + ai * HALF + m * 16) * 32 + 8 * fq;
                    *(f32x4*)p = acc[ai][0][m][0] * rs[ai][m]; *(f32x4*)(p + 4) = acc[ai][0][m][1] * rs[ai][m]; }
        }
    }
};
struct EpiResBf16 {
    static constexpr bool PERM = true, AFTER_DRAIN = false;
    const bf16_t* base; bf16_t* out; const float* bias; float* ssp; float accs;
    __device__ __forceinline__ void operator()(const f32x4 (&acc)[2][2][4][2], const Unit& u, int wr, int wc, int fr, int fq) const {
        const int row0 = u.pm * BM + wr * 64 + fr; const int col0 = u.pn * BM + wc * 32 + 8 * fq;
        f32x4 bv[2][2];
#pragma unroll
        for (int bj = 0; bj < 2; ++bj)
#pragma unroll
            for (int n = 0; n < 2; ++n) bv[bj][n] = bias ? *(const f32x4*)(bias + col0 + bj * HALF + 4 * n) : (f32x4){0.f, 0.f, 0.f, 0.f};
#pragma unroll
        for (int ai = 0; ai < 2; ++ai) {
            u32x4 bbv[4][2];
#pragma unroll
            for (int m = 0; m < 4; ++m)
#pragma unroll
                for (int bj = 0; bj < 2; ++bj) bbv[m][bj] = *(const u32x4*)(base + (size_t)(row0 + ai * HALF + m * 16) * 1024 + col0 + bj * HALF);
#pragma unroll
            for (int m = 0; m < 4; ++m) { const int row = row0 + ai * HALF + m * 16; const size_t off = (size_t)row * 1024 + col0; float s = 0.f;
#pragma unroll
                for (int bj = 0; bj < 2; ++bj) { const u32x4 bb = bbv[m][bj]; f32x4 v0, v1;
#pragma unroll
                    for (int j = 0; j < 2; ++j) { v0[2 * j] = __uint_as_float(bb[j] << 16); v0[2 * j + 1] = __uint_as_float(bb[j] & 0xffff0000u); v1[2 * j] = __uint_as_float(bb[2 + j] << 16); v1[2 * j + 1] = __uint_as_float(bb[2 + j] & 0xffff0000u); }
                    v0 = v0 + acc[ai][bj][m][0] * accs + bv[bj][0]; v1 = v1 + acc[ai][bj][m][1] * accs + bv[bj][1];
                    s += (v0[0] * v0[0] + v0[1] * v0[1]) + (v0[2] * v0[2] + v0[3] * v0[3]) + (v1[0] * v1[0] + v1[1] * v1[1]) + (v1[2] * v1[2] + v1[3] * v1[3]);
                    *(u32x4*)(out + off + bj * HALF) = pack8(v0, v1); }
                s += __shfl_xor(s, 16); s += __shfl_xor(s, 32);
                if (fq == 0) ssp[(size_t)row * 16 + 4 * u.pn + wc] = s; }
        }
    }
};
__device__ __forceinline__ float silu_f(float g) { return g * __builtin_amdgcn_rcpf(1.0f + __builtin_amdgcn_exp2f(-1.4426950408889634f * g)); }
__device__ __forceinline__ unsigned pk4_fp8(float a, float b, float c, float d) {
    a = __builtin_amdgcn_fmed3f(a, -448.f, 448.f); b = __builtin_amdgcn_fmed3f(b, -448.f, 448.f); c = __builtin_amdgcn_fmed3f(c, -448.f, 448.f); d = __builtin_amdgcn_fmed3f(d, -448.f, 448.f);
    unsigned r = 0u; r = __builtin_amdgcn_cvt_pk_fp8_f32(a, b, r, false); r = __builtin_amdgcn_cvt_pk_fp8_f32(c, d, r, true); return r;
}
struct EpiSwiglu {
    static constexpr bool PERM = true, AFTER_DRAIN = false;
    bf16_t* O; int ldo; int ntn; const float* ssp; const PG8_LAS unsigned char* aux; float f8scale;
    __device__ __forceinline__ void operator()(const f32x4 (&acc)[2][2][4][2], const Unit& u, int wr, int wc, int fr, int fq) const {
        const int row0 = u.pm * BM + wr * 64 + fr; const int col0 = (u.pn % ntn) * HALF + wc * 32 + 8 * fq;
        float rsv[2][4]; rowcache_get8(aux, ssp, 16, u.pm, wr * 64 + fr, rsv);
#pragma unroll
        for (int ai = 0; ai < 2; ++ai)
#pragma unroll
            for (int m = 0; m < 4; ++m) { f32x4 v0, v1; const float rs = rsv[ai][m];
                { const float c0 = -1.4426950408889634f * rs, c1 = rs * rs; const f32x4 g0 = acc[ai][0][m][0], g1 = acc[ai][0][m][1]; f32x4 t0 = g0 * c0, t1 = g1 * c0;
#pragma unroll
                  for (int j = 0; j < 4; ++j) { t0[j] = __builtin_amdgcn_rcpf(1.0f + __builtin_amdgcn_exp2f(t0[j])); t1[j] = __builtin_amdgcn_rcpf(1.0f + __builtin_amdgcn_exp2f(t1[j])); }
                  v0 = (g0 * acc[ai][1][m][0]) * (t0 * c1); v1 = (g1 * acc[ai][1][m][1]) * (t1 * c1); }
                if (f8scale > 0.f) { v0 = v0 * f8scale; v1 = v1 * f8scale; *(u32x2*)((unsigned char*)O + (size_t)(row0 + ai * HALF + m * 16) * ldo + col0) = (u32x2){pk4_fp8(v0[0], v0[1], v0[2], v0[3]), pk4_fp8(v1[0], v1[1], v1[2], v1[3])}; }
                else *(u32x4*)(O + (size_t)(row0 + ai * HALF + m * 16) * ldo + col0) = pack8(v0, v1); }
    }
};
struct EpiSwiglu8 {
    static constexpr bool PERM = true, AFTER_DRAIN = false;
    unsigned char* O; int ldo; int ntn; float inv, oscale;
    __device__ __forceinline__ void operator()(const f32x4 (&acc)[2][2][4][2], const Unit& u, int wr, int wc, int fr, int fq) const {
        const int row0 = u.pm * BM + wr * 64 + fr; const int col0 = (u.pn % ntn) * HALF + wc * 32 + 8 * fq;
#pragma unroll
        for (int ai = 0; ai < 2; ++ai)
#pragma unroll
            for (int m = 0; m < 4; ++m) { f32x4 v0, v1;
                { const float c0 = -1.4426950408889634f * inv, c1 = inv * inv * oscale; const f32x4 g0 = acc[ai][0][m][0], g1 = acc[ai][0][m][1]; f32x4 t0 = g0 * c0, t1 = g1 * c0;
#pragma unroll
                  for (int j = 0; j < 4; ++j) { t0[j] = __builtin_amdgcn_rcpf(1.0f + __builtin_amdgcn_exp2f(t0[j])); t1[j] = __builtin_amdgcn_rcpf(1.0f + __builtin_amdgcn_exp2f(t1[j])); }
                  v0 = (g0 * acc[ai][1][m][0]) * (t0 * c1); v1 = (g1 * acc[ai][1][m][1]) * (t1 * c1); }
                *(u32x2*)(O + (size_t)(row0 + ai * HALF + m * 16) * ldo + col0) = (u32x2){pk4_fp8(v0[0], v0[1], v0[2], v0[3]), pk4_fp8(v1[0], v1[1], v1[2], v1[3])}; }
    }
};
struct EpiMoeDown {
    static constexpr bool PERM = true, AFTER_DRAIN = false;
    bf16_t* Y; const float* roww; int row_base; float inv; const PG8_LAS unsigned char* aux;
    __device__ __forceinline__ void operator()(const f32x4 (&acc)[2][2][4][2], const Unit& u, int wr, int wc, int fr, int fq) const {
        const int row0 = row_base + u.pm * BM + wr * 64 + fr; const int col0 = (u.pn & 3) * BM + wc * 32 + 8 * fq;
        float wv[2][4]; rowcache_get8(aux, roww, 1, u.pm, wr * 64 + fr, wv);
#pragma unroll
        for (int ai = 0; ai < 2; ++ai)
#pragma unroll
            for (int m = 0; m < 4; ++m) wv[ai][m] *= inv;
#pragma unroll
        for (int ai = 0; ai < 2; ++ai)
#pragma unroll
            for (int m = 0; m < 4; ++m) { const int row = row0 + ai * HALF + m * 16; const float w = wv[ai][m]; bf16_t* rowp = Y + (size_t)row * 1024 + col0;
#pragma unroll
                for (int bj = 0; bj < 2; ++bj) *(u32x4*)(rowp + bj * HALF) = pack8(acc[ai][bj][m][0] * w, acc[ai][bj][m][1] * w); }
    }
};
struct EpiQkv {
    static constexpr bool PERM = true, AFTER_DRAIN = false;
    bf16_t *Q1, *K1, *V1; const float* bias; const float* ssp; const PG8_LAS unsigned char* aux;
    __device__ __forceinline__ void operator()(const f32x4 (&acc)[2][2][4][2], const Unit& u, int wr, int wc, int fr, int fq) const {
        const int pn = u.pn; const int row0 = u.pm * BM + wr * 64 + fr; const int cw = wc * 32 + 8 * fq;
        bf16_t* base; int ld, c0; float sc = 1.f;
        if (pn < 4) { base = Q1; ld = 1024; c0 = pn * 256; sc = 0.125f * 1.4426950408889634f; }
        else if (pn == 4) { base = K1; ld = 256; c0 = 0; }
        else { base = V1; ld = 256; c0 = 0; }
        f32x4 bv[2][2];
#pragma unroll
        for (int bj = 0; bj < 2; ++bj)
#pragma unroll
            for (int n = 0; n < 2; ++n) bv[bj][n] = *(const f32x4*)(bias + pn * 256 + bj * HALF + cw + 4 * n);
        float rsv[2][4]; rowcache_get8(aux, ssp, 16, u.pm, wr * 64 + fr, rsv);
#pragma unroll
        for (int ai = 0; ai < 2; ++ai)
#pragma unroll
            for (int m = 0; m < 4; ++m) { bf16_t* rowp = base + (size_t)(row0 + ai * HALF + m * 16) * ld + c0 + cw; const float rs = rsv[ai][m];
#pragma unroll
                for (int bj = 0; bj < 2; ++bj) *(u32x4*)(rowp + bj * HALF) = pack8((acc[ai][bj][m][0] * rs + bv[bj][0]) * sc, (acc[ai][bj][m][1] * rs + bv[bj][1]) * sc); }
    }
};
struct MoeOrder {
    int nM, nN, nwg, G, c, rev; const int* meta;
    __device__ __forceinline__ void init(const int* meta_, int nN_, int G_, int c_, int rev_ = 0) { meta = meta_; nM = meta_[8]; nN = nN_; nwg = nM * nN; G = G_; c = c_; rev = rev_; }
    __device__ __forceinline__ bool next(int i, Unit& u) const {
        const long L = (long)i * G + c; if (L >= nwg) return false;
        int wgid = (int)L; { const int q = nwg / NXCD, r = nwg % NXCD, xcd = wgid % NXCD, off = wgid / NXCD; wgid = (xcd < r ? xcd * (q + 1) : r * (q + 1) + (xcd - r) * q) + off; }
        const int nig = WGM * nN, gid = wgid / nig, fm = gid * WGM, gsz = (nM - fm) < WGM ? (nM - fm) : WGM;
        const int pm0 = fm + ((wgid % nig) % gsz), pn = (wgid % nig) / gsz; const int pm = rev ? nM - 1 - pm0 : pm0;
        int e = 0;
#pragma unroll
        for (int k = 1; k < 8; ++k) e += (pm >= meta[k]) ? 1 : 0;
        u.pm = pm; u.pn = e * nN + pn; return true;
    }
    __device__ __forceinline__ void a_ready(const Unit&) const {}
    __device__ __forceinline__ void done(const Unit&) const {}
};

constexpr int UL_MAX = 128;
template <class Sched> struct ListOrder {
    const PG8_LAS int* list; int n; Sched S;
    __device__ __forceinline__ bool next(int i, Unit& u) const {
        if (i >= UL_MAX) return S.next(i, u);
        if (i >= n) return false;
        const int a = list[2 * i], b = list[2 * i + 1]; u.pm = __builtin_amdgcn_readfirstlane(a); u.pn = __builtin_amdgcn_readfirstlane(b); return true;
    }
    __device__ __forceinline__ void a_ready(const Unit&) const {}
    __device__ __forceinline__ void done(const Unit&) const {}
};
template <class Sched> __device__ __forceinline__ ListOrder<Sched> unitlist_fill(PG8_LAS unsigned char* mem, const Sched& S, int wid) {
    PG8_LAS int* list = (PG8_LAS int*)mem; PG8_LAS int* cnt = list + 2 * UL_MAX;
    asm volatile("s_waitcnt lgkmcnt(0)" ::: "memory"); __builtin_amdgcn_s_barrier(); asm volatile("" ::: "memory");
    if (wid < 2) { const int i = wid * 64 + pg8_lane(); Unit u; const bool has = S.next(i, u);
        if (has) { list[2 * i] = u.pm; list[2 * i + 1] = u.pn; }
        const int c = __builtin_popcountll(__ballot(has)); if (pg8_lane() == 0) cnt[wid] = c; }
    asm volatile("s_waitcnt lgkmcnt(0)" ::: "memory"); __builtin_amdgcn_s_barrier(); asm volatile("" ::: "memory");
    ListOrder<Sched> L; L.list = list; L.n = __builtin_amdgcn_readfirstlane(cnt[0] + cnt[1]); L.S = S; return L;
}
typedef int v4i_t __attribute__((ext_vector_type(4))); typedef int v8i_t __attribute__((ext_vector_type(8)));
__device__ __forceinline__ v8i_t cat32(bf16x8 lo, bf16x8 hi) { const v4i_t a = __builtin_bit_cast(v4i_t, lo), b = __builtin_bit_cast(v4i_t, hi); return __builtin_shufflevector(a, b, 0, 1, 2, 3, 4, 5, 6, 7); }
template <class Epi, class Sched, bool ALIGN_EPI = false, bool SP2 = false, bool FP8 = false>
__device__ __forceinline__ void gemm_phase(PG8_LAS unsigned char* lds, const Gemm g, const Sched& S, const Epi& E, const int wid  ) {
    const int lane = pg8_lane(), tid = wid * 64 + lane, wr = wid >> 2, wc = wid & 3, fr = lane & 15, fq = lane >> 4;
    const int K = g.K, nt = K / BK;
    unsigned voffA[2], voffB[2];
#pragma unroll
    for (int i = 0; i < 2; ++i) { int R, C; stage_rc(tid * 16 + i * 8192, R, C); const int Rb = Epi::PERM ? ((R & ~31) + perm32(R & 31)) : R;
        voffA[i] = (unsigned)(R * K + C) * 2u; voffB[i] = (unsigned)(Rb * K + C) * 2u; }
    const __amdgpu_buffer_rsrc_t rsA = __builtin_amdgcn_make_buffer_rsrc((void*)g.A, 0, 0x7fffffff, 0x00020000), rsB = __builtin_amdgcn_make_buffer_rsrc((void*)g.Bt, 0, 0x7fffffff, 0x00020000);
    const size_t kstep = (size_t)(BK * 2);
    const size_t hstep = (size_t)HALF * K * 2;
    const size_t tstep = 2 * hstep;
    const unsigned ldsw = (unsigned)wid * 1024u;
    const int aoff = lds_byte(wr * 64 + fr, fq * 8), boff = lds_byte(wc * 32 + fr, fq * 8);
#define PG8_SA(b, h) (((b) * 2 + (h)) * HTB)
#define PG8_SB(b, h) ((4 + (b) * 2 + (h)) * HTB)
#define PG8_RS_voffA rsA
#define PG8_RS_voffB rsB
#define PG8_BASE_voffA ((const char*)g.A)
#define PG8_BASE_voffB ((const char*)g.Bt)
#define PG8_STAGE(bufoff, gbase, voff) do { const unsigned so_ = (unsigned)((const char*)(gbase) - PG8_BASE_##voff); _Pragma("unroll") for (int _i = 0; _i < 2; ++_i) \
        __builtin_amdgcn_raw_ptr_buffer_load_lds(PG8_RS_##voff, (PG8_LAS unsigned*)(lds + (bufoff) + ldsw + _i * 8192), 16, (int)(voff)[_i], (int)so_, 0, 0); } while (0)
#define PG8_LDA(dst, b, h) do { if constexpr (FP8) { _Pragma("unroll") for (int m = 0; m < 4; ++m) dst##8[m] = cat32(*(const PG8_LAS bf16x8*)(lds + PG8_SA(b, h) + aoff + m * 2048), *(const PG8_LAS bf16x8*)(lds + PG8_SA(b, h) + aoff + m * 2048 + 1024)); } \
        else { _Pragma("unroll") for (int m = 0; m < 4; ++m) _Pragma("unroll") for (int k = 0; k < 2; ++k) dst[m][k] = *(const PG8_LAS bf16x8*)(lds + PG8_SA(b, h) + aoff + m * 2048 + k * 1024); } } while (0)
#define PG8_LDB(dst, b, h) do { if constexpr (FP8) { _Pragma("unroll") for (int n = 0; n < 2; ++n) dst##8[n] = cat32(*(const PG8_LAS bf16x8*)(lds + PG8_SB(b, h) + boff + n * 2048), *(const PG8_LAS bf16x8*)(lds + PG8_SB(b, h) + boff + n * 2048 + 1024)); } \
        else { _Pragma("unroll") for (int n = 0; n < 2; ++n) _Pragma("unroll") for (int k = 0; k < 2; ++k) dst[n][k] = *(const PG8_LAS bf16x8*)(lds + PG8_SB(b, h) + boff + n * 2048 + k * 1024); } } while (0)
#define PG8_MMA(ai, bj, At, Bt) do { __builtin_amdgcn_s_setprio(1); if constexpr (FP8) { _Pragma("unroll") for (int m = 0; m < 4; ++m) _Pragma("unroll") for (int n = 0; n < 2; ++n) \
        acc[ai][bj][m][n] = __builtin_amdgcn_mfma_scale_f32_16x16x128_f8f6f4(Bt##8[n], At##8[m], acc[ai][bj][m][n], 0, 0, 0, 0x7f7f7f7f, 0, 0x7f7f7f7f); } else { \
        _Pragma("unroll") for (int m = 0; m < 4; ++m) _Pragma("unroll") for (int n = 0; n < 2; ++n) _Pragma("unroll") for (int k = 0; k < 2; ++k) \
        acc[ai][bj][m][n] = __builtin_amdgcn_mfma_f32_16x16x32_bf16(Bt[n][k], At[m][k], acc[ai][bj][m][n], 0, 0, 0); } __builtin_amdgcn_s_setprio(0); } while (0)
#define PG8_WAIT_V(n) asm volatile("s_waitcnt vmcnt(" #n ")" ::: "memory")
#define PG8_WAIT_L(n) asm volatile("s_waitcnt lgkmcnt(" #n ")" ::: "memory")
#define PG8_BAR __builtin_amdgcn_s_barrier()
#define PG8_SCHED __builtin_amdgcn_sched_barrier(0)
    Unit cur, nxt; int ui = 0;
    if (!S.next(0, cur)) return;
    f32x4 acc[2][2][4][2];
#pragma unroll
    for (int a = 0; a < 2; ++a)
#pragma unroll
        for (int b = 0; b < 2; ++b)
#pragma unroll
            for (int m = 0; m < 4; ++m)
#pragma unroll
                for (int n = 0; n < 2; ++n) acc[a][b][m][n] = (f32x4){0.f, 0.f, 0.f, 0.f};
    bf16x8 At[4][2], B0[2][2], B1[2][2]; v8i_t At8[4], B08[2], B18[2];
    const char* cA = (const char*)g.A + (size_t)cur.pm * tstep; const char* cB = (const char*)g.Bt + (size_t)cur.pn * tstep;
    S.a_ready(cur);
    if constexpr (SP2) {
        PG8_STAGE(PG8_SB(0, 0), cB, voffB); PG8_STAGE(PG8_SB(0, 1), cB + hstep, voffB); PG8_STAGE(PG8_SA(0, 0), cA, voffA); PG8_STAGE(PG8_SA(0, 1), cA + hstep, voffA);
        if (wr == 1) PG8_BAR;
        PG8_WAIT_V(2); PG8_BAR;
        PG8_STAGE(PG8_SB(1, 0), cB + kstep, voffB); PG8_STAGE(PG8_SA(1, 0), cA + kstep, voffA); PG8_STAGE(PG8_SB(1, 1), cB + hstep + kstep, voffB);
        PG8_WAIT_V(6); PG8_BAR;
    } else {
        PG8_STAGE(PG8_SB(0, 0), cB, voffB); PG8_STAGE(PG8_SA(0, 0), cA, voffA); PG8_STAGE(PG8_SB(0, 1), cB + hstep, voffB); PG8_STAGE(PG8_SA(0, 1), cA + hstep, voffA);
        if (wr == 1) PG8_BAR;
        PG8_WAIT_V(4); PG8_BAR;
        PG8_STAGE(PG8_SB(1, 0), cB + kstep, voffB); PG8_STAGE(PG8_SA(1, 0), cA + kstep, voffA); PG8_STAGE(PG8_SB(1, 1), cB + hstep + kstep, voffB);
        PG8_WAIT_V(6); PG8_BAR;
    }
    for (;;) {
        const bool has_next = S.next(ui + 1, nxt);
        const char* nA = has_next ? (const char*)g.A + (size_t)nxt.pm * tstep : cA; const char* nB = has_next ? (const char*)g.Bt + (size_t)nxt.pn * tstep : cB;
#pragma nounroll
        for (int t = 0; t < nt; t += 2) {
            const bool last = (t == nt - 2);
            const char* a1 = cA + (size_t)(t + 1) * kstep;
            const char* a2 = last ? nA : cA + (size_t)(t + 2) * kstep; const char* b2 = last ? nB : cB + (size_t)(t + 2) * kstep;
            const char* a3 = a2 + kstep; const char* b3 = b2 + kstep;
            if (last && has_next) S.a_ready(nxt);
            if constexpr (SP2) {
            PG8_LDB(B0, 0, 0); PG8_LDB(B1, 0, 1); PG8_SCHED; PG8_LDA(At, 0, 0); PG8_STAGE(PG8_SA(1, 1), a1 + hstep, voffA);
            PG8_WAIT_V(8); PG8_WAIT_L(0); PG8_BAR; PG8_MMA(0, 0, At, B0); PG8_MMA(0, 1, At, B1); PG8_BAR; PG8_SCHED;
            PG8_LDA(At, 0, 1); PG8_STAGE(PG8_SB(0, 0), b2, voffB); PG8_STAGE(PG8_SB(0, 1), b2 + hstep, voffB); PG8_STAGE(PG8_SA(0, 0), a2, voffA);
            PG8_WAIT_V(8); PG8_WAIT_L(0); PG8_BAR; PG8_MMA(1, 0, At, B0); PG8_MMA(1, 1, At, B1); PG8_BAR; PG8_SCHED;
            PG8_LDB(B0, 1, 0); PG8_LDB(B1, 1, 1); PG8_SCHED; PG8_LDA(At, 1, 0); PG8_STAGE(PG8_SA(0, 1), a2 + hstep, voffA);
            PG8_WAIT_V(8); PG8_WAIT_L(0); PG8_BAR; PG8_MMA(0, 0, At, B0); PG8_MMA(0, 1, At, B1); PG8_BAR; PG8_SCHED;
            PG8_LDA(At, 1, 1); PG8_STAGE(PG8_SB(1, 0), b3, voffB); PG8_STAGE(PG8_SB(1, 1), b3 + hstep, voffB); PG8_STAGE(PG8_SA(1, 0), a3, voffA);
            PG8_WAIT_V(8); PG8_WAIT_L(0); PG8_BAR; PG8_MMA(1, 0, At, B0); PG8_MMA(1, 1, At, B1); PG8_BAR; PG8_SCHED;
            } else {
            PG8_LDB(B0, 0, 0); PG8_SCHED; PG8_LDA(At, 0, 0); PG8_STAGE(PG8_SA(1, 1), a1 + hstep, voffA);
            PG8_WAIT_L(8); PG8_BAR; PG8_WAIT_L(0); PG8_MMA(0, 0, At, B0); PG8_BAR; PG8_SCHED;
            PG8_LDB(B1, 0, 1); PG8_STAGE(PG8_SB(0, 0), b2, voffB);
            PG8_BAR; PG8_WAIT_L(0); PG8_MMA(0, 1, At, B1); PG8_BAR;
            PG8_LDA(At, 0, 1); PG8_STAGE(PG8_SA(0, 0), a2, voffA);
            PG8_BAR; PG8_WAIT_L(0); PG8_MMA(1, 0, At, B0); PG8_BAR; PG8_SCHED;
            PG8_STAGE(PG8_SB(0, 1), b2 + hstep, voffB);
            PG8_WAIT_V(6); PG8_BAR; PG8_MMA(1, 1, At, B1); PG8_BAR;
            PG8_LDB(B0, 1, 0); PG8_SCHED; PG8_LDA(At, 1, 0); PG8_STAGE(PG8_SA(0, 1), a2 + hstep, voffA);
            PG8_WAIT_L(8); PG8_BAR; PG8_WAIT_L(0); PG8_MMA(0, 0, At, B0); PG8_BAR; PG8_SCHED;
            PG8_LDB(B1, 1, 1); PG8_STAGE(PG8_SB(1, 0), b3, voffB);
            PG8_BAR; PG8_WAIT_L(0); PG8_MMA(0, 1, At, B1); PG8_BAR;
            PG8_LDA(At, 1, 1); PG8_STAGE(PG8_SA(1, 0), a3, voffA);
            PG8_BAR; PG8_WAIT_L(0); PG8_MMA(1, 0, At, B0); PG8_BAR; PG8_SCHED;
            PG8_STAGE(PG8_SB(1, 1), b3 + hstep, voffB);
            PG8_WAIT_V(6); PG8_BAR; PG8_MMA(1, 1, At, B1); PG8_BAR;
            }
        }
        if constexpr (ALIGN_EPI) { if (wr == 0) PG8_BAR; }
        if constexpr (!Epi::AFTER_DRAIN) { const int l2 = pg8_lane(); E(acc, cur, wr, wc, l2 & 15, l2 >> 4); S.done(cur); }
        if (!has_next) break;
#pragma unroll
        for (int a = 0; a < 2; ++a)
#pragma unroll
            for (int b = 0; b < 2; ++b)
#pragma unroll
                for (int m = 0; m < 4; ++m)
#pragma unroll
                    for (int n = 0; n < 2; ++n) acc[a][b][m][n] = (f32x4){0.f, 0.f, 0.f, 0.f};
        cur = nxt; cA = nA; cB = nB; ++ui;
        if constexpr (ALIGN_EPI) { if (wr == 1) PG8_BAR; }
    }
    PG8_WAIT_V(0);
    if constexpr (!ALIGN_EPI) { if (wr == 0) PG8_BAR; }
    PG8_BAR;
    if constexpr (Epi::AFTER_DRAIN) { E.fused(acc, cur, wr, wc, fr, fq, lds, wid, lane); S.done(cur); }
#undef PG8_SA
#undef PG8_SB
#undef PG8_STAGE
#undef PG8_RS_voffA
#undef PG8_RS_voffB
#undef PG8_BASE_voffA
#undef PG8_BASE_voffB
#undef PG8_LDA
#undef PG8_LDB
#undef PG8_MMA
#undef PG8_WAIT_V
#undef PG8_WAIT_L
#undef PG8_BAR
#undef PG8_SCHED
}
}

constexpr int NWAVES = 8;
constexpr int NTOK = 65536, SEQ = 8192, DM = 1024, DFF = 2816;
constexpr float NORM_EPS = 1e-5f;
constexpr float LOG2E = 1.4426950408889634f;
#ifndef MK_ONE_LAUNCH
#define MK_ONE_LAUNCH 1
#endif
constexpr int NPHASE = 16;

constexpr size_t MiB = 1u << 20;
constexpr size_t WS_CTL = 0, CTL_ZERO_BYTES = 1 * MiB;
constexpr size_t WS_W_GLAIN = 1 * MiB, WS_W_GLAOUT = 8 * MiB, WS_W_QKV = 10 * MiB, WS_W_SWAOUT = 13 * MiB, WS_W_DGU = 15 * MiB, WS_W_DDN = 26 * MiB, WS_W_MGU = 32 * MiB, WS_W_MDN = 120 * MiB;
constexpr size_t WS_HB = 164 * MiB;
constexpr size_t WS_XN = 612 * MiB;
constexpr size_t OUT_XB = 0, OUT_OB = 128 * MiB;
constexpr size_t WS_Q0 = 292 * MiB, WS_K0 = 356 * MiB, WS_V0 = 420 * MiB, WS_R0 = 548 * MiB, WS_LR = 676 * MiB;
constexpr size_t WS_QE = 684 * MiB;
constexpr size_t WS_CC = 940 * MiB;
constexpr size_t WS_OF = WS_Q0, WS_G = WS_V0;
constexpr size_t WS_ACT0 = 292 * MiB;
constexpr size_t WS_Q1 = 292 * MiB, WS_K1 = 420 * MiB, WS_V1 = 452 * MiB, WS_O1 = 484 * MiB;
constexpr size_t WS_XS = 292 * MiB;
constexpr size_t WS_ACT1 = 552 * MiB;
constexpr float XSCALE = 16.f, WSCALE = 64.f, ASCALE = 8.f;
constexpr size_t WS_ROUT = 952 * MiB;
constexpr size_t WS_SEL = WS_ROUT, WS_WSEL = WS_ROUT + 1 * MiB, WS_POSTOK = WS_ROUT + 2 * MiB, WS_ROWW = WS_ROUT + 3 * MiB, WS_WCNT = WS_ROUT + 4 * MiB, WS_META = WS_ROUT + 5 * MiB;
constexpr size_t WS_SSP1 = 960 * MiB, WS_SSP2 = 964 * MiB, WS_SSP3 = 968 * MiB, WS_SS0 = 972 * MiB;
constexpr size_t WS_END = 1024 * MiB;
static_assert(WS_W_MDN + (size_t)8 * 1024 * 2816 * 2 <= WS_HB && WS_CC + (size_t)2 * 8 * 128 * 1536 * 4 <= WS_ROUT && WS_ACT0 + (size_t)NTOK * DFF * 2 <= WS_QE + 4 * 64 * MiB, "ws map");
static_assert(WS_ACT1 + (size_t)133120 * DFF <= WS_ROUT && WS_XS + (size_t)133120 * 1024 * 2 <= WS_ACT1, "ws map 2");
constexpr int CW_TMO = 0, CW_BAR = 4096;

constexpr int RING_OFF = 0, RING_BYTES = 131072;
constexpr int LDS_BYTES = 163840;
constexpr int LDSCTL_OFF = LDS_BYTES - 1024, MISC_OFF = LDSCTL_OFF + 320;
constexpr int UL_OFF = RING_BYTES + 15616;
constexpr int AUX_OFF = RING_BYTES;

#define GAS __attribute__((address_space(1)))
#define LAS __attribute__((address_space(3)))
typedef unsigned short bf16;
typedef unsigned v4u __attribute__((ext_vector_type(4)));
typedef float f32x4 __attribute__((ext_vector_type(4)));
typedef short bf16x8 __attribute__((ext_vector_type(8)));
typedef GAS unsigned gu32;
typedef GAS unsigned long long gu64;
#define RLX_AGENT __ATOMIC_RELAXED, __HIP_MEMORY_SCOPE_AGENT
#define LDS_WAIT() asm volatile("s_waitcnt lgkmcnt(0)" ::: "memory")
#define VM_WAIT() asm volatile("s_waitcnt vmcnt(0)" ::: "memory")
__device__ __forceinline__ unsigned long long rt() { return __builtin_amdgcn_s_memrealtime(); }
__device__ __forceinline__ unsigned f2bf(float f) { unsigned u = __builtin_bit_cast(unsigned, f); return (u + 0x7fffu + ((u >> 16) & 1u)) >> 16; }
__device__ __forceinline__ unsigned pk2(float lo, float hi) { return f2bf(lo) | (f2bf(hi) << 16); }

#define XB_TMO      128
#define XB_XCNT(j)  (256  + 64 * (j))
#define XB_XSUB(j)  (1280 + 64 * (j))
#define XB_XGEN(j)  (2304 + 64 * (j))
#define XB_TOP      3328
#define XB_TOPGEN   3392
#define XCD_BAR_WORDS 3456
#define XB_SPIN_CAP (1u << 18)

__device__ __forceinline__ unsigned xb_ld(unsigned* p)              { return __hip_atomic_load(p, __ATOMIC_RELAXED, __HIP_MEMORY_SCOPE_AGENT); }
__device__ __forceinline__ unsigned xb_add(unsigned* p, unsigned v) { return __hip_atomic_fetch_add(p, v, __ATOMIC_RELAXED, __HIP_MEMORY_SCOPE_AGENT); }
__device__ __forceinline__ unsigned xb_xcc_id() { return (unsigned)__builtin_amdgcn_s_getreg((3 << 11) | 20) & 0xFu; }
#define XB_SPIN(cond, bar) do { unsigned _sp = 0; while (cond) { __builtin_amdgcn_s_sleep(1); \
    if ((++_sp & 255u) == 0u) { if (xb_ld(&(bar)[XB_TMO])) break; if (_sp > XB_SPIN_CAP) { atomicAdd(&(bar)[XB_TMO], 1u); break; } } } } while (0)

struct XcdBarrier {
    unsigned* bar; unsigned x;
    volatile LAS unsigned* st;
    unsigned t0;
};

__device__ __forceinline__ XcdBarrier xcd_barrier_post(unsigned* bar, volatile LAS unsigned* st, unsigned t0) {
    XcdBarrier b; b.bar = bar; b.x = xb_xcc_id(); b.st = st; b.t0 = t0;
    if (t0) (void)xb_add(&bar[XB_XCNT(b.x)], 1u);
    return b;
}
__device__ __forceinline__ void xcd_barrier_complete(unsigned* bar, unsigned x, unsigned& nloc, unsigned& nx) {
    const unsigned G = gridDim.x * gridDim.y * gridDim.z;
    unsigned sum, cnt, mine, sp = 0u;
    for (;;) {
        sum = 0u; cnt = 0u; mine = 0u;
#pragma unroll
        for (unsigned j = 0; j < 16; ++j) { const unsigned c = xb_ld(&bar[XB_XCNT(j)]); sum += c; cnt += (c > 0u) ? 1u : 0u; mine = (j == x) ? c : mine; }
        if (sum == G) break;
        __builtin_amdgcn_s_sleep(1);
        if ((++sp & 255u) == 0u) { if (xb_ld(&bar[XB_TMO])) break; if (sp > XB_SPIN_CAP) { atomicAdd(&bar[XB_TMO], 1u); break; } }
    }
    nloc = mine > 0u ? mine : 1u; nx = cnt > 0u ? cnt : 1u;
}

__device__ __forceinline__ void xcd_barrier(const XcdBarrier& b) {
    asm volatile("s_waitcnt vmcnt(0)" ::: "memory");
    __syncthreads();
    if (b.t0) {
        unsigned* bar = b.bar;
        __builtin_amdgcn_s_waitcnt(0);
        unsigned nloc = b.st[0], nx = b.st[1];
        if (nloc == 0u) { xcd_barrier_complete(bar, b.x, nloc, nx); b.st[0] = nloc; b.st[1] = nx; }
        const unsigned old = xb_add(&bar[XB_XSUB(b.x)], 1u);
        const unsigned gen = old / nloc;
        if (old + 1u == (gen + 1u) * nloc) {
            __builtin_amdgcn_fence(__ATOMIC_RELEASE, "agent");
            asm volatile("s_waitcnt vmcnt(0)" ::: "memory");
            const unsigned og = xb_add(&bar[XB_TOP], 1u);
            const unsigned tg = og / nx;
            if (og + 1u == (tg + 1u) * nx) xb_add(&bar[XB_TOPGEN], 1u);
            else XB_SPIN(xb_ld(&bar[XB_TOPGEN]) == tg, bar);
            __builtin_amdgcn_fence(__ATOMIC_ACQUIRE, "agent");
            xb_add(&bar[XB_XGEN(b.x)], 1u);
            asm volatile("s_waitcnt vmcnt(0)" ::: "memory");
        } else {
            XB_SPIN(xb_ld(&bar[XB_XGEN(b.x)]) == gen, bar);
            __builtin_amdgcn_fence(__ATOMIC_ACQUIRE, "agent");
            asm volatile("s_waitcnt vmcnt(0)" ::: "memory");
        }
    }
    __syncthreads();
}
typedef unsigned u32x4 __attribute__((ext_vector_type(4)));

typedef unsigned u32x2 __attribute__((ext_vector_type(2)));
typedef short s16x4 __attribute__((ext_vector_type(4)));
struct Frame {
    LAS unsigned char* lds;
    volatile LAS unsigned* MISC;
    int wave;
    int vcu, G;
    float* out; unsigned char* ws;
    const float* const* in;
};
__device__ __forceinline__ int lane_id() { return pg8::pg8_lane(); }
__device__ __forceinline__ float bf_lo(unsigned u) { return __uint_as_float(u << 16); }
__device__ __forceinline__ float bf_hi(unsigned u) { return __uint_as_float(u & 0xffff0000u); }
typedef float f32x2_t __attribute__((ext_vector_type(2))); typedef __bf16 bf16x2_t __attribute__((ext_vector_type(2)));
__device__ __forceinline__ unsigned cvtpk(float lo, float hi) { f32x2_t v = {lo, hi}; bf16x2_t b = __builtin_convertvector(v, bf16x2_t); return __builtin_bit_cast(unsigned, b); }
__device__ __forceinline__ float wave_sum(float v) {
#pragma unroll
    for (int o = 1; o < 64; o <<= 1) v += __shfl_xor(v, o);
    return v;
}
__device__ __forceinline__ int wave_sum_i(int v) {
#pragma unroll
    for (int o = 1; o < 64; o <<= 1) v += __shfl_xor(v, o);
    return v;
}
#define LBAR() do { asm volatile("s_waitcnt lgkmcnt(0)" ::: "memory"); __builtin_amdgcn_s_barrier(); asm volatile("" ::: "memory"); } while (0)
__device__ __forceinline__ f32x4 mfma16(bf16x8 a, bf16x8 b, f32x4 c) { return __builtin_amdgcn_mfma_f32_16x16x32_bf16(a, b, c, 0, 0, 0); }
typedef short v4i16_t __attribute__((ext_vector_type(4)));
__device__ __forceinline__ s16x4 ldtr(const LAS unsigned char* p) { return __builtin_bit_cast(s16x4, __builtin_amdgcn_ds_read_tr16_b64_v4i16((LAS v4i16_t*)p)); }
__device__ __forceinline__ bf16x8 cat8(s16x4 lo, s16x4 hi) { return (bf16x8){lo[0], lo[1], lo[2], lo[3], hi[0], hi[1], hi[2], hi[3]}; }

__device__ __forceinline__ void conv_item(const float* W, int K, int N, bf16* WT, int drow0, int k0, int n0, LAS float* scr, int lane, const float* gain) {
    const float* gp = gain ? gain : W;
    float wv[32], gv[32];
#pragma unroll
    for (int i = 0; i < 32; ++i) { const int kk = 2 * i + (lane >> 5); wv[i] = W[(size_t)(k0 + kk) * N + n0 + (lane & 31)]; gv[i] = gp[k0 + kk]; }
#pragma unroll
    for (int i = 0; i < 32; ++i) { const int kk = 2 * i + (lane >> 5); scr[kk * 33 + (lane & 31)] = wv[i] * (gain ? gv[i] : 1.0f); }
    LDS_WAIT(); asm volatile("" ::: "memory");
    const int c = lane & 7;
#pragma unroll
    for (int j = 0; j < 4; ++j) { const int n = (lane >> 3) + 8 * j; const LAS float* s = scr + (8 * c) * 33 + n;
        v4u o; o.x = pk2(s[0 * 33], s[1 * 33]); o.y = pk2(s[2 * 33], s[3 * 33]); o.z = pk2(s[4 * 33], s[5 * 33]); o.w = pk2(s[6 * 33], s[7 * 33]);
        *(GAS v4u*)(WT + (size_t)(drow0 + n) * K + k0 + 8 * c) = o; }
    LDS_WAIT(); asm volatile("" ::: "memory");
}
__device__ __forceinline__ unsigned pk4f8(float a, float b, float c, float d) { unsigned r = 0u; r = __builtin_amdgcn_cvt_pk_fp8_f32(a, b, r, false); r = __builtin_amdgcn_cvt_pk_fp8_f32(c, d, r, true); return r; }
__device__ __forceinline__ void conv_item8(const float* W, int K, int N, unsigned char* WT, int drow0, int k0, int n0, LAS float* scr, int lane, float scale) {
    float wv[64];
#pragma unroll
    for (int i = 0; i < 64; ++i) wv[i] = W[(size_t)(k0 + 2 * i + (lane >> 5)) * N + n0 + (lane & 31)];
#pragma unroll
    for (int i = 0; i < 64; ++i) scr[(2 * i + (lane >> 5)) * 33 + (lane & 31)] = wv[i] * scale;
    LDS_WAIT(); asm volatile("" ::: "memory");
    const int c = lane & 7;
#pragma unroll
    for (int j = 0; j < 4; ++j) { const int n = (lane >> 3) + 8 * j; const LAS float* s = scr + (16 * c) * 33 + n;
        v4u o; o.x = pk4f8(s[0 * 33], s[1 * 33], s[2 * 33], s[3 * 33]); o.y = pk4f8(s[4 * 33], s[5 * 33], s[6 * 33], s[7 * 33]); o.z = pk4f8(s[8 * 33], s[9 * 33], s[10 * 33], s[11 * 33]); o.w = pk4f8(s[12 * 33], s[13 * 33], s[14 * 33], s[15 * 33]);
        *(GAS v4u*)(WT + (size_t)(drow0 + n) * K + k0 + 16 * c) = o; }
    LDS_WAIT(); asm volatile("" ::: "memory");
}
constexpr int IT_GLAIN = 16 * 97, IT_SQ = 16 * 32, IT_QKV = 16 * 48, IT_FF = 1408, IT_FF8 = 704;
#ifndef MK_DDN_FP8
#define MK_DDN_FP8 1
#endif
constexpr int N_FF16 = MK_DDN_FP8 ? 2 : 3, N_FF8 = MK_DDN_FP8 ? 25 : 24;
constexpr int NITEMS = IT_GLAIN + 2 * IT_SQ + IT_QKV + N_FF16 * IT_FF + N_FF8 * IT_FF8;
__device__ __forceinline__ void p0_weights(Frame& F, const float* gla_in, const float* gla_out, const float* swa_qkv, const float* swa_out, const float* d_gate, const float* d_up, const float* d_down, const float* m_gate, const float* m_up, const float* m_down, const float* g_mix0, const float* g_ffn0, const float* g_mix1) {
    LAS float* scr = (LAS float*)(F.lds + F.wave * 16896);
    const int gw = F.vcu * NWAVES + F.wave, NGW = F.G * NWAVES, lane = lane_id();
    for (int it = gw; it < NITEMS; it += NGW) {
        int r = it; const float* W; int K = 1024, N; bf16* WT; int mode = 0; bool f8 = false; const float* gain = nullptr;
        if (r < IT_GLAIN) { W = gla_in; N = 3104; WT = (bf16*)(F.ws + WS_W_GLAIN); gain = g_mix0; }
        else if ((r -= IT_GLAIN) < IT_SQ) { W = gla_out; N = 1024; WT = (bf16*)(F.ws + WS_W_GLAOUT); }
        else if ((r -= IT_SQ) < IT_QKV) { W = swa_qkv; N = 1536; WT = (bf16*)(F.ws + WS_W_QKV); gain = g_mix1; }
        else if ((r -= IT_QKV) < IT_SQ) { W = swa_out; N = 1024; WT = (bf16*)(F.ws + WS_W_SWAOUT); }
        else { r -= IT_SQ; int j;
            if (r < N_FF16 * IT_FF) { j = r / IT_FF; r -= j * IT_FF; } else { r -= N_FF16 * IT_FF; const int j8 = r / IT_FF8; r -= j8 * IT_FF8; j = N_FF16 + j8; }
            int kind, e; if (j < 3) { kind = j; e = 0; } else { kind = (j - 3) >> 3; e = (j - 3) & 7; }
            const bool moe = j >= 3;
            f8 = j >= N_FF16;
            if (kind == 2) { W = (moe ? m_down : d_down) + (size_t)e * DFF * 1024; K = DFF; N = 1024; WT = moe ? (bf16*)(F.ws + WS_W_MDN + (size_t)e * 1024 * DFF) : (bf16*)(F.ws + WS_W_DDN); }
            else { W = (kind == 0 ? (moe ? m_gate : d_gate) : (moe ? m_up : d_up)) + (size_t)e * 1024 * DFF; N = DFF; WT = moe ? (bf16*)(F.ws + WS_W_MGU + (size_t)e * 5632 * 1024) : (bf16*)(F.ws + WS_W_DGU); mode = 1 + kind; gain = moe ? nullptr : g_ffn0; }
        }
        const int nsh = 5, nblk = N >> nsh, kb = r / nblk, nb = r - kb * nblk, n0 = nb << nsh;
        const int drow0 = (mode == 0) ? n0 : (((n0 >> 7) << 8) + (n0 & 127) + (mode == 2 ? 128 : 0));
        if (f8) conv_item8(W, K, N, (unsigned char*)WT, drow0, kb * 128, n0, scr, lane, WSCALE);
        else conv_item(W, K, N, WT, drow0, kb * 64, n0, scr, lane, gain);
    }
}
constexpr int CR_PITCH = 2064;
static_assert(32 * CR_PITCH <= RING_BYTES, "convert_rows LDS");
__device__ __forceinline__ void convert_rows(Frame& F, const float* src, bf16* dst, float* ss, const float* Win, const float* gain, float* LR) {
    const int gw = F.vcu * NWAVES + F.wave, NGW = F.G * NWAVES, lane = lane_id(), r16 = lane & 15, g4 = lane >> 4, tid = F.wave * 64 + lane;
    LAS unsigned char* wl = F.lds;
    LBAR();
#pragma unroll 1
    for (int k = tid; k < DM; k += NWAVES * 64) { const GAS f32x4* wp = (const GAS f32x4*)(Win + (size_t)k * 3104 + 3072); const float gk = gain[k];
#pragma unroll
        for (int j = 0; j < 8; ++j) { const f32x4 w4 = wp[j];
#pragma unroll
            for (int e = 0; e < 4; ++e) *(LAS unsigned short*)(wl + (4 * j + e) * CR_PITCH + k * 2) = (unsigned short)(cvtpk(w4[e] * gk, 0.f) & 0xffffu); } }
    LBAR();
    for (int rg = gw; rg < NTOK / 16; rg += NGW) {
        const size_t row = (size_t)rg * 16 + r16;
        const GAS f32x4* xr = (const GAS f32x4*)(src + row * DM + 8 * g4); GAS v4u* orow = (GAS v4u*)(dst + row * DM + 8 * g4);
        f32x4 acc0 = (f32x4){0.f, 0.f, 0.f, 0.f}, acc1 = acc0; float s = 0.f;
#pragma unroll 1
        for (int kb = 0; kb < 32; kb += 8) {
            f32x4 v[8][2];
#pragma unroll
            for (int j = 0; j < 8; ++j) { v[j][0] = xr[(kb + j) * 8]; v[j][1] = xr[(kb + j) * 8 + 1]; }
#pragma unroll
            for (int j = 0; j < 8; ++j) { const int ks = kb + j; const f32x4 a = v[j][0], c = v[j][1];
                s += ((a.x * a.x + a.y * a.y) + (a.z * a.z + a.w * a.w)) + ((c.x * c.x + c.y * c.y) + (c.z * c.z + c.w * c.w));
                const v4u pk = (v4u){cvtpk(a.x, a.y), cvtpk(a.z, a.w), cvtpk(c.x, c.y), cvtpk(c.z, c.w)};
                orow[ks * 4] = pk;
                const bf16x8 af = __builtin_bit_cast(bf16x8, pk);
                const bf16x8 b0 = *(const LAS bf16x8*)(wl + r16 * CR_PITCH + (32 * ks + 8 * g4) * 2), b1 = *(const LAS bf16x8*)(wl + (16 + r16) * CR_PITCH + (32 * ks + 8 * g4) * 2);
                acc0 = mfma16(af, b0, acc0); acc1 = mfma16(af, b1, acc1); }
        }
        s += __shfl_xor(s, 16); s += __shfl_xor(s, 32);
        const float rs = 1.0f / sqrtf(s * (1.f / DM) + NORM_EPS);
        if (g4 == 0) ss[row] = rs;
#pragma unroll
        for (int r = 0; r < 4; ++r) { const float rr = __shfl(rs, 4 * g4 + r); float* lp = LR + ((size_t)rg * 16 + 4 * g4 + r) * 32 + r16; lp[0] = acc0[r] * rr; lp[16] = acc1[r] * rr; }
    }
}

__device__ __forceinline__ float logsig16(float z) { const float e = __expf(-fabsf(z)); return (fminf(z, 0.f) - __logf(1.f + e)) * 0.0625f; }
constexpr int GP_Q = 0, GP_K = 65536, GP_LR = 131072, GP_X0 = GP_LR + 8192, GP_X1 = GP_X0 + 2048;
static_assert(GP_X1 + 4096 <= LDSCTL_OFF, "gla prep LDS");
__device__ __forceinline__ void gla_prep(Frame& F) {
    typedef float f32x2 __attribute__((ext_vector_type(2)));
    LAS unsigned char* L = F.lds;
    LAS float* lrs = (LAS float*)(L + GP_LR);
    LAS f32x2* xch0 = (LAS f32x2*)(L + GP_X0);
    LAS f32x4* xch1 = (LAS f32x4*)(L + GP_X1);
    LAS unsigned* tq = (LAS unsigned*)(L + GP_Q); LAS unsigned* tk = (LAS unsigned*)(L + GP_K);
    const int lane = lane_id(), tid = F.wave * 64 + lane, ph = tid >> 8, cp = tid & 255, col = 2 * cp;
    const bf16* Q0 = (const bf16*)(F.ws + WS_Q0); const bf16* K0 = (const bf16*)(F.ws + WS_K0); const float* LR = (const float*)(F.ws + WS_LR);
    float* CC = (float*)(F.ws + WS_CC);
    f32x2 wgv[16]; f32x2 bgv = (f32x2){0.f, 0.f}; int cur_dir = -1;
#pragma unroll
    for (int r = 0; r < 16; ++r) wgv[r] = (f32x2){0.f, 0.f};
    for (int u = F.vcu; u < 2048; u += F.G) {
        const int b = u >> 8, n = (u >> 1) & 127, dir = u & 1; const size_t row0 = (size_t)b * SEQ + 64 * n;
        bf16* QEd = (bf16*)(F.ws + WS_QE) + (size_t)dir * 2 * NTOK * 512; bf16* KEd = QEd + (size_t)NTOK * 512;
        if (dir != cur_dir) {
            const float* wg = dir ? F.in[6] : F.in[4]; const float* bg = dir ? F.in[7] : F.in[5]; cur_dir = dir;
#pragma unroll
            for (int r = 0; r < 16; ++r) wgv[r] = *(const f32x2*)(wg + r * 512 + col);
            bgv = *(const f32x2*)(bg + col);
            asm volatile("s_waitcnt vmcnt(0)" ::: "memory");
        }
        const f32x4 lrn = *(const f32x4*)(LR + row0 * 32 + tid * 4);
        LBAR();
        *(LAS f32x4*)(lrs + tid * 4) = lrn;
#pragma unroll
        for (int i = 0; i < 8; ++i) {
            __builtin_amdgcn_global_load_lds((const unsigned*)((const char*)(Q0 + row0 * 512) + (i * 8 + F.wave) * 1024 + lane * 16), (LAS unsigned*)(L + GP_Q + (i * 8 + F.wave) * 1024), 16, 0, 0);
            __builtin_amdgcn_global_load_lds((const unsigned*)((const char*)(K0 + row0 * 512) + (i * 8 + F.wave) * 1024 + lane * 16), (LAS unsigned*)(L + GP_K + (i * 8 + F.wave) * 1024), 16, 0, 0); }
        LBAR();
        float bc0[32], bc1[32]; float run0 = 0.f, run1 = 0.f;
#pragma unroll
        for (int i = 0; i < 32; ++i) { const int p = 32 * ph + i; const int tok = dir ? 63 - p : p; const LAS float* lp = lrs + tok * 32 + dir * 16;
            f32x2 z = bgv;
#pragma unroll
            for (int r4 = 0; r4 < 4; ++r4) { const f32x4 l4 = *(const LAS f32x4*)(lp + 4 * r4);
#pragma unroll
                for (int k = 0; k < 4; ++k) z = __builtin_elementwise_fma((f32x2){l4[k], l4[k]}, wgv[4 * r4 + k], z); }
            run0 += logsig16(z.x); run1 += logsig16(z.y); bc0[i] = run0; bc1[i] = run1; }
        if (ph == 0) xch0[cp] = (f32x2){run0, run1};
        LBAR();
        if (ph == 1) { const f32x2 add = xch0[cp];
#pragma unroll
            for (int i = 0; i < 32; ++i) { bc0[i] += add.x; bc1[i] += add.y; }
            xch1[cp] = (f32x4){bc0[31], bc1[31], bc0[31], bc1[31]}; }
        asm volatile("s_waitcnt vmcnt(0)" ::: "memory");
        LBAR();
        const f32x4 rl = xch1[cp]; const float br0 = rl[0], br1 = rl[1], bl0 = rl[2], bl1 = rl[3];
#pragma unroll
        for (int i = 0; i < 32; ++i) { const int p = 32 * ph + i; const int tok = dir ? 63 - p : p;
            const unsigned q2 = tq[tok * 256 + cp], k2 = tk[tok * 256 + cp];
            const float e0 = __expf(bc0[i] - br0), e1 = __expf(bc1[i] - br1), i0 = __builtin_amdgcn_rcpf(e0), i1 = __builtin_amdgcn_rcpf(e1);
            tq[tok * 256 + cp] = cvtpk(bf_lo(q2) * e0, bf_hi(q2) * e1);
            tk[tok * 256 + cp] = cvtpk(bf_lo(k2) * i0, bf_hi(k2) * i1); }
        if (ph == 0) { const int c = dir ? 127 - n : n; float* rec = CC + ((size_t)(dir * 8 + b) * 128 + c) * 512;
            if (c >= 1) *(f32x2*)(rec - 512 + col) = (f32x2){__expf(bl0), __expf(bl1)}; }
        LBAR();
#pragma unroll
        for (int i = 0; i < 8; ++i) { const int off = (i * 512 + tid) * 16;
            *(v4u*)((char*)(QEd + row0 * 512) + off) = *(const LAS v4u*)(L + GP_Q + off); *(v4u*)((char*)(KEd + row0 * 512) + off) = *(const LAS v4u*)(L + GP_K + off); }
    }
}

constexpr int GS_QE = 0, GS_KE = 17408, GS_V = 34816, GS_CC = 44032, GS_BUF = 45568, GS_P = 3 * GS_BUF, GS_PB = 9216;
static_assert(GS_P + 2 * GS_PB <= LDSCTL_OFF, "gla scan LDS");
__device__ __forceinline__ void gla_scan(Frame& F) {
    const int lane = lane_id(), tid = F.wave * 64 + lane, w = F.wave, r16 = lane & 15, g4 = lane >> 4;
    LAS unsigned char* L = F.lds;
    const bf16* V0 = (const bf16*)(F.ws + WS_V0);
    for (int unit = F.vcu; unit < 256; unit += F.G) {
        const int combo = unit >> 2, dvq = unit & 3, dir = combo & 1, h = (combo >> 1) & 3, b = combo >> 3;
        const bf16* QEg = (const bf16*)(F.ws + WS_QE) + (size_t)dir * 2 * NTOK * 512; const bf16* KEg = QEg + (size_t)NTOK * 512;
        const float* CCg = (const float*)(F.ws + WS_CC) + (size_t)(dir * 8 + b) * 128 * 512;
        bf16* Og = dir ? (bf16*)((unsigned char*)F.out + OUT_OB) : (bf16*)(F.ws + WS_OF);
        v4u rqA[4], rkA[4], rvA[2], rcA, rqB[4], rkB[4], rvB[2], rcB;
        const int st = tid & 255, sqrow = st >> 4, sqch = st & 15, svrow = st >> 3, svch = st & 7, sct = st & 31;
        const long tstride = dir ? -64 : 64;
        const bf16* pQ = QEg + ((size_t)b * SEQ + (dir ? 127 * 64 : 0) + sqrow) * 512 + h * 128 + sqch * 8; const bf16* pK = pQ + (size_t)NTOK * 512;
        const bf16* pV = V0 + ((size_t)b * SEQ + (dir ? 127 * 64 : 0) + svrow) * 1024 + h * 256 + dvq * 64 + svch * 8;
        const float* pC = CCg + h * 128 + sct * 4;
#define GS_LOAD(c_, X) do { _Pragma("unroll") for (int k_ = 0; k_ < 4; ++k_) { rq##X[k_] = *(const v4u*)(pQ + k_ * 16 * 512); rk##X[k_] = *(const v4u*)(pK + k_ * 16 * 512); } \
        rv##X[0] = *(const v4u*)pV; rv##X[1] = *(const v4u*)(pV + 32 * 1024); rc##X = *(const v4u*)pC; \
        pQ += tstride * 512; pK += tstride * 512; pV += tstride * 1024; pC += 512; } while (0)
#define GS_STORE(buf_, X) do { LAS unsigned char* B_ = L + (buf_) * GS_BUF; \
        _Pragma("unroll") for (int k_ = 0; k_ < 4; ++k_) { *(LAS v4u*)(B_ + GS_QE + (sqrow + 16 * k_) * 272 + sqch * 16) = rq##X[k_]; *(LAS v4u*)(B_ + GS_KE + (sqrow + 16 * k_) * 272 + sqch * 16) = rk##X[k_]; } \
        *(LAS v4u*)(B_ + GS_V + svrow * 144 + svch * 16) = rv##X[0]; *(LAS v4u*)(B_ + GS_V + (svrow + 32) * 144 + svch * 16) = rv##X[1]; \
        if (st < 32) *(LAS v4u*)(B_ + GS_CC + st * 16) = rc##X; } while (0)
        int sit[3], sjt[3];
        { const int s2 = 2 * (w & 3); const int i0 = (123 >> s2) & 3, i1 = (27 >> s2) & 3, j0 = (48 >> s2) & 3, j1 = (21 >> s2) & 3, j2 = (26 >> s2) & 3;
          sit[0] = dir ? 3 - i0 : i0; sit[1] = dir ? 3 - i1 : i1; sit[2] = sit[1]; sjt[0] = dir ? 3 - j0 : j0; sjt[1] = dir ? 3 - j1 : j1; sjt[2] = dir ? 3 - j2 : j2; }
        bool skeep[4];
#pragma unroll
        for (int r = 0; r < 4; ++r) { const int j_ = 4 * g4 + r; skeep[r] = dir ? (j_ > r16) : (j_ <= r16); }
#define GS_SCORES(tb_, pb_) do { const LAS unsigned char* B_ = L + (tb_) * GS_BUF; LAS unsigned char* P_ = L + GS_P + (pb_) * GS_PB; \
        bf16x8 qf_[2][4], kf_[3][4];                                         \
        _Pragma("unroll") for (int k_ = 0; k_ < 3; ++k_) _Pragma("unroll") for (int ks = 0; ks < 4; ++ks) { \
            if (k_ < 2) qf_[k_][ks] = *(const LAS bf16x8*)(B_ + GS_QE + (16 * sit[k_] + r16) * 272 + ks * 64 + g4 * 16); kf_[k_][ks] = *(const LAS bf16x8*)(B_ + GS_KE + (16 * sjt[k_] + r16) * 272 + ks * 64 + g4 * 16); } \
        __builtin_amdgcn_sched_barrier(0); \
        f32x4 pa_[3]; \
        _Pragma("unroll") for (int k_ = 0; k_ < 3; ++k_) { pa_[k_] = (f32x4){0.f, 0.f, 0.f, 0.f}; _Pragma("unroll") for (int ks = 0; ks < 4; ++ks) pa_[k_] = mfma16(kf_[k_][ks], qf_[k_ < 2 ? k_ : 1][ks], pa_[k_]); } \
        _Pragma("unroll") for (int k_ = 0; k_ < 3; ++k_) { const bool diag_ = sit[k_] == sjt[k_]; \
            _Pragma("unroll") for (int r = 0; r < 4; ++r) pa_[k_][r] = (diag_ && !skeep[r]) ? 0.f : pa_[k_][r]; \
            *(LAS u32x2*)(P_ + (16 * sit[k_] + r16) * 144 + (16 * sjt[k_] + 4 * g4) * 2) = (u32x2){cvtpk(pa_[k_][0], pa_[k_][1]), cvtpk(pa_[k_][2], pa_[k_][3])}; } } while (0)
        LBAR();
#define GS_STEP_SCORE(cc, XS, XL) do { const int c = (cc); const int tbn = (c + 1) % 3, tbw = (c + 2) % 3, pb = c & 1; \
            GS_LOAD(c + 3, XL); if (c + 1 < 128) GS_SCORES(tbn, pb ^ 1); GS_STORE(tbw, XS); LBAR(); } while (0)
#define GS_STEP_STATE(cc) do { const int c = (cc); const int tb = c % 3, pb = c & 1; \
            const LAS unsigned char* B = L + tb * GS_BUF; const LAS unsigned char* P = L + GS_P + pb * GS_PB; \
            const int orig = dir ? 127 - c : c; const size_t row0 = (size_t)b * SEQ + 64 * orig; \
              \
            bf16x8 vf[2]; u32x4 qe[2][2][4]; bf16x8 pf[2][2][2]; bf16x8 kt[2][2][2]; f32x4 decn[2][2]; \
_Pragma("unroll")             for (int kk = 0; kk < 2; ++kk) { const LAS unsigned char* a = B + GS_V + (32 * kk + 8 * g4 + (r16 >> 2)) * 144 + (16 * w + 4 * (r16 & 3)) * 2; vf[kk] = cat8(ldtr(a), ldtr(a + 4 * 144)); } \
            GS_RD_A(0); GS_RD_A(1); GS_RD_B(0, 0); \
            __builtin_amdgcn_sched_barrier(0); \
            GS_CMP_A(0); __builtin_amdgcn_sched_barrier(0); \
            GS_CMP_A(1); __builtin_amdgcn_sched_barrier(0); \
            GS_RD_B(1, 1); __builtin_amdgcn_sched_barrier(0); GS_CMP_B(0, 0); __builtin_amdgcn_sched_barrier(0); \
            GS_RD_B(2, 0); __builtin_amdgcn_sched_barrier(0); GS_CMP_B(1, 1); __builtin_amdgcn_sched_barrier(0); \
            GS_RD_B(3, 1); __builtin_amdgcn_sched_barrier(0); GS_CMP_B(2, 0); __builtin_amdgcn_sched_barrier(0); \
            GS_CMP_B(3, 1); \
            LBAR(); } while (0)
#define GS_RD_A(ih) do { _Pragma("unroll") for (int i2 = 0; i2 < 2; ++i2) { const int it = 2 * (ih) + i2; \
_Pragma("unroll")                 for (int ks = 0; ks < 4; ++ks) { const LAS unsigned char* qa = B + GS_QE + (16 * it + r16) * 272 + (32 * ks + 4 * g4) * 2; \
                    const u32x2 q0 = *(const LAS u32x2*)qa, q1 = *(const LAS u32x2*)(qa + 32); qe[ih][i2][ks] = (u32x4){q0.x, q0.y, q1.x, q1.y}; } \
_Pragma("unroll")                 for (int kk = 0; kk < 2; ++kk) pf[ih][i2][kk] = *(const LAS bf16x8*)(P + (16 * it + r16) * 144 + (32 * kk + 8 * g4) * 2); } } while (0)
#define GS_CMP_A(ih) do { _Pragma("unroll") for (int i2 = 0; i2 < 2; ++i2) { const int it = 2 * (ih) + i2; f32x4 o = (f32x4){0.f, 0.f, 0.f, 0.f}; \
_Pragma("unroll")                 for (int ks = 0; ks < 4; ++ks) o = mfma16(sbf[ks], __builtin_bit_cast(bf16x8, qe[ih][i2][ks]), o); \
_Pragma("unroll")                 for (int kk = 0; kk < 2; ++kk) o = mfma16(vf[kk], pf[ih][i2][kk], o); \
                { u32x2* op_ = (u32x2*)(Og + (row0 + 16 * it + r16) * 1024 + h * 256 + dvq * 64 + 16 * w + 4 * g4); const u32x2 ov_ = (u32x2){cvtpk(o[0], o[1]), cvtpk(o[2], o[3])}; *op_ = ov_; } } } while (0)
#define GS_RD_B(ks, s_) do { _Pragma("unroll") for (int d = 0; d < 2; ++d) { const int dkt = 2 * (ks) + d; \
_Pragma("unroll")                 for (int kk = 0; kk < 2; ++kk) { const LAS unsigned char* a = B + GS_KE + (32 * kk + 8 * g4 + (r16 >> 2)) * 272 + (16 * dkt + 4 * (r16 & 3)) * 2; kt[s_][d][kk] = cat8(ldtr(a), ldtr(a + 4 * 272)); } \
                decn[s_][d] = *(const LAS f32x4*)(B + GS_CC + (16 * dkt + 4 * g4) * 4); } } while (0)
#define GS_CMP_B(ks, s_) do { u32x2 sw[2]; \
_Pragma("unroll")             for (int d = 0; d < 2; ++d) { const int dkt = 2 * (ks) + d; f32x4 ua = (f32x4){0.f, 0.f, 0.f, 0.f}; \
_Pragma("unroll")                 for (int kk = 0; kk < 2; ++kk) ua = mfma16(kt[s_][d][kk], vf[kk], ua); \
                sacc[dkt] = (sacc[dkt] + ua) * decn[s_][d]; \
                const f32x4 sb = sacc[dkt]; sw[d] = (u32x2){cvtpk(sb[0], sb[1]), cvtpk(sb[2], sb[3])}; } \
            sbf[ks] = __builtin_bit_cast(bf16x8, (u32x4){sw[0].x, sw[0].y, sw[1].x, sw[1].y}); } while (0)
        if (w >= 4) {
            GS_LOAD(0, A); GS_LOAD(1, B);
            for (int o = st * 16; o < 2 * GS_PB; o += 4096) *(LAS v4u*)(L + GS_P + o) = (v4u){0u, 0u, 0u, 0u};
            GS_STORE(0, A); GS_STORE(1, B); GS_LOAD(2, A);
            LBAR();
            GS_SCORES(0, 0);
            LBAR();
            for (int c2 = 0; c2 < 128; c2 += 2) { GS_STEP_SCORE(c2, A, B); GS_STEP_SCORE(c2 + 1, B, A); }
        } else {
            f32x4 sacc[8]; bf16x8 sbf[4];
#pragma unroll
            for (int d = 0; d < 8; ++d) sacc[d] = (f32x4){0.f, 0.f, 0.f, 0.f};
#pragma unroll
            for (int ks = 0; ks < 4; ++ks) sbf[ks] = (bf16x8){0, 0, 0, 0, 0, 0, 0, 0};
            LBAR();
            LBAR();
            for (int c2 = 0; c2 < 128; ++c2) GS_STEP_STATE(c2);
        }
#undef GS_STEP_SCORE
#undef GS_STEP_STATE
#undef GS_RD_A
#undef GS_CMP_A
#undef GS_RD_B
#undef GS_CMP_B
#undef GS_LOAD
#undef GS_STORE
#undef GS_SCORES
    }
}

__device__ __forceinline__ void gla_post(Frame& F) {
    const int gw = F.vcu * NWAVES + F.wave, NGW = F.G * NWAVES, lane = lane_id();
    const bf16* OFp = (const bf16*)(F.ws + WS_OF); const bf16* OBp = (const bf16*)((const unsigned char*)F.out + OUT_OB); const bf16* R0 = (const bf16*)(F.ws + WS_R0); bf16* Gp = (bf16*)(F.ws + WS_G);
    float gn[16];
#pragma unroll
    for (int j = 0; j < 4; ++j) { const f32x4 t = *(const f32x4*)(F.in[8] + 16 * lane + 4 * j); gn[4 * j] = t.x; gn[4 * j + 1] = t.y; gn[4 * j + 2] = t.z; gn[4 * j + 3] = t.w; }
    v4u nx[6];
    if (gw < NTOK) { const size_t off = (size_t)gw * 1024 + 16 * lane; nx[0] = *(const v4u*)(OFp + off); nx[1] = *(const v4u*)(OFp + off + 8); nx[2] = *(const v4u*)(OBp + off); nx[3] = *(const v4u*)(OBp + off + 8); nx[4] = *(const v4u*)(R0 + off); nx[5] = *(const v4u*)(R0 + off + 8); }
    for (int m = gw; m < NTOK; m += NGW) {
        const size_t off = (size_t)m * 1024 + 16 * lane;
        const v4u a0 = nx[0], a1 = nx[1], b0 = nx[2], b1 = nx[3], r0 = nx[4], r1 = nx[5];
        { const int mn = (m + NGW < NTOK) ? m + NGW : m; const size_t offn = (size_t)mn * 1024 + 16 * lane;
          nx[0] = *(const v4u*)(OFp + offn); nx[1] = *(const v4u*)(OFp + offn + 8); nx[2] = *(const v4u*)(OBp + offn); nx[3] = *(const v4u*)(OBp + offn + 8); nx[4] = *(const v4u*)(R0 + offn); nx[5] = *(const v4u*)(R0 + offn + 8); }
        float o[16], rr[16]; float ss = 0.f;
#pragma unroll
        for (int j = 0; j < 4; ++j) { o[2 * j] = bf_lo(a0[j]) + bf_lo(b0[j]); o[2 * j + 1] = bf_hi(a0[j]) + bf_hi(b0[j]); o[8 + 2 * j] = bf_lo(a1[j]) + bf_lo(b1[j]); o[8 + 2 * j + 1] = bf_hi(a1[j]) + bf_hi(b1[j]);
            rr[2 * j] = bf_lo(r0[j]); rr[2 * j + 1] = bf_hi(r0[j]); rr[8 + 2 * j] = bf_lo(r1[j]); rr[8 + 2 * j + 1] = bf_hi(r1[j]); }
#pragma unroll
        for (int j = 0; j < 16; ++j) ss += o[j] * o[j];
        ss += __shfl_xor(ss, 1); ss += __shfl_xor(ss, 2); ss += __shfl_xor(ss, 4); ss += __shfl_xor(ss, 8);
        const float rs = 1.0f / sqrtf(ss * (1.f / 256.f) + NORM_EPS);
        float y[16];
#pragma unroll
        for (int j = 0; j < 16; ++j) y[j] = o[j] * rs * gn[j] * pg8::silu_f(rr[j]);
        v4u w0, w1;
#pragma unroll
        for (int j = 0; j < 4; ++j) { w0[j] = cvtpk(y[2 * j], y[2 * j + 1]); w1[j] = cvtpk(y[8 + 2 * j], y[8 + 2 * j + 1]); }
        *(v4u*)(Gp + off) = w0; *(v4u*)(Gp + off + 8) = w1;
    }
}

constexpr int AT_K = 0, AT_V = 55296, AT_STRIDE = 144;
static_assert(2 * 55296 <= RING_BYTES, "attention LDS");
__device__ __forceinline__ void swa_attn(Frame& F) {
    const int lane = lane_id(), tid = F.wave * 64 + lane, w = F.wave, r16 = lane & 15, g4 = lane >> 4;
    LAS unsigned char* L = F.lds + RING_OFF;
    const bf16* Q1 = (const bf16*)(F.ws + WS_Q1); const bf16* K1 = (const bf16*)(F.ws + WS_K1); const bf16* V1 = (const bf16*)(F.ws + WS_V1); bf16* O1 = (bf16*)(F.ws + WS_O1);
    v4u kr[6], vr[6];
#define AT_FETCH(u_) do { const int b_ = (u_) >> 8, g_ = ((u_) >> 6) & 3, kb_ = (((u_) & 63) - 1) * 128; \
        _Pragma("unroll") for (int i = 0; i < 6; ++i) { const int piece = tid + 512 * i, row = piece >> 3, ch = piece & 7; int tok = kb_ + row; tok = tok < 0 ? 0 : (tok >= SEQ ? SEQ - 1 : tok); \
            const size_t go = ((size_t)b_ * SEQ + tok) * 256 + g_ * 64 + ch * 8; kr[i] = *(const v4u*)(K1 + go); vr[i] = *(const v4u*)(V1 + go); } } while (0)
    if (F.vcu < 2048) AT_FETCH(F.vcu);
    for (int u = F.vcu; u < 2048; u += F.G) {
        const int b = u >> 8, g = (u >> 6) & 3, nb = u & 63;
        const int kbase = (nb - 1) * 128;
        LBAR();
#pragma unroll
        for (int i = 0; i < 6; ++i) { const int piece = tid + 512 * i, row = piece >> 3, ch = piece & 7;
            *(LAS v4u*)(L + AT_K + row * AT_STRIDE + ch * 16) = kr[i]; *(LAS v4u*)(L + AT_V + row * AT_STRIDE + ch * 16) = vr[i]; }
        const int hq = 4 * g + (w >> 1), q0w = nb * 128 + 64 * (w & 1);
        bf16x8 qfa[4][2];
#pragma unroll
        for (int qt = 0; qt < 4; ++qt)
#pragma unroll
            for (int ks = 0; ks < 2; ++ks) qfa[qt][ks] = *(const bf16x8*)(Q1 + ((size_t)b * SEQ + q0w + 16 * qt + r16) * 1024 + hq * 64 + 32 * ks + 8 * g4);
        { const int un = (u + F.G < 2048) ? u + F.G : u; AT_FETCH(un); }
        const float slope = exp2f(-0.5f * (float)(hq + 1)) * LOG2E, sink2 = F.in[12][hq] * LOG2E;
        const float clf = (float)(r16 - 4 * g4);
        LBAR();
        for (int pass = 0; pass < 2; ++pass) {
            const int q0 = q0w + 32 * pass;
            bf16x8 qf[2][2];
#pragma unroll
            for (int qt = 0; qt < 2; ++qt)
#pragma unroll
                for (int ks = 0; ks < 2; ++ks) qf[qt][ks] = pass ? qfa[2 + qt][ks] : qfa[qt][ks];
            float mrun[2], lrun[2]; f32x4 oacc[2][4];
#pragma unroll
            for (int qt = 0; qt < 2; ++qt) { mrun[qt] = sink2; lrun[qt] = (g4 == 0) ? 1.f : 0.f;
#pragma unroll
                for (int dt = 0; dt < 4; ++dt) oacc[qt][dt] = (f32x4){0.f, 0.f, 0.f, 0.f}; }
            for (int t = 0; t < 9; ++t) {
                const int ktok0 = q0 - 128 + 32 * t, s0 = ktok0 - kbase;
                if (ktok0 < 0 || ktok0 >= SEQ) continue;
                bf16x8 kf[2][2];
#pragma unroll
                for (int sub = 0; sub < 2; ++sub)
#pragma unroll
                    for (int ks = 0; ks < 2; ++ks) kf[sub][ks] = *(const LAS bf16x8*)(L + AT_K + (s0 + 16 * sub + r16) * AT_STRIDE + ks * 64 + g4 * 16);
                bf16x8 vf[4];
#pragma unroll
                for (int dt = 0; dt < 4; ++dt) { const LAS unsigned char* a = L + AT_V + (s0 + 4 * g4 + (r16 >> 2)) * AT_STRIDE + (16 * dt + 4 * (r16 & 3)) * 2; vf[dt] = cat8(ldtr(a), ldtr(a + 16 * AT_STRIDE)); }
#pragma unroll
                for (int qt = 0; qt < 2; ++qt) {
                    f32x4 s[2];
#pragma unroll
                    for (int sub = 0; sub < 2; ++sub) { s[sub] = (f32x4){0.f, 0.f, 0.f, 0.f};
#pragma unroll
                        for (int ks = 0; ks < 2; ++ks) s[sub] = mfma16(kf[sub][ks], qf[qt][ks], s[sub]); }
                    const int d0 = 128 - 32 * t + 16 * qt; float mx = -INFINITY;
                    if ((d0 >= 31 && d0 <= 113) || (d0 <= -15 && d0 >= -97)) {
                        const float sg = d0 > 0 ? -slope : slope, b0 = -slope * (float)(d0 > 0 ? d0 : -d0) + sg * clf;
#pragma unroll
                        for (int sub = 0; sub < 2; ++sub)
#pragma unroll
                            for (int r = 0; r < 4; ++r) { const float v = s[sub][r] + (b0 - sg * (float)(16 * sub + r)); s[sub][r] = v; mx = fmaxf(mx, v); }
                    } else {
                        const float dlf = clf + (float)d0;
#pragma unroll
                        for (int sub = 0; sub < 2; ++sub)
#pragma unroll
                            for (int r = 0; r < 4; ++r) { const float ad = __builtin_fabsf(dlf - (float)(16 * sub + r));
                                float v = __builtin_fmaf(-slope, ad, s[sub][r]); v = (ad > 128.0f) ? -INFINITY : v; s[sub][r] = v; mx = fmaxf(mx, v); }
                    }
                    if (__any(mx > mrun[qt] + 6.0f)) {
                        mx = fmaxf(mx, __shfl_xor(mx, 16)); mx = fmaxf(mx, __shfl_xor(mx, 32));
                        const float mnew = fmaxf(mrun[qt], mx), alpha = __builtin_amdgcn_exp2f(mrun[qt] - mnew); mrun[qt] = mnew; lrun[qt] *= alpha;
#pragma unroll
                        for (int dt = 0; dt < 4; ++dt) oacc[qt][dt] = oacc[qt][dt] * alpha;
                    }
                    const float off = -mrun[qt]; float ps = 0.f;
#pragma unroll
                    for (int sub = 0; sub < 2; ++sub)
#pragma unroll
                        for (int r = 0; r < 4; ++r) { const float p = __builtin_amdgcn_exp2f(s[sub][r] + off); s[sub][r] = p; ps += p; }
                    lrun[qt] += ps;
                    const u32x4 pw = (u32x4){cvtpk(s[0][0], s[0][1]), cvtpk(s[0][2], s[0][3]), cvtpk(s[1][0], s[1][1]), cvtpk(s[1][2], s[1][3])};
#pragma unroll
                    for (int dt = 0; dt < 4; ++dt) oacc[qt][dt] = mfma16(vf[dt], __builtin_bit_cast(bf16x8, pw), oacc[qt][dt]);
                }
            }
#pragma unroll
            for (int qt = 0; qt < 2; ++qt) { float l = lrun[qt]; l += __shfl_xor(l, 16); l += __shfl_xor(l, 32); const float inv = 1.0f / l;
                bf16* op = O1 + ((size_t)b * SEQ + q0 + 16 * qt + r16) * 1024 + hq * 64 + 4 * g4;
#pragma unroll
                for (int dt = 0; dt < 4; ++dt) { const f32x4 o = oacc[qt][dt] * inv; *(u32x2*)(op + 16 * dt) = (u32x2){cvtpk(o[0], o[1]), cvtpk(o[2], o[3])}; } }
        }
    }
}

#undef AT_FETCH
__device__ __forceinline__ void moe_route(Frame& F, const bf16* HB, const float* ssp, const float* gain) {
    const int gw = F.vcu * NWAVES + F.wave, NGW = F.G * NWAVES, lane = lane_id();
    unsigned char* XN = F.ws + WS_XN; int* sel = (int*)(F.ws + WS_SEL); float* wsel = (float*)(F.ws + WS_WSEL); int* wcnt = (int*)(F.ws + WS_WCNT);
    const float* router = F.in[18];
    f32x4 g[4]; f32x4 rt[4][4][2];
#pragma unroll
    for (int j = 0; j < 4; ++j) { g[j] = ((const f32x4*)gain)[lane + 64 * j];
#pragma unroll
        for (int i = 0; i < 4; ++i) { const float* rp = router + (size_t)(256 * j + 4 * lane + i) * 8; rt[j][i][0] = *(const f32x4*)rp; rt[j][i][1] = *(const f32x4*)(rp + 4); } }
    int cnt[8];
#pragma unroll
    for (int e = 0; e < 8; ++e) cnt[e] = 0;
    u32x2 hvn[4]; float sn = 0.f;
    if (gw < NTOK) { const GAS u32x2* xr = (const GAS u32x2*)(HB + (size_t)gw * DM) + lane;
#pragma unroll
        for (int j = 0; j < 4; ++j) hvn[j] = xr[64 * j];
        sn = ssp[(size_t)gw * 16 + (lane & 15)]; }
    for (int m = gw; m < NTOK; m += NGW) {
        u32x2 hvc[4]; float s = sn;
#pragma unroll
        for (int j = 0; j < 4; ++j) hvc[j] = hvn[j];
        { const int mn = (m + NGW < NTOK) ? m + NGW : m; const GAS u32x2* xr = (const GAS u32x2*)(HB + (size_t)mn * DM) + lane;
#pragma unroll
          for (int j = 0; j < 4; ++j) hvn[j] = xr[64 * j];
          sn = ssp[(size_t)mn * 16 + (lane & 15)]; }
        s += __shfl_xor(s, 1); s += __shfl_xor(s, 2); s += __shfl_xor(s, 4); s += __shfl_xor(s, 8);
        const float rs = 1.0f / sqrtf(s * (1.f / DM) + NORM_EPS);
        GAS unsigned* o4 = (GAS unsigned*)(XN + (size_t)m * DM) + lane;
        float lg[8];
#pragma unroll
        for (int e = 0; e < 8; ++e) lg[e] = 0.f;
#pragma unroll
        for (int j = 0; j < 4; ++j) { const u32x2 hv = hvc[j]; const f32x4 v = (f32x4){bf_lo(hv.x), bf_hi(hv.x), bf_lo(hv.y), bf_hi(hv.y)};
            const f32x4 o = v * rs * g[j]; o4[64 * j] = pk4f8(o.x * XSCALE, o.y * XSCALE, o.z * XSCALE, o.w * XSCALE);
#pragma unroll
            for (int i = 0; i < 4; ++i)
#pragma unroll
                for (int e = 0; e < 8; ++e) lg[e] += o[i] * rt[j][i][e >> 2][e & 3]; }
#pragma unroll
        for (int e = 0; e < 8; ++e) lg[e] = wave_sum(lg[e]);
        int e0 = 0; float l0 = lg[0];
#pragma unroll
        for (int e = 1; e < 8; ++e) if (lg[e] > l0) { l0 = lg[e]; e0 = e; }
        int e1 = -1; float l1 = -INFINITY;
#pragma unroll
        for (int e = 0; e < 8; ++e) if (e != e0 && lg[e] > l1) { l1 = lg[e]; e1 = e; }
        const float w0 = 1.0f / (1.0f + __expf(l1 - l0)), w1 = 1.0f - w0;
        int rk0 = 0, rk1 = 0;
#pragma unroll
        for (int e = 0; e < 8; ++e) { rk0 = (e0 == e) ? cnt[e] : rk0; rk1 = (e1 == e) ? cnt[e] : rk1; cnt[e] += ((e0 == e) ? 1 : 0) + ((e1 == e) ? 1 : 0); }
        if (lane == 0) { *(int4*)(sel + (size_t)m * 4) = make_int4(e0, e1, rk0, rk1); *(float2*)(wsel + (size_t)m * 2) = make_float2(w0, w1); }
    }
    if (lane < 8) { int cv = 0;
#pragma unroll
        for (int e = 0; e < 8; ++e) cv = (lane == e) ? cnt[e] : cv;
        wcnt[(size_t)gw * 8 + lane] = cv; }
}
__device__ __forceinline__ void moe_gather(Frame& F) {
    const int gw = F.vcu * NWAVES + F.wave, NGW = F.G * NWAVES, lane = lane_id();
    const unsigned char* XN = F.ws + WS_XN; unsigned char* XS = F.ws + WS_XS;
    const int* sel = (const int*)(F.ws + WS_SEL); const float* wsel = (const float*)(F.ws + WS_WSEL); const int* wcnt = (const int*)(F.ws + WS_WCNT);
    int* postok = (int*)(F.ws + WS_POSTOK); float* roww = (float*)(F.ws + WS_ROWW); int* meta = (int*)(F.ws + WS_META);
    int base[8], tot[8];
#pragma unroll
    for (int e = 0; e < 8; ++e) { base[e] = 0; tot[e] = 0; }
    for (int w0 = lane; w0 < NGW; w0 += 64 * 8) {
        int4 av[8], cv[8];
#pragma unroll
        for (int j = 0; j < 8; ++j) { const int w2 = w0 + 64 * j, wc = (w2 < NGW) ? w2 : lane; av[j] = *(const int4*)(wcnt + (size_t)wc * 8); cv[j] = *(const int4*)(wcnt + (size_t)wc * 8 + 4); }
#pragma unroll
        for (int j = 0; j < 8; ++j) { const int w2 = w0 + 64 * j; const int vz = (w2 < NGW) ? 1 : 0, lt = (w2 < gw) ? vz : 0; const int4 a = av[j], c = cv[j];
            tot[0] += vz * a.x; tot[1] += vz * a.y; tot[2] += vz * a.z; tot[3] += vz * a.w; tot[4] += vz * c.x; tot[5] += vz * c.y; tot[6] += vz * c.z; tot[7] += vz * c.w;
            base[0] += lt * a.x; base[1] += lt * a.y; base[2] += lt * a.z; base[3] += lt * a.w; base[4] += lt * c.x; base[5] += lt * c.y; base[6] += lt * c.z; base[7] += lt * c.w; } }
    int ts[9]; ts[0] = 0;
#pragma unroll
    for (int e = 0; e < 8; ++e) { tot[e] = wave_sum_i(tot[e]); base[e] = wave_sum_i(base[e]); ts[e + 1] = ts[e] + ((tot[e] + 255) >> 8); base[e] += ts[e] * 256; }
    if (gw == 0 && lane < 9) { int tv = 0;
#pragma unroll
        for (int e = 0; e < 9; ++e) tv = (lane == e) ? ts[e] : tv;
        meta[lane] = tv; }
    for (int m0 = gw; m0 < NTOK; m0 += 4 * NGW) {
        int4 sv[4]; float2 wv[4]; v4u a0[4];
#pragma unroll
        for (int j = 0; j < 4; ++j) { const int m = (m0 + j * NGW < NTOK) ? m0 + j * NGW : m0;
            sv[j] = *(const int4*)(sel + (size_t)m * 4); wv[j] = *(const float2*)(wsel + (size_t)m * 2); a0[j] = *(const v4u*)(XN + (size_t)m * 1024 + 16 * lane); }
#pragma unroll
        for (int j = 0; j < 4; ++j) { const int m = m0 + j * NGW; if (m < NTOK) {
            int p0 = 0, p1 = 0;
#pragma unroll
            for (int e = 0; e < 8; ++e) { p0 = (sv[j].x == e) ? base[e] : p0; p1 = (sv[j].y == e) ? base[e] : p1; }
            p0 += sv[j].z; p1 += sv[j].w;
            *(v4u*)(XS + (size_t)p0 * 1024 + 16 * lane) = a0[j]; *(v4u*)(XS + (size_t)p1 * 1024 + 16 * lane) = a0[j];
            if (lane == 0) { roww[p0] = wv[j].x; roww[p1] = wv[j].y; *(int2*)(postok + (size_t)m * 2) = make_int2(p0, p1); } } }
    }
}
__device__ __forceinline__ void final_rows(Frame& F, const bf16* HB, float* out, const float* gain) {
    const int gw = F.vcu * NWAVES + F.wave, NGW = F.G * NWAVES, lane = lane_id();
    const bf16* Y = (const bf16*)(F.ws + WS_XS); const int* postok = (const int*)(F.ws + WS_POSTOK);
    f32x4 g[4];
#pragma unroll
    for (int j = 0; j < 4; ++j) g[j] = ((const f32x4*)gain)[lane + 64 * j];
    u32x2 hv[4], ya[4], yc[4]; int2 ppn = make_int2(0, 0);
    if (gw < NTOK) { const int2 pp = *(const int2*)(postok + (size_t)gw * 2);
        const GAS u32x2* hr = (const GAS u32x2*)(HB + (size_t)gw * DM) + lane; const u32x2* y0 = (const u32x2*)(Y + (size_t)pp.x * 1024) + lane; const u32x2* y1 = (const u32x2*)(Y + (size_t)pp.y * 1024) + lane;
#pragma unroll
        for (int j = 0; j < 4; ++j) { hv[j] = hr[64 * j]; ya[j] = y0[64 * j]; yc[j] = y1[64 * j]; }
        const int m1 = (gw + NGW < NTOK) ? gw + NGW : gw; ppn = *(const int2*)(postok + (size_t)m1 * 2); }
    for (int m = gw; m < NTOK; m += NGW) {
        u32x2 hvc[4], yac[4], ycc[4];
#pragma unroll
        for (int j = 0; j < 4; ++j) { hvc[j] = hv[j]; yac[j] = ya[j]; ycc[j] = yc[j]; }
        { const int m1 = (m + NGW < NTOK) ? m + NGW : m, m2 = (m + 2 * NGW < NTOK) ? m + 2 * NGW : m; const int2 pp = ppn;
          const GAS u32x2* hr = (const GAS u32x2*)(HB + (size_t)m1 * DM) + lane; const u32x2* y0 = (const u32x2*)(Y + (size_t)pp.x * 1024) + lane; const u32x2* y1 = (const u32x2*)(Y + (size_t)pp.y * 1024) + lane;
#pragma unroll
          for (int j = 0; j < 4; ++j) { hv[j] = hr[64 * j]; ya[j] = y0[64 * j]; yc[j] = y1[64 * j]; }
          ppn = *(const int2*)(postok + (size_t)m2 * 2); }
        GAS f32x4* xr = (GAS f32x4*)(out + (size_t)m * DM) + lane;
        f32x4 v[4]; float s = 0.f;
#pragma unroll
        for (int j = 0; j < 4; ++j) { const u32x2 h2 = hvc[j], a = yac[j], c = ycc[j];
            v[j].x = bf_lo(h2.x) + bf_lo(a.x) + bf_lo(c.x); v[j].y = bf_hi(h2.x) + bf_hi(a.x) + bf_hi(c.x); v[j].z = bf_lo(h2.y) + bf_lo(a.y) + bf_lo(c.y); v[j].w = bf_hi(h2.y) + bf_hi(a.y) + bf_hi(c.y);
            s += (v[j].x * v[j].x + v[j].y * v[j].y) + (v[j].z * v[j].z + v[j].w * v[j].w); }
        const float rs = 1.0f / sqrtf(wave_sum(s) * (1.f / DM) + NORM_EPS);
#pragma unroll
        for (int j = 0; j < 4; ++j) xr[64 * j] = v[j] * rs * g[j];
    }
}

struct Args { const float* in[23]; float* out; unsigned char* ws; int ph_lo, ph_hi; };
__global__ void __launch_bounds__(NWAVES * 64, 2) fwd_kernel(Args args) {
    extern __shared__ __attribute__((aligned(16))) unsigned char lds[];
    Frame F;
    F.lds = (LAS unsigned char*)lds;
    F.MISC = (volatile LAS unsigned*)(F.lds + MISC_OFF);
    F.wave = __builtin_amdgcn_readfirstlane((int)threadIdx.x >> 6);
    F.G = gridDim.x; { const int bx = blockIdx.x; F.vcu = (F.G % 8 == 0) ? (bx % 8) * (F.G / 8) + bx / 8 : bx; }
    F.ws = args.ws; F.out = args.out;
    F.in = args.in;
    for (int u = F.wave * 64 + lane_id(); u < (LDS_BYTES - LDSCTL_OFF) / 4; u += NWAVES * 64) ((LAS unsigned*)(F.lds + LDSCTL_OFF))[u] = 0u;
    __syncthreads();
    const int lo = args.ph_lo, hi = args.ph_hi;
    if (hi - lo > 1) (void)xcd_barrier_post((unsigned*)(F.ws + WS_CTL) + CW_BAR, F.MISC + 8, (F.wave == 0 && lane_id() == 0) ? 1u : 0u);
#define MKBAR() do { XcdBarrier bar_; bar_.bar = (unsigned*)(F.ws + WS_CTL) + CW_BAR; bar_.x = xb_xcc_id(); bar_.st = (volatile LAS unsigned*)(F.lds + MISC_OFF) + 8; bar_.t0 = (F.wave == 0 && lane_id() == 0) ? 1u : 0u; xcd_barrier(bar_); } while (0)
#ifndef MK_PHASE_MASK
#define MK_PHASE_MASK 0xFFFFu
#endif
#define IN(k) (((MK_PHASE_MASK >> (k)) & 1u) && lo <= (k) && (k) < hi)
#ifndef MK_BAR_REP
#define MK_BAR_REP 1
#endif
#define SEAM(k) do { if (IN(k) && IN((k) + 1)) { _Pragma("nounroll") for (int r_ = 0; r_ < MK_BAR_REP; ++r_) MKBAR(); } } while (0)
    bf16* XB = (bf16*)((unsigned char*)F.out + OUT_XB); bf16* HB = (bf16*)(F.ws + WS_HB);

#define PH0 do { p0_weights(F, args.in[3], args.in[9], args.in[10], args.in[13], args.in[15], args.in[16], args.in[17], args.in[19], args.in[20], args.in[21], F.in[1], F.in[2], F.in[1] + DM); \
        convert_rows(F, F.in[0], XB, (float*)(F.ws + WS_SS0), args.in[3], F.in[1], (float*)(F.ws + WS_LR)); } while (0)
#define PH1 do { pg8::Gemm g{XB, (const bf16*)(F.ws + WS_W_GLAIN), NTOK, 3072, 1024}; pg8::StaticOrder S0; S0.init(NTOK, 3072, F.G, (int)blockIdx.x); const auto S = pg8::unitlist_fill(F.lds + UL_OFF, S0, F.wave); \
        pg8::rowcache_fill(F.lds + AUX_OFF, S, (const float*)(F.ws + WS_SS0), 1, F.wave); \
        pg8::EpiGlaIn E{(bf16*)(F.ws + WS_Q0), (bf16*)(F.ws + WS_K0), (bf16*)(F.ws + WS_V0), (bf16*)(F.ws + WS_R0), (float*)(F.ws + WS_LR), (const float*)(F.ws + WS_SS0), F.lds + AUX_OFF}; \
        pg8::gemm_phase<pg8::EpiGlaIn, pg8::ListOrder<pg8::StaticOrder>, MK_DENSE_ALIGN, MK_DENSE_SP2>(F.lds + RING_OFF, g, S, E, F.wave); } while (0)
#define PH2 do { gla_prep(F); } while (0)
#define PH3 do { gla_scan(F); } while (0)
#define PH4 do { gla_post(F); } while (0)
#define PH5 do { pg8::Gemm g{(const bf16*)(F.ws + WS_G), (const bf16*)(F.ws + WS_W_GLAOUT), NTOK, 1024, 1024}; pg8::StaticOrder S0; S0.init(NTOK, 1024, F.G, (int)blockIdx.x); const auto S = pg8::unitlist_fill(F.lds + UL_OFF, S0, F.wave); \
        pg8::EpiResBf16 E{XB, HB, nullptr, (float*)(F.ws + WS_SSP1), 1.0f}; \
        pg8::gemm_phase<pg8::EpiResBf16, pg8::ListOrder<pg8::StaticOrder>, MK_DENSE_ALIGN, MK_DENSE_SP2>(F.lds + RING_OFF, g, S, E, F.wave); } while (0)
#define PH6 do { pg8::Gemm g{HB, (const bf16*)(F.ws + WS_W_DGU), NTOK, 5632, 1024}; pg8::StaticOrder S0; S0.init(NTOK, 5632, F.G, (int)blockIdx.x); const auto S = pg8::unitlist_fill(F.lds + UL_OFF, S0, F.wave); \
        pg8::rowcache_fill(F.lds + AUX_OFF, S, (const float*)(F.ws + WS_SSP1), 16, F.wave); \
        pg8::EpiSwiglu E{(bf16*)(F.ws + WS_ACT0), DFF, 22, (const float*)(F.ws + WS_SSP1), F.lds + AUX_OFF, MK_DDN_FP8 ? ASCALE : 0.f}; \
        pg8::gemm_phase<pg8::EpiSwiglu, pg8::ListOrder<pg8::StaticOrder>, MK_DENSE_ALIGN, MK_DENSE_SP2>(F.lds + RING_OFF, g, S, E, F.wave); } while (0)
#define PH7 do { pg8::Gemm g{(const bf16*)(F.ws + WS_ACT0), (const bf16*)(F.ws + WS_W_DDN), NTOK, 1024, MK_DDN_FP8 ? DFF / 2 : DFF}; pg8::StaticOrder S0; S0.init(NTOK, 1024, F.G, (int)blockIdx.x); const auto S = pg8::unitlist_fill(F.lds + UL_OFF, S0, F.wave); \
        pg8::EpiResBf16 E{HB, HB, nullptr, (float*)(F.ws + WS_SSP2), MK_DDN_FP8 ? 1.0f / (ASCALE * WSCALE) : 1.0f}; \
        pg8::gemm_phase<pg8::EpiResBf16, pg8::ListOrder<pg8::StaticOrder>, MK_DENSE_ALIGN, MK_DENSE_SP2, (MK_DDN_FP8 != 0)>(F.lds + RING_OFF, g, S, E, F.wave); } while (0)
#define PH8 do { pg8::Gemm g{HB, (const bf16*)(F.ws + WS_W_QKV), NTOK, 1536, 1024}; pg8::StaticOrder S0; S0.init(NTOK, 1536, F.G, (int)blockIdx.x); const auto S = pg8::unitlist_fill(F.lds + UL_OFF, S0, F.wave); \
        pg8::rowcache_fill(F.lds + AUX_OFF, S, (const float*)(F.ws + WS_SSP2), 16, F.wave); \
        pg8::EpiQkv E{(bf16*)(F.ws + WS_Q1), (bf16*)(F.ws + WS_K1), (bf16*)(F.ws + WS_V1), F.in[11], (const float*)(F.ws + WS_SSP2), F.lds + AUX_OFF}; \
        pg8::gemm_phase<pg8::EpiQkv, pg8::ListOrder<pg8::StaticOrder>, MK_DENSE_ALIGN, MK_DENSE_SP2>(F.lds + RING_OFF, g, S, E, F.wave); } while (0)
#define PH9 do { swa_attn(F); } while (0)
#define PH10 do { pg8::Gemm g{(const bf16*)(F.ws + WS_O1), (const bf16*)(F.ws + WS_W_SWAOUT), NTOK, 1024, 1024}; pg8::StaticOrder S0; S0.init(NTOK, 1024, F.G, (int)blockIdx.x); const auto S = pg8::unitlist_fill(F.lds + UL_OFF, S0, F.wave); \
        pg8::EpiResBf16 E{HB, HB, F.in[14], (float*)(F.ws + WS_SSP3), 1.0f}; \
        pg8::gemm_phase<pg8::EpiResBf16, pg8::ListOrder<pg8::StaticOrder>, MK_DENSE_ALIGN, MK_DENSE_SP2>(F.lds + RING_OFF, g, S, E, F.wave); } while (0)
#define PH11 do { moe_route(F, HB, (const float*)(F.ws + WS_SSP3), F.in[2] + DM); } while (0)
#define PH12 do { moe_gather(F); } while (0)
#define PH13 do { pg8::MoeOrder S0; S0.init((const int*)(F.ws + WS_META), 22, F.G, (int)blockIdx.x); const auto S = pg8::unitlist_fill(F.lds + UL_OFF, S0, F.wave); \
        pg8::Gemm g{(const bf16*)(F.ws + WS_XS), (const bf16*)(F.ws + WS_W_MGU), 0, 0, 512}; \
        pg8::EpiSwiglu8 E{F.ws + WS_ACT1, DFF, 22, 1.0f / (XSCALE * WSCALE), ASCALE}; \
        pg8::gemm_phase<pg8::EpiSwiglu8, pg8::ListOrder<pg8::MoeOrder>, MK_P13_ALIGN, MK_P13_SP2, true>(F.lds + RING_OFF, g, S, E, F.wave); } while (0)
#ifndef MK_P14_REV
#define MK_P14_REV 0
#endif
#ifndef MK_P14_ALIGN
#define MK_P14_ALIGN true
#endif
#ifndef MK_P14_SP2
#define MK_P14_SP2 true
#endif
#define PH14 do { pg8::MoeOrder S0; S0.init((const int*)(F.ws + WS_META), 4, F.G, (int)blockIdx.x, MK_P14_REV); const auto S = pg8::unitlist_fill(F.lds + UL_OFF, S0, F.wave); \
        pg8::Gemm g{(const bf16*)(F.ws + WS_ACT1), (const bf16*)(F.ws + WS_W_MDN), 0, 0, DFF / 2}; \
        pg8::rowcache_fill(F.lds + AUX_OFF, S, (const float*)(F.ws + WS_ROWW), 1, F.wave); \
        pg8::EpiMoeDown E{(bf16*)(F.ws + WS_XS), (const float*)(F.ws + WS_ROWW), 0, 1.0f / (ASCALE * WSCALE), F.lds + AUX_OFF}; \
        pg8::gemm_phase<pg8::EpiMoeDown, pg8::ListOrder<pg8::MoeOrder>, MK_P14_ALIGN, MK_P14_SP2, true>(F.lds + RING_OFF, g, S, E, F.wave); } while (0)
#define PH15 do { final_rows(F, HB, F.out, F.in[22]); } while (0)
#ifndef MK_DENSE_ALIGN
#define MK_DENSE_ALIGN true
#endif
#ifndef MK_DENSE_SP2
#define MK_DENSE_SP2 true
#endif
#ifndef MK_P13_ALIGN
#define MK_P13_ALIGN true
#endif
#ifndef MK_P13_SP2
#define MK_P13_SP2 true
#endif
#ifndef MK_REP_PHASE
#define MK_REP_PHASE -1
#endif
#define RUN(k) do { if (IN(k)) { PH##k; if (MK_REP_PHASE == (k)) { MKBAR(); PH##k; } } } while (0)
    RUN(0); SEAM(0); RUN(1); SEAM(1); RUN(2); SEAM(2); RUN(3); SEAM(3); RUN(4); SEAM(4); RUN(5); SEAM(5); RUN(6);
    SEAM(6); RUN(7); SEAM(7); RUN(8); SEAM(8);
    RUN(9); SEAM(9); RUN(10); SEAM(10); RUN(11); SEAM(11); RUN(12); SEAM(12); RUN(13); SEAM(13); RUN(14); SEAM(14); RUN(15);
#undef IN
#undef SEAM
}

extern "C" void kernel_launch(void* const* d_in, const int* in_sizes, int n_in, void* d_out, int out_size, void* d_ws, size_t ws_size, hipStream_t stream) {
    static int grid = 0;
    if (grid == 0) {
        if (n_in != 23 || in_sizes[0] != NTOK * DM || out_size != NTOK * DM || ws_size < WS_END) {
            fprintf(stderr, "kernel_launch: built for 23 inputs, x/out of %d floats, >= %zu bytes of workspace; got n_in %d, in0 %d, out %d, ws %zu; nothing launched\n", NTOK * DM, (size_t)WS_END, n_in, n_in > 0 ? in_sizes[0] : -1, out_size, ws_size); grid = -1; return; }
        int dev = 0, cus = 0, per_cu = 0;
        if (hipGetDevice(&dev) != hipSuccess || hipDeviceGetAttribute(&cus, hipDeviceAttributeMultiprocessorCount, dev) != hipSuccess) { fprintf(stderr, "kernel_launch: device query failed\n"); grid = -1; return; }
        if (hipFuncSetAttribute((const void*)fwd_kernel, hipFuncAttributeMaxDynamicSharedMemorySize, LDS_BYTES) != hipSuccess) { fprintf(stderr, "kernel_launch: hipFuncSetAttribute failed\n"); grid = -1; return; }
        if (hipOccupancyMaxActiveBlocksPerMultiprocessor(&per_cu, (const void*)fwd_kernel, NWAVES * 64, LDS_BYTES) != hipSuccess || per_cu < 1) {
            fprintf(stderr, "kernel_launch: occupancy query reports %d workgroups per CU\n", per_cu); (void)hipGetLastError(); grid = -1; return; }
        grid = cus;
    }
    if (grid < 0) return;
    if (hipMemsetAsync((char*)d_ws + WS_CTL, 0, CTL_ZERO_BYTES, stream) != hipSuccess) { fprintf(stderr, "kernel_launch: memset failed\n"); return; }
    Args a{};
    for (int i = 0; i < 23; ++i) a.in[i] = (const float*)d_in[i];
    a.out = (float*)d_out; a.ws = (unsigned char*)d_ws;
#if MK_ONE_LAUNCH
    a.ph_lo = 0; a.ph_hi = NPHASE;
    hipLaunchKernelGGL(fwd_kernel, dim3(grid), dim3(NWAVES * 64), LDS_BYTES, stream, a);
#else
    for (int p = 0; p < NPHASE; ++p) { a.ph_lo = p; a.ph_hi = p + 1; hipLaunchKernelGGL(fwd_kernel, dim3(grid), dim3(NWAVES * 64), LDS_BYTES, stream, a); }
#endif
    const hipError_t le = hipPeekAtLastError();
    if (le != hipSuccess) fprintf(stderr, "kernel_launch: launch failed: %s\n", hipGetErrorName(le));
}
```

```cpp
#include <hip/hip_runtime.h>
#include <cstdio>
#include <cstdint>
namespace pg8 {
#define PG8_LAS __attribute__((address_space(3)))
typedef unsigned short bf16_t;
typedef short bf16x8 __attribute__((ext_vector_type(8)));
typedef float f32x4 __attribute__((ext_vector_type(4)));
typedef unsigned u32x4 __attribute__((ext_vector_type(4)));
constexpr int BM = 256, BK = 64, HALF = 128, HTB = HALF * BK * 2  , STAGE_BYTES = 8 * HTB, NXCD = 8,
#ifdef MK_WGM
    WGM = MK_WGM;
#else
    WGM = 8;
#endif

__host__ __device__ __forceinline__ int lds_byte(int r, int c) { const int st = (r >> 4) * 2 + (c >> 5), rr = r & 15, cc = c & 31, ob = rr * 64 + cc * 2; return st * 1024 + (ob ^ (((ob >> 9) & 1) << 5)); }
__host__ __device__ __forceinline__ void stage_rc(int b, int& R, int& C) { const int st = b / 1024, sb = b % 1024, swz = sb ^ (((sb >> 9) & 1) << 5); R = (st >> 1) * 16 + swz / 64; C = (st & 1) * 32 + (swz % 64) / 2; }
__host__ __device__ __forceinline__ int perm32(int rho) { const int n = rho >> 4, i = rho & 15; return 8 * (i >> 2) + 4 * n + (i & 3); }

struct Unit { int pm, pn; };
struct Gemm { const bf16_t* A; const bf16_t* Bt; int M, N, K; };

struct StaticOrder {
    int nM, nN, nwg, G, c;
    __host__ __device__ void init(int M, int N, int G_, int c_) { nM = M / BM; nN = N / BM; nwg = nM * nN; G = G_; c = c_; }
    __host__ __device__ bool next(int i, Unit& u) const {
        const long L = (long)i * G + c; if (L >= nwg) return false;
        int wgid = (int)L; { const int q = nwg / NXCD, r = nwg % NXCD, xcd = wgid % NXCD, off = wgid / NXCD; wgid = (xcd < r ? xcd * (q + 1) : r * (q + 1) + (xcd - r) * q) + off; }
        const int nig = WGM * nN, gid = wgid / nig, fm = gid * WGM, gsz = (nM - fm) < WGM ? (nM - fm) : WGM;
        u.pm = fm + ((wgid % nig) % gsz); u.pn = (wgid % nig) / gsz; return true;
    }
    __device__ __forceinline__ void a_ready(const Unit&) const {}
    __device__ __forceinline__ void done(const Unit&) const {}
};

__device__ __forceinline__ unsigned cvt_pk_bf16(float lo, float hi) { unsigned r; asm volatile("v_cvt_pk_bf16_f32 %0, %1, %2" : "=v"(r) : "v"(lo), "v"(hi)); return r; }
typedef float f32x2 __attribute__((ext_vector_type(2)));

typedef unsigned u32x2 __attribute__((ext_vector_type(2)));
__device__ __forceinline__ int pg8_lane() { int l; asm volatile("v_mbcnt_lo_u32_b32 %0, -1, 0\n\tv_mbcnt_hi_u32_b32 %0, -1, %0" : "=v"(l)); return l; }
typedef float f32x2_t __attribute__((ext_vector_type(2))); typedef __bf16 bf16x2_t __attribute__((ext_vector_type(2)));
__device__ __forceinline__ unsigned cvt2(float lo, float hi) { f32x2_t v = {lo, hi}; bf16x2_t b = __builtin_convertvector(v, bf16x2_t); return __builtin_bit_cast(unsigned, b); }
__device__ __forceinline__ u32x4 pack8(f32x4 a, f32x4 b) { u32x4 w; w.x = cvt2(a[0], a[1]); w.y = cvt2(a[2], a[3]); w.z = cvt2(b[0], b[1]); w.w = cvt2(b[2], b[3]); return w; }

constexpr int RC_MAXP = 15, RC_BYTES = 64 + RC_MAXP * 1024;
__device__ __forceinline__ float rs_from_partials(const float* ssp, int row) {
    const f32x4 a = *(const f32x4*)(ssp + (size_t)row * 16), b = *(const f32x4*)(ssp + (size_t)row * 16 + 4), c = *(const f32x4*)(ssp + (size_t)row * 16 + 8), d = *(const f32x4*)(ssp + (size_t)row * 16 + 12);
    const float s = ((a[0] + a[1]) + (a[2] + a[3])) + ((b[0] + b[1]) + (b[2] + b[3])) + ((c[0] + c[1]) + (c[2] + c[3])) + ((d[0] + d[1]) + (d[2] + d[3]));
    return __builtin_amdgcn_rsqf(s * (1.0f / 1024.0f) + 1e-5f);
}
template <class Sched>
__device__ __forceinline__ void rowcache_fill(PG8_LAS unsigned char* aux, const Sched& S, const float* src, int np, int wid) {
    PG8_LAS int* hdr = (PG8_LAS int*)aux; PG8_LAS float* val = (PG8_LAS float*)(aux + 64);
    const int lane = pg8_lane(), tid = wid * 64 + lane;
    asm volatile("s_waitcnt lgkmcnt(0)" ::: "memory"); __builtin_amdgcn_s_barrier(); asm volatile("" ::: "memory");
    if (wid == 0) {
        Unit u; const bool has = S.next(lane, u); const int pm = has ? u.pm : -1;
        PG8_LAS int* mark = (PG8_LAS int*)val;
        if (has) mark[pm & 1023] = 64;
        asm volatile("s_waitcnt lgkmcnt(0)" ::: "memory");
        if (has) (void)__hip_atomic_fetch_min(&mark[pm & 1023], lane, __ATOMIC_RELAXED, __HIP_MEMORY_SCOPE_WORKGROUP);
        asm volatile("s_waitcnt lgkmcnt(0)" ::: "memory");
        const bool first = has && mark[pm & 1023] == lane;
        const unsigned long long mask = __ballot(first);
        const int pos = __builtin_popcountll(mask & ((1ull << lane) - 1ull));
        if (first && pos < RC_MAXP) hdr[1 + pos] = pm;
        if (lane == 0) { const int n = __builtin_popcountll(mask); hdr[0] = n < RC_MAXP ? n : RC_MAXP; }
    }
    asm volatile("s_waitcnt lgkmcnt(0)" ::: "memory"); __builtin_amdgcn_s_barrier(); asm volatile("" ::: "memory");
    const int n = hdr[0];
    for (int s = (tid >> 8); s < n; s += 2) { const int row = hdr[1 + s] * BM + (tid & 255);
        val[s * 256 + (tid & 255)] = (np == 16) ? rs_from_partials(src, row) : src[row]; }
    asm volatile("s_waitcnt vmcnt(0) lgkmcnt(0)" ::: "memory"); __builtin_amdgcn_s_barrier(); asm volatile("" ::: "memory");
}
__device__ __forceinline__ void rowcache_get8(const PG8_LAS unsigned char* aux, const float* src, int np, int pm, int rr0, float (&v)[2][4]) {
    const PG8_LAS int* hdr = (const PG8_LAS int*)aux; const PG8_LAS float* val = (const PG8_LAS float*)(aux + 64);
    const int n = hdr[0]; int slot = -1;
#pragma unroll
    for (int k = 0; k < RC_MAXP; ++k) slot = (k < n && hdr[1 + k] == pm) ? k : slot;
    slot = __builtin_amdgcn_readfirstlane(slot);
    if (slot >= 0) {
#pragma unroll
        for (int ai = 0; ai < 2; ++ai)
#pragma unroll
            for (int m = 0; m < 4; ++m) v[ai][m] = val[slot * 256 + rr0 + ai * HALF + m * 16];
    } else {
#pragma unroll
        for (int ai = 0; ai < 2; ++ai)
#pragma unroll
            for (int m = 0; m < 4; ++m) { const int row = pm * BM + rr0 + ai * HALF + m * 16; v[ai][m] = (np == 16) ? rs_from_partials(src, row) : src[row]; }
    }
}
struct EpiGlaIn {
    static constexpr bool PERM = true, AFTER_DRAIN = false;
    bf16_t *Q0, *K0, *V0, *R0; float* LR; const float* rs0; const PG8_LAS unsigned char* aux;
    __device__ __forceinline__ void operator()(const f32x4 (&acc)[2][2][4][2], const Unit& u, int wr, int wc, int fr, int fq) const {
        const int pn = u.pn; const int row0 = u.pm * BM + wr * 64 + fr; const int cw = wc * 32 + 8 * fq;
        float rs[2][4]; rowcache_get8(aux, rs0, 1, u.pm, wr * 64 + fr, rs);
        if (pn < 12) {
            bf16_t* base; int ld, c0; float sc = 1.f;
            if (pn < 2) { base = Q0; ld = 512; c0 = pn * 256; sc = 0.08838834764831845f; }
            else if (pn < 4) { base = K0; ld = 512; c0 = (pn - 2) * 256; }
            else if (pn < 8) { base = V0; ld = 1024; c0 = (pn - 4) * 256; }
            else { base = R0; ld = 1024; c0 = (pn - 8) * 256; }
#pragma unroll
            for (int ai = 0; ai < 2; ++ai)
#pragma unroll
                for (int m = 0; m < 4; ++m) { bf16_t* rowp = base + (size_t)(row0 + ai * HALF + m * 16) * ld + c0 + cw;
#pragma unroll
                    for (int bj = 0; bj < 2; ++bj) *(u32x4*)(rowp + bj * HALF) = pack8(acc[ai][bj][m][0] * (sc * rs[ai][m]), acc[ai][bj][m][1] * (sc * rs[ai][m])); }
        } else if (wc == 0) {
#pragma unroll
            for (int ai = 0; ai < 2; ++ai)
#pragma unroll
                for (int m = 0; m < 4; ++m) { float* p = LR + (size_t)(row0 + ai * HALF + m * 16) * 32 + 8 * fq;
                    *(f32x4*)p = acc[ai][0][m][0] * rs[ai][m]; *(f32x4*)(p + 4) = acc[ai][0][m][1] * rs[ai][m]; }
        }
    }
};
struct EpiResBf16 {
    static constexpr bool PERM = true, AFTER_DRAIN = false;
    const bf16_t* base; bf16_t* out; const float* bias; float* ssp; float accs;
    __device__ __forceinline__ void operator()(const f32x4 (&acc)[2][2][4][2], const Unit& u, int wr, int wc, int fr, int fq) const {
        const int row0 = u.pm * BM + wr * 64 + fr; const int col0 = u.pn * BM + wc * 32 + 8 * fq;
        f32x4 bv[2][2];
#pragma unroll
        for (int bj = 0; bj < 2; ++bj)
#pragma unroll
            for (int n = 0; n < 2; ++n) bv[bj][n] = bias ? *(const f32x4*)(bias + col0 + bj * HALF + 4 * n) : (f32x4){0.f, 0.f, 0.f, 0.f};
#pragma unroll
        for (int ai = 0; ai < 2; ++ai) {
            u32x4 bbv[4][2];
#pragma unroll
            for (int m = 0; m < 4; ++m)
#pragma unroll
                for (int bj = 0; bj < 2; ++bj) bbv[m][bj] = *(const u32x4*)(base + (size_t)(row0 + ai * HALF + m * 16) * 1024 + col0 + bj * HALF);
#pragma unroll
            for (int m = 0; m < 4; ++m) { const int row = row0 + ai * HALF + m * 16; const size_t off = (size_t)row * 1024 + col0; float s = 0.f;
#pragma unroll
                for (int bj = 0; bj < 2; ++bj) { const u32x4 bb = bbv[m][bj]; f32x4 v0, v1;
#pragma unroll
                    for (int j = 0; j < 2; ++j) { v0[2 * j] = __uint_as_float(bb[j] << 16); v0[2 * j + 1] = __uint_as_float(bb[j] & 0xffff0000u); v1[2 * j] = __uint_as_float(bb[2 + j] << 16); v1[2 * j + 1] = __uint_as_float(bb[2 + j] & 0xffff0000u); }
                    v0 = v0 + acc[ai][bj][m][0] * accs + bv[bj][0]; v1 = v1 + acc[ai][bj][m][1] * accs + bv[bj][1];
                    s += (v0[0] * v0[0] + v0[1] * v0[1]) + (v0[2] * v0[2] + v0[3] * v0[3]) + (v1[0] * v1[0] + v1[1] * v1[1]) + (v1[2] * v1[2] + v1[3] * v1[3]);
                    *(u32x4*)(out + off + bj * HALF) = pack8(v0, v1); }
                s += __shfl_xor(s, 16); s += __shfl_xor(s, 32);
                if (fq == 0) ssp[(size_t)row * 16 + 4 * u.pn + wc] = s; }
        }
    }
};
__device__ __forceinline__ float silu_f(float g) { return g * __builtin_amdgcn_rcpf(1.0f + __builtin_amdgcn_exp2f(-1.4426950408889634f * g)); }
__device__ __forceinline__ unsigned pk4_fp8(float a, float b, float c, float d) {
    a = __builtin_amdgcn_fmed3f(a, -448.f, 448.f); b = __builtin_amdgcn_fmed3f(b, -448.f, 448.f); c = __builtin_amdgcn_fmed3f(c, -448.f, 448.f); d = __builtin_amdgcn_fmed3f(d, -448.f, 448.f);
    unsigned r = 0u; r = __builtin_amdgcn_cvt_pk_fp8_f32(a, b, r, false); r = __builtin_amdgcn_cvt_pk_fp8_f32(c, d, r, true); return r;
}
struct EpiSwiglu {
    static constexpr bool PERM = true, AFTER_DRAIN = false;
    bf16_t* O; int ldo; int ntn; const float* ssp; const PG8_LAS unsigned char* aux; float f8scale;
    __device__ __forceinline__ void operator()(const f32x4 (&acc)[2][2][4][2], const Unit& u, int wr, int wc, int fr, int fq) const {
        const int row0 = u.pm * BM + wr * 64 + fr; const int col0 = (u.pn % ntn) * HALF + wc * 32 + 8 * fq;
        float rsv[2][4]; rowcache_get8(aux, ssp, 16, u.pm, wr * 64 + fr, rsv);
#pragma unroll
        for (int ai = 0; ai < 2; ++ai)
#pragma unroll
            for (int m = 0; m < 4; ++m) { f32x4 v0, v1; const float rs = rsv[ai][m];
                { const float c0 = -1.4426950408889634f * rs, c1 = rs * rs * (f8scale > 0.f ? f8scale : 1.0f); const f32x4 g0 = acc[ai][0][m][0], g1 = acc[ai][0][m][1]; f32x4 t0 = g0 * c0, t1 = g1 * c0;
#pragma unroll
                  for (int j = 0; j < 4; ++j) { t0[j] = __builtin_amdgcn_rcpf(1.0f + __builtin_amdgcn_exp2f(t0[j])); t1[j] = __builtin_amdgcn_rcpf(1.0f + __builtin_amdgcn_exp2f(t1[j])); }
                  v0 = (g0 * acc[ai][1][m][0]) * (t0 * c1); v1 = (g1 * acc[ai][1][m][1]) * (t1 * c1); }
                if (f8scale > 0.f) { *(u32x2*)((unsigned char*)O + (size_t)(row0 + ai * HALF + m * 16) * ldo + col0) = (u32x2){pk4_fp8(v0[0], v0[1], v0[2], v0[3]), pk4_fp8(v1[0], v1[1], v1[2], v1[3])}; }
                else *(u32x4*)(O + (size_t)(row0 + ai * HALF + m * 16) * ldo + col0) = pack8(v0, v1); }
    }
};
struct EpiSwiglu8 {
    static constexpr bool PERM = true, AFTER_DRAIN = false;
    static constexpr int F8S0 = 0x75757575, F8S1 = 0x78787878;
    unsigned char* O; int ldo; int ntn; float inv, oscale;
    __device__ __forceinline__ void operator()(const f32x4 (&acc)[2][2][4][2], const Unit& u, int wr, int wc, int fr, int fq) const {
        const int row0 = u.pm * BM + wr * 64 + fr; const int col0 = (u.pn % ntn) * HALF + wc * 32 + 8 * fq;
#pragma unroll
        for (int ai = 0; ai < 2; ++ai)
#pragma unroll
            for (int m = 0; m < 4; ++m) { f32x4 v0, v1;
                { const f32x4 g0 = acc[ai][0][m][0], g1 = acc[ai][0][m][1]; f32x4 t0, t1;
#pragma unroll
                  for (int j = 0; j < 4; ++j) { t0[j] = __builtin_amdgcn_rcpf(1.0f + __builtin_amdgcn_exp2f(-g0[j])); t1[j] = __builtin_amdgcn_rcpf(1.0f + __builtin_amdgcn_exp2f(-g1[j])); }
                  v0 = (g0 * acc[ai][1][m][0]) * t0; v1 = (g1 * acc[ai][1][m][1]) * t1; }
                *(u32x2*)(O + (size_t)(row0 + ai * HALF + m * 16) * ldo + col0) = (u32x2){pk4_fp8(v0[0], v0[1], v0[2], v0[3]), pk4_fp8(v1[0], v1[1], v1[2], v1[3])}; }
    }
};
struct EpiMoeDown {
    static constexpr bool PERM = true, AFTER_DRAIN = false;
    static constexpr int F8S0 = 0x76767676, F8S1 = 0x76767676;
    bf16_t* Y; int row_base;
    __device__ __forceinline__ void operator()(const f32x4 (&acc)[2][2][4][2], const Unit& u, int wr, int wc, int fr, int fq) const {
        const int row0 = row_base + u.pm * BM + wr * 64 + fr; const int col0 = (u.pn & 3) * BM + wc * 32 + 8 * fq;
#pragma unroll
        for (int ai = 0; ai < 2; ++ai)
#pragma unroll
            for (int m = 0; m < 4; ++m) { const int row = row0 + ai * HALF + m * 16; bf16_t* rowp = Y + (size_t)row * 1024 + col0;
#pragma unroll
                for (int bj = 0; bj < 2; ++bj) *(u32x4*)(rowp + bj * HALF) = pack8(acc[ai][bj][m][0], acc[ai][bj][m][1]); }
    }
};
struct EpiQkv {
    static constexpr bool PERM = true, AFTER_DRAIN = false;
    bf16_t *Q1, *K1, *V1; const float* bias; const float* ssp; const PG8_LAS unsigned char* aux;
    __device__ __forceinline__ void operator()(const f32x4 (&acc)[2][2][4][2], const Unit& u, int wr, int wc, int fr, int fq) const {
        const int pn = u.pn; const int row0 = u.pm * BM + wr * 64 + fr; const int cw = wc * 32 + 8 * fq;
        bf16_t* base; int ld, c0; float sc = 1.f;
        if (pn < 4) { base = Q1; ld = 1024; c0 = pn * 256; sc = 0.125f * 1.4426950408889634f; }
        else if (pn == 4) { base = K1; ld = 256; c0 = 0; }
        else { base = V1; ld = 256; c0 = 0; }
        f32x4 bv[2][2];
#pragma unroll
        for (int bj = 0; bj < 2; ++bj)
#pragma unroll
            for (int n = 0; n < 2; ++n) bv[bj][n] = *(const f32x4*)(bias + pn * 256 + bj * HALF + cw + 4 * n);
        float rsv[2][4]; rowcache_get8(aux, ssp, 16, u.pm, wr * 64 + fr, rsv);
#pragma unroll
        for (int ai = 0; ai < 2; ++ai)
#pragma unroll
            for (int m = 0; m < 4; ++m) { bf16_t* rowp = base + (size_t)(row0 + ai * HALF + m * 16) * ld + c0 + cw; const float rs = rsv[ai][m];
#pragma unroll
                for (int bj = 0; bj < 2; ++bj) *(u32x4*)(rowp + bj * HALF) = pack8((acc[ai][bj][m][0] * rs + bv[bj][0]) * sc, (acc[ai][bj][m][1] * rs + bv[bj][1]) * sc); }
    }
};
struct MoeOrder {
    int nM, nN, nwg, G, c, rev; const int* meta;
    __device__ __forceinline__ void init(const int* meta_, int nN_, int G_, int c_, int rev_ = 0) { meta = meta_; nM = meta_[8]; nN = nN_; nwg = nM * nN; G = G_; c = c_; rev = rev_; }
    __device__ __forceinline__ bool next(int i, Unit& u) const {
        const long L = (long)i * G + c; if (L >= nwg) return false;
        int wgid = (int)L; { const int q = nwg / NXCD, r = nwg % NXCD, xcd = wgid % NXCD, off = wgid / NXCD; wgid = (xcd < r ? xcd * (q + 1) : r * (q + 1) + (xcd - r) * q) + off; }
        const int nig = WGM * nN, gid = wgid / nig, fm = gid * WGM, gsz = (nM - fm) < WGM ? (nM - fm) : WGM;
        const int pm0 = fm + ((wgid % nig) % gsz), pn = (wgid % nig) / gsz; const int pm = rev ? nM - 1 - pm0 : pm0;
        int e = 0;
#pragma unroll
        for (int k = 1; k < 8; ++k) e += (pm >= meta[k]) ? 1 : 0;
        u.pm = pm; u.pn = e * nN + pn; return true;
    }
    __device__ __forceinline__ void a_ready(const Unit&) const {}
    __device__ __forceinline__ void done(const Unit&) const {}
};

constexpr int UL_MAX = 128;
template <class Sched> struct ListOrder {
    const PG8_LAS int* list; int n; Sched S;
    __device__ __forceinline__ bool next(int i, Unit& u) const {
        if (i >= UL_MAX) return S.next(i, u);
        if (i >= n) return false;
        const int a = list[2 * i], b = list[2 * i + 1]; u.pm = __builtin_amdgcn_readfirstlane(a); u.pn = __builtin_amdgcn_readfirstlane(b); return true;
    }
    __device__ __forceinline__ void a_ready(const Unit&) const {}
    __device__ __forceinline__ void done(const Unit&) const {}
};
template <class Sched> __device__ __forceinline__ ListOrder<Sched> unitlist_fill(PG8_LAS unsigned char* mem, const Sched& S, int wid) {
    PG8_LAS int* list = (PG8_LAS int*)mem; PG8_LAS int* cnt = list + 2 * UL_MAX;
    asm volatile("s_waitcnt lgkmcnt(0)" ::: "memory"); __builtin_amdgcn_s_barrier(); asm volatile("" ::: "memory");
    if (wid < 2) { const int i = wid * 64 + pg8_lane(); Unit u; const bool has = S.next(i, u);
        if (has) { list[2 * i] = u.pm; list[2 * i + 1] = u.pn; }
        const int c = __builtin_popcountll(__ballot(has)); if (pg8_lane() == 0) cnt[wid] = c; }
    asm volatile("s_waitcnt lgkmcnt(0)" ::: "memory"); __builtin_amdgcn_s_barrier(); asm volatile("" ::: "memory");
    ListOrder<Sched> L; L.list = list; L.n = __builtin_amdgcn_readfirstlane(cnt[0] + cnt[1]); L.S = S; return L;
}
typedef int v4i_t __attribute__((ext_vector_type(4))); typedef int v8i_t __attribute__((ext_vector_type(8)));
__device__ __forceinline__ v8i_t cat32(bf16x8 lo, bf16x8 hi) { const v4i_t a = __builtin_bit_cast(v4i_t, lo), b = __builtin_bit_cast(v4i_t, hi); return __builtin_shufflevector(a, b, 0, 1, 2, 3, 4, 5, 6, 7); }
template <class E, class = void> struct pg8_f8s { static constexpr int s0 = 0x7f7f7f7f, s1 = 0x7f7f7f7f; };
template <class E> struct pg8_f8s<E, decltype((void)E::F8S0)> { static constexpr int s0 = E::F8S0, s1 = E::F8S1; };
template <class Epi, class Sched, bool ALIGN_EPI = false, bool SP2 = false, bool FP8 = false>
__device__ __forceinline__ void gemm_phase(PG8_LAS unsigned char* lds, const Gemm g, const Sched& S, const Epi& E, const int wid  ) {
    const int lane = pg8_lane(), tid = wid * 64 + lane, wr = wid >> 2, wc = wid & 3, fr = lane & 15, fq = lane >> 4;
    const int K = g.K, nt = K / BK;
    unsigned voffA[2], voffB[2];
#pragma unroll
    for (int i = 0; i < 2; ++i) { int R, C; stage_rc(tid * 16 + i * 8192, R, C); const int Rb = Epi::PERM ? ((R & ~31) + perm32(R & 31)) : R;
        voffA[i] = (unsigned)(R * K + C) * 2u; voffB[i] = (unsigned)(Rb * K + C) * 2u; }
    const __amdgpu_buffer_rsrc_t rsA = __builtin_amdgcn_make_buffer_rsrc((void*)g.A, 0, 0x7fffffff, 0x00020000), rsB = __builtin_amdgcn_make_buffer_rsrc((void*)g.Bt, 0, 0x7fffffff, 0x00020000);
    const size_t kstep = (size_t)(BK * 2);
    const size_t hstep = (size_t)HALF * K * 2;
    const size_t tstep = 2 * hstep;
    const unsigned ldsw = (unsigned)wid * 1024u;
    const int aoff = lds_byte(wr * 64 + fr, fq * 8), boff = lds_byte(wc * 32 + fr, fq * 8);
#define PG8_SA(b, h) (((b) * 2 + (h)) * HTB)
#define PG8_SB(b, h) ((4 + (b) * 2 + (h)) * HTB)
#define PG8_RS_voffA rsA
#define PG8_RS_voffB rsB
#define PG8_BASE_voffA ((const char*)g.A)
#define PG8_BASE_voffB ((const char*)g.Bt)
#define PG8_STAGE(bufoff, gbase, voff) do { const unsigned so_ = (unsigned)((const char*)(gbase) - PG8_BASE_##voff); _Pragma("unroll") for (int _i = 0; _i < 2; ++_i) \
        __builtin_amdgcn_raw_ptr_buffer_load_lds(PG8_RS_##voff, (PG8_LAS unsigned*)(lds + (bufoff) + ldsw + _i * 8192), 16, (int)(voff)[_i], (int)so_, 0, 0); } while (0)
#define PG8_LDA(dst, b, h) do { if constexpr (FP8) { _Pragma("unroll") for (int m = 0; m < 4; ++m) dst##8[m] = cat32(*(const PG8_LAS bf16x8*)(lds + PG8_SA(b, h) + aoff + m * 2048), *(const PG8_LAS bf16x8*)(lds + PG8_SA(b, h) + aoff + m * 2048 + 1024)); } \
        else { _Pragma("unroll") for (int m = 0; m < 4; ++m) _Pragma("unroll") for (int k = 0; k < 2; ++k) dst[m][k] = *(const PG8_LAS bf16x8*)(lds + PG8_SA(b, h) + aoff + m * 2048 + k * 1024); } } while (0)
#define PG8_LDB(dst, b, h) do { if constexpr (FP8) { _Pragma("unroll") for (int n = 0; n < 2; ++n) dst##8[n] = cat32(*(const PG8_LAS bf16x8*)(lds + PG8_SB(b, h) + boff + n * 2048), *(const PG8_LAS bf16x8*)(lds + PG8_SB(b, h) + boff + n * 2048 + 1024)); } \
        else { _Pragma("unroll") for (int n = 0; n < 2; ++n) _Pragma("unroll") for (int k = 0; k < 2; ++k) dst[n][k] = *(const PG8_LAS bf16x8*)(lds + PG8_SB(b, h) + boff + n * 2048 + k * 1024); } } while (0)
#define PG8_MMA(ai, bj, At, Bt) do { __builtin_amdgcn_s_setprio(1); if constexpr (FP8) { _Pragma("unroll") for (int m = 0; m < 4; ++m) _Pragma("unroll") for (int n = 0; n < 2; ++n) \
        acc[ai][bj][m][n] = __builtin_amdgcn_mfma_scale_f32_16x16x128_f8f6f4(Bt##8[n], At##8[m], acc[ai][bj][m][n], 0, 0, 0, ((bj) == 0 ? pg8_f8s<Epi>::s0 : pg8_f8s<Epi>::s1), 0, 0x7f7f7f7f); } else { \
        _Pragma("unroll") for (int m = 0; m < 4; ++m) _Pragma("unroll") for (int n = 0; n < 2; ++n) _Pragma("unroll") for (int k = 0; k < 2; ++k) \
        acc[ai][bj][m][n] = __builtin_amdgcn_mfma_f32_16x16x32_bf16(Bt[n][k], At[m][k], acc[ai][bj][m][n], 0, 0, 0); } __builtin_amdgcn_s_setprio(0); } while (0)
#define PG8_WAIT_V(n) asm volatile("s_waitcnt vmcnt(" #n ")" ::: "memory")
#define PG8_WAIT_L(n) asm volatile("s_waitcnt lgkmcnt(" #n ")" ::: "memory")
#define PG8_BAR __builtin_amdgcn_s_barrier()
#define PG8_SCHED __builtin_amdgcn_sched_barrier(0)
    Unit cur, nxt; int ui = 0;
    if (!S.next(0, cur)) return;
    f32x4 acc[2][2][4][2];
#pragma unroll
    for (int a = 0; a < 2; ++a)
#pragma unroll
        for (int b = 0; b < 2; ++b)
#pragma unroll
            for (int m = 0; m < 4; ++m)
#pragma unroll
                for (int n = 0; n < 2; ++n) acc[a][b][m][n] = (f32x4){0.f, 0.f, 0.f, 0.f};
    bf16x8 At[4][2], B0[2][2], B1[2][2]; v8i_t At8[4], B08[2], B18[2];
    const char* cA = (const char*)g.A + (size_t)cur.pm * tstep; const char* cB = (const char*)g.Bt + (size_t)cur.pn * tstep;
    S.a_ready(cur);
    if constexpr (SP2) {
        PG8_STAGE(PG8_SB(0, 0), cB, voffB); PG8_STAGE(PG8_SB(0, 1), cB + hstep, voffB); PG8_STAGE(PG8_SA(0, 0), cA, voffA); PG8_STAGE(PG8_SA(0, 1), cA + hstep, voffA);
        if (wr == 1) PG8_BAR;
        PG8_WAIT_V(2); PG8_BAR;
        PG8_STAGE(PG8_SB(1, 0), cB + kstep, voffB); PG8_STAGE(PG8_SA(1, 0), cA + kstep, voffA); PG8_STAGE(PG8_SB(1, 1), cB + hstep + kstep, voffB);
        PG8_WAIT_V(6); PG8_BAR;
    } else {
        PG8_STAGE(PG8_SB(0, 0), cB, voffB); PG8_STAGE(PG8_SA(0, 0), cA, voffA); PG8_STAGE(PG8_SB(0, 1), cB + hstep, voffB); PG8_STAGE(PG8_SA(0, 1), cA + hstep, voffA);
        if (wr == 1) PG8_BAR;
        PG8_WAIT_V(4); PG8_BAR;
        PG8_STAGE(PG8_SB(1, 0), cB + kstep, voffB); PG8_STAGE(PG8_SA(1, 0), cA + kstep, voffA); PG8_STAGE(PG8_SB(1, 1), cB + hstep + kstep, voffB);
        PG8_WAIT_V(6); PG8_BAR;
    }
    for (;;) {
        const bool has_next = S.next(ui + 1, nxt);
        const char* nA = has_next ? (const char*)g.A + (size_t)nxt.pm * tstep : cA; const char* nB = has_next ? (const char*)g.Bt + (size_t)nxt.pn * tstep : cB;
#pragma nounroll
        for (int t = 0; t < nt; t += 2) {
            const bool last = (t == nt - 2);
            const char* a1 = cA + (size_t)(t + 1) * kstep;
            const char* a2 = last ? nA : cA + (size_t)(t + 2) * kstep; const char* b2 = last ? nB : cB + (size_t)(t + 2) * kstep;
            const char* a3 = a2 + kstep; const char* b3 = b2 + kstep;
            if (last && has_next) S.a_ready(nxt);
            if constexpr (SP2) {
            PG8_LDB(B0, 0, 0); PG8_LDB(B1, 0, 1); PG8_SCHED; PG8_LDA(At, 0, 0); PG8_STAGE(PG8_SA(1, 1), a1 + hstep, voffA);
            PG8_WAIT_V(8); PG8_WAIT_L(0); PG8_BAR; PG8_MMA(0, 0, At, B0); PG8_MMA(0, 1, At, B1); PG8_BAR; PG8_SCHED;
            PG8_LDA(At, 0, 1); PG8_STAGE(PG8_SB(0, 0), b2, voffB); PG8_STAGE(PG8_SB(0, 1), b2 + hstep, voffB); PG8_STAGE(PG8_SA(0, 0), a2, voffA);
            PG8_WAIT_V(8); PG8_WAIT_L(0); PG8_BAR; PG8_MMA(1, 0, At, B0); PG8_MMA(1, 1, At, B1); PG8_BAR; PG8_SCHED;
            PG8_LDB(B0, 1, 0); PG8_LDB(B1, 1, 1); PG8_SCHED; PG8_LDA(At, 1, 0); PG8_STAGE(PG8_SA(0, 1), a2 + hstep, voffA);
            PG8_WAIT_V(8); PG8_WAIT_L(0); PG8_BAR; PG8_MMA(0, 0, At, B0); PG8_MMA(0, 1, At, B1); PG8_BAR; PG8_SCHED;
            PG8_LDA(At, 1, 1); PG8_STAGE(PG8_SB(1, 0), b3, voffB); PG8_STAGE(PG8_SB(1, 1), b3 + hstep, voffB); PG8_STAGE(PG8_SA(1, 0), a3, voffA);
            PG8_WAIT_V(8); PG8_WAIT_L(0); PG8_BAR; PG8_MMA(1, 0, At, B0); PG8_MMA(1, 1, At, B1); PG8_BAR; PG8_SCHED;
            } else {
            PG8_LDB(B0, 0, 0); PG8_SCHED; PG8_LDA(At, 0, 0); PG8_STAGE(PG8_SA(1, 1), a1 + hstep, voffA);
            PG8_WAIT_L(8); PG8_BAR; PG8_WAIT_L(0); PG8_MMA(0, 0, At, B0); PG8_BAR; PG8_SCHED;
            PG8_LDB(B1, 0, 1); PG8_STAGE(PG8_SB(0, 0), b2, voffB);
            PG8_BAR; PG8_WAIT_L(0); PG8_MMA(0, 1, At, B1); PG8_BAR;
            PG8_LDA(At, 0, 1); PG8_STAGE(PG8_SA(0, 0), a2, voffA);
            PG8_BAR; PG8_WAIT_L(0); PG8_MMA(1, 0, At, B0); PG8_BAR; PG8_SCHED;
            PG8_STAGE(PG8_SB(0, 1), b2 + hstep, voffB);
            PG8_WAIT_V(6); PG8_BAR; PG8_MMA(1, 1, At, B1); PG8_BAR;
            PG8_LDB(B0, 1, 0); PG8_SCHED; PG8_LDA(At, 1, 0); PG8_STAGE(PG8_SA(0, 1), a2 + hstep, voffA);
            PG8_WAIT_L(8); PG8_BAR; PG8_WAIT_L(0); PG8_MMA(0, 0, At, B0); PG8_BAR; PG8_SCHED;
            PG8_LDB(B1, 1, 1); PG8_STAGE(PG8_SB(1, 0), b3, voffB);
            PG8_BAR; PG8_WAIT_L(0); PG8_MMA(0, 1, At, B1); PG8_BAR;
            PG8_LDA(At, 1, 1); PG8_STAGE(PG8_SA(1, 0), a3, voffA);
            PG8_BAR; PG8_WAIT_L(0); PG8_MMA(1, 0, At, B0); PG8_BAR; PG8_SCHED;
            PG8_STAGE(PG8_SB(1, 1), b3 + hstep, voffB);
            PG8_WAIT_V(6); PG8_BAR; PG8_MMA(1, 1, At, B1); PG8_BAR;
            }
        }
        if constexpr (ALIGN_EPI) { if (wr == 0) PG8_BAR; }
        if constexpr (!Epi::AFTER_DRAIN) { const int l2 = pg8_lane(); E(acc, cur, wr, wc, l2 & 15, l2 >> 4); S.done(cur); }
        if (!has_next) break;
#pragma unroll
        for (int a = 0; a < 2; ++a)
#pragma unroll
            for (int b = 0; b < 2; ++b)
#pragma unroll
                for (int m = 0; m < 4; ++m)
#pragma unroll
                    for (int n = 0; n < 2; ++n) acc[a][b][m][n] = (f32x4){0.f, 0.f, 0.f, 0.f};
        cur = nxt; cA = nA; cB = nB; ++ui;
        if constexpr (ALIGN_EPI) { if (wr == 1) PG8_BAR; }
    }
    PG8_WAIT_V(0);
    if constexpr (!ALIGN_EPI) { if (wr == 0) PG8_BAR; }
    PG8_BAR;
    if constexpr (Epi::AFTER_DRAIN) { E.fused(acc, cur, wr, wc, fr, fq, lds, wid, lane); S.done(cur); }
#undef PG8_SA
#undef PG8_SB
#undef PG8_STAGE
#undef PG8_RS_voffA
#undef PG8_RS_voffB
#undef PG8_BASE_voffA
#undef PG8_BASE_voffB
#undef PG8_LDA
#undef PG8_LDB
#undef PG8_MMA
#undef PG8_WAIT_V
#undef PG8_WAIT_L
#undef PG8_BAR
#undef PG8_SCHED
}
}

constexpr int NWAVES = 8;
constexpr int NTOK = 65536, SEQ = 8192, DM = 1024, DFF = 2816;
constexpr float NORM_EPS = 1e-5f;
constexpr float LOG2E = 1.4426950408889634f;
#ifndef MK_ONE_LAUNCH
#define MK_ONE_LAUNCH 1
#endif
constexpr int NPHASE = 16;

constexpr size_t MiB = 1u << 20;
constexpr size_t WS_CTL = 0, CTL_ZERO_BYTES = 1 * MiB;
constexpr size_t WS_W_GLAIN = 1 * MiB, WS_W_GLAOUT = 8 * MiB, WS_W_QKV = 10 * MiB, WS_W_SWAOUT = 13 * MiB, WS_W_DGU = 15 * MiB, WS_W_DDN = 26 * MiB, WS_W_MGU = 32 * MiB, WS_W_MDN = 120 * MiB;
constexpr size_t WS_HB = 164 * MiB;
constexpr size_t WS_XN = 612 * MiB;
constexpr size_t OUT_XB = 0, OUT_OB = 128 * MiB;
constexpr size_t WS_Q0 = 292 * MiB, WS_K0 = 356 * MiB, WS_V0 = 420 * MiB, WS_R0 = 548 * MiB, WS_LR = 676 * MiB;
constexpr size_t WS_QE = 684 * MiB;
constexpr size_t WS_CC = 940 * MiB;
constexpr size_t WS_OF = WS_Q0, WS_G = WS_V0;
constexpr size_t WS_ACT0 = 292 * MiB;
constexpr size_t WS_Q1 = 292 * MiB, WS_K1 = 420 * MiB, WS_V1 = 452 * MiB, WS_O1 = 484 * MiB;
constexpr size_t WS_XS = 292 * MiB;
constexpr size_t WS_ACT1 = 552 * MiB;
constexpr float XSCALE = 16.f, WSCALE = 64.f, ASCALE = 8.f;
constexpr size_t WS_ROUT = 952 * MiB;
constexpr size_t WS_SEL = WS_ROUT, WS_WSEL = WS_ROUT + 1 * MiB, WS_POSTOK = WS_ROUT + 2 * MiB, WS_ROWW = WS_ROUT + 3 * MiB, WS_WCNT = WS_ROUT + 4 * MiB, WS_META = WS_ROUT + 5 * MiB;
constexpr size_t WS_SSP1 = 960 * MiB, WS_SSP2 = 964 * MiB, WS_SSP3 = 968 * MiB, WS_SS0 = 972 * MiB;
constexpr size_t WS_END = 1024 * MiB;
static_assert(WS_W_MDN + (size_t)8 * 1024 * 2816 * 2 <= WS_HB && WS_CC + (size_t)2 * 8 * 128 * 1536 * 4 <= WS_ROUT && WS_ACT0 + (size_t)NTOK * DFF * 2 <= WS_QE + 4 * 64 * MiB, "ws map");
static_assert(WS_ACT1 + (size_t)133120 * DFF <= WS_ROUT && WS_XS + (size_t)133120 * 1024 * 2 <= WS_ACT1, "ws map 2");
constexpr int CW_TMO = 0, CW_BAR = 4096;

constexpr int RING_OFF = 0, RING_BYTES = 131072;
constexpr int LDS_BYTES = 163840;
constexpr int LDSCTL_OFF = LDS_BYTES - 1024, MISC_OFF = LDSCTL_OFF + 320;
constexpr int UL_OFF = RING_BYTES + 15616;
constexpr int AUX_OFF = RING_BYTES;

#define GAS __attribute__((address_space(1)))
#define LAS __attribute__((address_space(3)))
typedef unsigned short bf16;
typedef unsigned v4u __attribute__((ext_vector_type(4)));
typedef float f32x4 __attribute__((ext_vector_type(4)));
typedef short bf16x8 __attribute__((ext_vector_type(8)));
typedef GAS unsigned gu32;
typedef GAS unsigned long long gu64;
#define RLX_AGENT __ATOMIC_RELAXED, __HIP_MEMORY_SCOPE_AGENT
#define LDS_WAIT() asm volatile("s_waitcnt lgkmcnt(0)" ::: "memory")
#define VM_WAIT() asm volatile("s_waitcnt vmcnt(0)" ::: "memory")
__device__ __forceinline__ unsigned long long rt() { return __builtin_amdgcn_s_memrealtime(); }
__device__ __forceinline__ unsigned f2bf(float f) { unsigned u = __builtin_bit_cast(unsigned, f); return (u + 0x7fffu + ((u >> 16) & 1u)) >> 16; }
__device__ __forceinline__ unsigned pk2(float lo, float hi) { return f2bf(lo) | (f2bf(hi) << 16); }

#define XB_TMO      128
#define XB_XCNT(j)  (256  + 64 * (j))
#define XB_XSUB(j)  (1280 + 64 * (j))
#define XB_XGEN(j)  (2304 + 64 * (j))
#define XB_TOP      3328
#define XB_TOPGEN   3392
#define XCD_BAR_WORDS 3456
#define XB_SPIN_CAP (1u << 18)

__device__ __forceinline__ unsigned xb_ld(unsigned* p)              { return __hip_atomic_load(p, __ATOMIC_RELAXED, __HIP_MEMORY_SCOPE_AGENT); }
__device__ __forceinline__ unsigned xb_add(unsigned* p, unsigned v) { return __hip_atomic_fetch_add(p, v, __ATOMIC_RELAXED, __HIP_MEMORY_SCOPE_AGENT); }
__device__ __forceinline__ unsigned xb_xcc_id() { return (unsigned)__builtin_amdgcn_s_getreg((3 << 11) | 20) & 0xFu; }
#define XB_SPIN(cond, bar) do { unsigned _sp = 0; while (cond) { __builtin_amdgcn_s_sleep(1); \
    if ((++_sp & 255u) == 0u) { if (xb_ld(&(bar)[XB_TMO])) break; if (_sp > XB_SPIN_CAP) { atomicAdd(&(bar)[XB_TMO], 1u); break; } } } } while (0)

struct XcdBarrier {
    unsigned* bar; unsigned x;
    volatile LAS unsigned* st;
    unsigned t0;
};

__device__ __forceinline__ XcdBarrier xcd_barrier_post(unsigned* bar, volatile LAS unsigned* st, unsigned t0) {
    XcdBarrier b; b.bar = bar; b.x = xb_xcc_id(); b.st = st; b.t0 = t0;
    if (t0) (void)xb_add(&bar[XB_XCNT(b.x)], 1u);
    return b;
}
__device__ __forceinline__ void xcd_barrier_complete(unsigned* bar, unsigned x, unsigned& nloc, unsigned& nx) {
    const unsigned G = gridDim.x * gridDim.y * gridDim.z;
    unsigned sum, cnt, mine, sp = 0u;
    for (;;) {
        sum = 0u; cnt = 0u; mine = 0u;
#pragma unroll
        for (unsigned j = 0; j < 16; ++j) { const unsigned c = xb_ld(&bar[XB_XCNT(j)]); sum += c; cnt += (c > 0u) ? 1u : 0u; mine = (j == x) ? c : mine; }
        if (sum == G) break;
        __builtin_amdgcn_s_sleep(1);
        if ((++sp & 255u) == 0u) { if (xb_ld(&bar[XB_TMO])) break; if (sp > XB_SPIN_CAP) { atomicAdd(&bar[XB_TMO], 1u); break; } }
    }
    nloc = mine > 0u ? mine : 1u; nx = cnt > 0u ? cnt : 1u;
}

__device__ __forceinline__ void xcd_barrier(const XcdBarrier& b) {
    asm volatile("s_waitcnt vmcnt(0)" ::: "memory");
    __syncthreads();
    if (b.t0) {
        unsigned* bar = b.bar;
        __builtin_amdgcn_s_waitcnt(0);
        unsigned nloc = b.st[0], nx = b.st[1];
        if (nloc == 0u) { xcd_barrier_complete(bar, b.x, nloc, nx); b.st[0] = nloc; b.st[1] = nx; }
        const unsigned old = xb_add(&bar[XB_XSUB(b.x)], 1u);
        const unsigned gen = old / nloc;
        if (old + 1u == (gen + 1u) * nloc) {
            __builtin_amdgcn_fence(__ATOMIC_RELEASE, "agent");
            asm volatile("s_waitcnt vmcnt(0)" ::: "memory");
            const unsigned og = xb_add(&bar[XB_TOP], 1u);
            const unsigned tg = og / nx;
            if (og + 1u == (tg + 1u) * nx) xb_add(&bar[XB_TOPGEN], 1u);
            else XB_SPIN(xb_ld(&bar[XB_TOPGEN]) == tg, bar);
            __builtin_amdgcn_fence(__ATOMIC_ACQUIRE, "agent");
            xb_add(&bar[XB_XGEN(b.x)], 1u);
            asm volatile("s_waitcnt vmcnt(0)" ::: "memory");
        } else {
            XB_SPIN(xb_ld(&bar[XB_XGEN(b.x)]) == gen, bar);
            __builtin_amdgcn_fence(__ATOMIC_ACQUIRE, "agent");
            asm volatile("s_waitcnt vmcnt(0)" ::: "memory");
        }
    }
    __syncthreads();
}
typedef unsigned u32x4 __attribute__((ext_vector_type(4)));

typedef unsigned u32x2 __attribute__((ext_vector_type(2)));
typedef short s16x4 __attribute__((ext_vector_type(4)));
struct Frame {
    LAS unsigned char* lds;
    volatile LAS unsigned* MISC;
    int wave;
    int vcu, G;
    float* out; unsigned char* ws;
    const float* const* in;
};
__device__ __forceinline__ int lane_id() { return pg8::pg8_lane(); }
__device__ __forceinline__ float bf_lo(unsigned u) { return __uint_as_float(u << 16); }
__device__ __forceinline__ float bf_hi(unsigned u) { return __uint_as_float(u & 0xffff0000u); }
typedef float f32x2_t __attribute__((ext_vector_type(2))); typedef __bf16 bf16x2_t __attribute__((ext_vector_type(2)));
__device__ __forceinline__ unsigned cvtpk(float lo, float hi) { f32x2_t v = {lo, hi}; bf16x2_t b = __builtin_convertvector(v, bf16x2_t); return __builtin_bit_cast(unsigned, b); }
__device__ __forceinline__ float wave_sum(float v) {
#pragma unroll
    for (int o = 1; o < 64; o <<= 1) v += __shfl_xor(v, o);
    return v;
}
__device__ __forceinline__ int wave_sum_i(int v) {
#pragma unroll
    for (int o = 1; o < 64; o <<= 1) v += __shfl_xor(v, o);
    return v;
}
#define LBAR() do { asm volatile("s_waitcnt lgkmcnt(0)" ::: "memory"); __builtin_amdgcn_s_barrier(); asm volatile("" ::: "memory"); } while (0)
__device__ __forceinline__ f32x4 mfma16(bf16x8 a, bf16x8 b, f32x4 c) { return __builtin_amdgcn_mfma_f32_16x16x32_bf16(a, b, c, 0, 0, 0); }
typedef short v4i16_t __attribute__((ext_vector_type(4)));
__device__ __forceinline__ s16x4 ldtr(const LAS unsigned char* p) { return __builtin_bit_cast(s16x4, __builtin_amdgcn_ds_read_tr16_b64_v4i16((LAS v4i16_t*)p)); }
__device__ __forceinline__ bf16x8 cat8(s16x4 lo, s16x4 hi) { return (bf16x8){lo[0], lo[1], lo[2], lo[3], hi[0], hi[1], hi[2], hi[3]}; }

__device__ __forceinline__ void conv_item(const float* W, int K, int N, bf16* WT, int drow0, int k0, int n0, LAS float* scr, int lane, const float* gain) {
    const float* gp = gain ? gain : W;
    float wv[32], gv[32];
#pragma unroll
    for (int i = 0; i < 32; ++i) { const int kk = 2 * i + (lane >> 5); wv[i] = W[(size_t)(k0 + kk) * N + n0 + (lane & 31)]; gv[i] = gp[k0 + kk]; }
#pragma unroll
    for (int i = 0; i < 32; ++i) { const int kk = 2 * i + (lane >> 5); scr[kk * 33 + (lane & 31)] = wv[i] * (gain ? gv[i] : 1.0f); }
    LDS_WAIT(); asm volatile("" ::: "memory");
    const int c = lane & 7;
#pragma unroll
    for (int j = 0; j < 4; ++j) { const int n = (lane >> 3) + 8 * j; const LAS float* s = scr + (8 * c) * 33 + n;
        v4u o; o.x = pk2(s[0 * 33], s[1 * 33]); o.y = pk2(s[2 * 33], s[3 * 33]); o.z = pk2(s[4 * 33], s[5 * 33]); o.w = pk2(s[6 * 33], s[7 * 33]);
        *(GAS v4u*)(WT + (size_t)(drow0 + n) * K + k0 + 8 * c) = o; }
    LDS_WAIT(); asm volatile("" ::: "memory");
}
__device__ __forceinline__ unsigned pk4f8(float a, float b, float c, float d) { unsigned r = 0u; r = __builtin_amdgcn_cvt_pk_fp8_f32(a, b, r, false); r = __builtin_amdgcn_cvt_pk_fp8_f32(c, d, r, true); return r; }
__device__ __forceinline__ void conv_item8(const float* W, int K, int N, unsigned char* WT, int drow0, int k0, int n0, LAS float* scr, int lane, float scale) {
    float wv[64];
#pragma unroll
    for (int i = 0; i < 64; ++i) wv[i] = W[(size_t)(k0 + 2 * i + (lane >> 5)) * N + n0 + (lane & 31)];
#pragma unroll
    for (int i = 0; i < 64; ++i) scr[(2 * i + (lane >> 5)) * 33 + (lane & 31)] = wv[i] * scale;
    LDS_WAIT(); asm volatile("" ::: "memory");
    const int c = lane & 7;
#pragma unroll
    for (int j = 0; j < 4; ++j) { const int n = (lane >> 3) + 8 * j; const LAS float* s = scr + (16 * c) * 33 + n;
        v4u o; o.x = pk4f8(s[0 * 33], s[1 * 33], s[2 * 33], s[3 * 33]); o.y = pk4f8(s[4 * 33], s[5 * 33], s[6 * 33], s[7 * 33]); o.z = pk4f8(s[8 * 33], s[9 * 33], s[10 * 33], s[11 * 33]); o.w = pk4f8(s[12 * 33], s[13 * 33], s[14 * 33], s[15 * 33]);
        *(GAS v4u*)(WT + (size_t)(drow0 + n) * K + k0 + 16 * c) = o; }
    LDS_WAIT(); asm volatile("" ::: "memory");
}
constexpr int IT_GLAIN = 16 * 97, IT_SQ = 16 * 32, IT_QKV = 16 * 48, IT_FF = 1408, IT_FF8 = 704;
#ifndef MK_DDN_FP8
#define MK_DDN_FP8 1
#endif
constexpr int N_FF16 = MK_DDN_FP8 ? 2 : 3, N_FF8 = MK_DDN_FP8 ? 25 : 24;
constexpr int NITEMS = IT_GLAIN + 2 * IT_SQ + IT_QKV + N_FF16 * IT_FF + N_FF8 * IT_FF8;
__device__ __forceinline__ void p0_weights(Frame& F, const float* gla_in, const float* gla_out, const float* swa_qkv, const float* swa_out, const float* d_gate, const float* d_up, const float* d_down, const float* m_gate, const float* m_up, const float* m_down, const float* g_mix0, const float* g_ffn0, const float* g_mix1) {
    LAS float* scr = (LAS float*)(F.lds + F.wave * 16896);
    const int gw = F.vcu * NWAVES + F.wave, NGW = F.G * NWAVES, lane = lane_id();
    for (int it = gw; it < NITEMS; it += NGW) {
        int r = it; const float* W; int K = 1024, N; bf16* WT; int mode = 0; bool f8 = false, f8m = false; const float* gain = nullptr;
        if (r < IT_GLAIN) { W = gla_in; N = 3104; WT = (bf16*)(F.ws + WS_W_GLAIN); gain = g_mix0; }
        else if ((r -= IT_GLAIN) < IT_SQ) { W = gla_out; N = 1024; WT = (bf16*)(F.ws + WS_W_GLAOUT); }
        else if ((r -= IT_SQ) < IT_QKV) { W = swa_qkv; N = 1536; WT = (bf16*)(F.ws + WS_W_QKV); gain = g_mix1; }
        else if ((r -= IT_QKV) < IT_SQ) { W = swa_out; N = 1024; WT = (bf16*)(F.ws + WS_W_SWAOUT); }
        else { r -= IT_SQ; int j;
            if (r < N_FF16 * IT_FF) { j = r / IT_FF; r -= j * IT_FF; } else { r -= N_FF16 * IT_FF; const int j8 = r / IT_FF8; r -= j8 * IT_FF8; j = N_FF16 + j8; }
            int kind, e; if (j < 3) { kind = j; e = 0; } else { kind = (j - 3) >> 3; e = (j - 3) & 7; }
            const bool moe = j >= 3; f8m = moe;
            f8 = j >= N_FF16;
            if (kind == 2) { W = (moe ? m_down : d_down) + (size_t)e * DFF * 1024; K = DFF; N = 1024; WT = moe ? (bf16*)(F.ws + WS_W_MDN + (size_t)e * 1024 * DFF) : (bf16*)(F.ws + WS_W_DDN); }
            else { W = (kind == 0 ? (moe ? m_gate : d_gate) : (moe ? m_up : d_up)) + (size_t)e * 1024 * DFF; N = DFF; WT = moe ? (bf16*)(F.ws + WS_W_MGU + (size_t)e * 5632 * 1024) : (bf16*)(F.ws + WS_W_DGU); mode = 1 + kind; gain = moe ? nullptr : g_ffn0; }
        }
        const int nsh = 5, nblk = N >> nsh, kb = r / nblk, nb = r - kb * nblk, n0 = nb << nsh;
        const int drow0 = (mode == 0) ? n0 : (((n0 >> 7) << 8) + (n0 & 127) + (mode == 2 ? 128 : 0));
        if (f8) conv_item8(W, K, N, (unsigned char*)WT, drow0, kb * 128, n0, scr, lane, WSCALE * ((mode == 1 && f8m) ? LOG2E : (mode == 2 && f8m) ? 0.6931471805599453f : 1.0f));
        else conv_item(W, K, N, WT, drow0, kb * 64, n0, scr, lane, gain);
    }
}
constexpr int CR_PITCH = 2064;
static_assert(32 * CR_PITCH <= RING_BYTES, "convert_rows LDS");
__device__ __forceinline__ void convert_rows(Frame& F, const float* src, bf16* dst, float* ss, const float* Win, const float* gain, float* LR) {
    const int gw = F.vcu * NWAVES + F.wave, NGW = F.G * NWAVES, lane = lane_id(), r16 = lane & 15, g4 = lane >> 4, tid = F.wave * 64 + lane;
    LAS unsigned char* wl = F.lds;
    LBAR();
#pragma unroll 4
    for (int pi = tid; pi < DM * 8; pi += NWAVES * 64) { const int k = pi >> 3, j = pi & 7; const f32x4 w4 = *(const GAS f32x4*)(Win + (size_t)k * 3104 + 3072 + 4 * j); const float gk = gain[k];
#pragma unroll
        for (int e = 0; e < 4; ++e) *(LAS unsigned short*)(wl + (4 * j + e) * CR_PITCH + k * 2) = (unsigned short)(cvtpk(w4[e] * gk, 0.f) & 0xffffu); }
    LBAR();
    for (int rg = gw; rg < NTOK / 16; rg += NGW) {
        const size_t row = (size_t)rg * 16 + r16;
        const GAS f32x4* xr = (const GAS f32x4*)(src + row * DM + 8 * g4); GAS v4u* orow = (GAS v4u*)(dst + row * DM + 8 * g4);
        f32x4 acc0 = (f32x4){0.f, 0.f, 0.f, 0.f}, acc1 = acc0; float s = 0.f;
#pragma unroll 1
        for (int kb = 0; kb < 32; kb += 8) {
            f32x4 v[8][2];
#pragma unroll
            for (int j = 0; j < 8; ++j) { v[j][0] = xr[(kb + j) * 8]; v[j][1] = xr[(kb + j) * 8 + 1]; }
#pragma unroll
            for (int j = 0; j < 8; ++j) { const int ks = kb + j; const f32x4 a = v[j][0], c = v[j][1];
                s += ((a.x * a.x + a.y * a.y) + (a.z * a.z + a.w * a.w)) + ((c.x * c.x + c.y * c.y) + (c.z * c.z + c.w * c.w));
                const v4u pk = (v4u){cvtpk(a.x, a.y), cvtpk(a.z, a.w), cvtpk(c.x, c.y), cvtpk(c.z, c.w)};
                orow[ks * 4] = pk;
                const bf16x8 af = __builtin_bit_cast(bf16x8, pk);
                const bf16x8 b0 = *(const LAS bf16x8*)(wl + r16 * CR_PITCH + (32 * ks + 8 * g4) * 2), b1 = *(const LAS bf16x8*)(wl + (16 + r16) * CR_PITCH + (32 * ks + 8 * g4) * 2);
                acc0 = mfma16(af, b0, acc0); acc1 = mfma16(af, b1, acc1); }
        }
        s += __shfl_xor(s, 16); s += __shfl_xor(s, 32);
        const float rs = 1.0f / sqrtf(s * (1.f / DM) + NORM_EPS);
        if (g4 == 0) ss[row] = rs;
#pragma unroll
        for (int r = 0; r < 4; ++r) { const float rr = __shfl(rs, 4 * g4 + r); float* lp = LR + ((size_t)rg * 16 + 4 * g4 + r) * 32 + r16; lp[0] = acc0[r] * rr; lp[16] = acc1[r] * rr; }
    }
}

__device__ __forceinline__ float logsig16(float z) { const float e = __expf(-fabsf(z)); return (fminf(z, 0.f) - __logf(1.f + e)) * 0.0625f; }
constexpr int GP_Q = 0, GP_K = 65536, GP_LR = 131072, GP_X0 = GP_LR + 8192, GP_X1 = GP_X0 + 2048;
static_assert(GP_X1 + 4096 <= LDSCTL_OFF, "gla prep LDS");
__device__ __forceinline__ void gla_prep(Frame& F) {
    typedef float f32x2 __attribute__((ext_vector_type(2)));
    LAS unsigned char* L = F.lds;
    LAS float* lrs = (LAS float*)(L + GP_LR);
    LAS f32x2* xch0 = (LAS f32x2*)(L + GP_X0);
    LAS f32x4* xch1 = (LAS f32x4*)(L + GP_X1);
    LAS unsigned* tq = (LAS unsigned*)(L + GP_Q); LAS unsigned* tk = (LAS unsigned*)(L + GP_K);
    const int lane = lane_id(), tid = F.wave * 64 + lane, ph = tid >> 8, cp = tid & 255, col = 2 * cp;
    const bf16* Q0 = (const bf16*)(F.ws + WS_Q0); const bf16* K0 = (const bf16*)(F.ws + WS_K0); const float* LR = (const float*)(F.ws + WS_LR);
    float* CC = (float*)(F.ws + WS_CC);
    f32x2 wgv[16]; f32x2 bgv = (f32x2){0.f, 0.f}; int cur_dir = -1;
#pragma unroll
    for (int r = 0; r < 16; ++r) wgv[r] = (f32x2){0.f, 0.f};
    for (int u = F.vcu; u < 2048; u += F.G) {
        const int b = u >> 8, n = (u >> 1) & 127, dir = u & 1; const size_t row0 = (size_t)b * SEQ + 64 * n;
        bf16* QEd = (bf16*)(F.ws + WS_QE) + (size_t)dir * 2 * NTOK * 512; bf16* KEd = QEd + (size_t)NTOK * 512;
        if (dir != cur_dir) {
            const float* wg = dir ? F.in[6] : F.in[4]; const float* bg = dir ? F.in[7] : F.in[5]; cur_dir = dir;
#pragma unroll
            for (int r = 0; r < 16; ++r) wgv[r] = *(const f32x2*)(wg + r * 512 + col);
            bgv = *(const f32x2*)(bg + col);
            asm volatile("s_waitcnt vmcnt(0)" ::: "memory");
        }
        const f32x4 lrn = *(const f32x4*)(LR + row0 * 32 + tid * 4);
        LBAR();
        *(LAS f32x4*)(lrs + tid * 4) = lrn;
#pragma unroll
        for (int i = 0; i < 8; ++i) {
            __builtin_amdgcn_global_load_lds((const unsigned*)((const char*)(Q0 + row0 * 512) + (i * 8 + F.wave) * 1024 + lane * 16), (LAS unsigned*)(L + GP_Q + (i * 8 + F.wave) * 1024), 16, 0, 0);
            __builtin_amdgcn_global_load_lds((const unsigned*)((const char*)(K0 + row0 * 512) + (i * 8 + F.wave) * 1024 + lane * 16), (LAS unsigned*)(L + GP_K + (i * 8 + F.wave) * 1024), 16, 0, 0); }
        LBAR();
        float bc0[32], bc1[32]; float run0 = 0.f, run1 = 0.f;
#pragma unroll
        for (int i = 0; i < 32; ++i) { const int p = 32 * ph + i; const int tok = dir ? 63 - p : p; const LAS float* lp = lrs + tok * 32 + dir * 16;
            f32x2 z = bgv;
#pragma unroll
            for (int r4 = 0; r4 < 4; ++r4) { const f32x4 l4 = *(const LAS f32x4*)(lp + 4 * r4);
#pragma unroll
                for (int k = 0; k < 4; ++k) z = __builtin_elementwise_fma((f32x2){l4[k], l4[k]}, wgv[4 * r4 + k], z); }
            run0 += logsig16(z.x); run1 += logsig16(z.y); bc0[i] = run0; bc1[i] = run1; }
        if (ph == 0) xch0[cp] = (f32x2){run0, run1};
        LBAR();
        if (ph == 1) { const f32x2 add = xch0[cp];
#pragma unroll
            for (int i = 0; i < 32; ++i) { bc0[i] += add.x; bc1[i] += add.y; }
            xch1[cp] = (f32x4){bc0[31], bc1[31], bc0[31], bc1[31]}; }
        asm volatile("s_waitcnt vmcnt(0)" ::: "memory");
        LBAR();
        const f32x4 rl = xch1[cp]; const float br0 = rl[0], br1 = rl[1], bl0 = rl[2], bl1 = rl[3];
#pragma unroll
        for (int i = 0; i < 32; ++i) { const int p = 32 * ph + i; const int tok = dir ? 63 - p : p;
            const unsigned q2 = tq[tok * 256 + cp], k2 = tk[tok * 256 + cp];
            const float e0 = __expf(bc0[i] - br0), e1 = __expf(bc1[i] - br1), i0 = __builtin_amdgcn_rcpf(e0), i1 = __builtin_amdgcn_rcpf(e1);
            tq[tok * 256 + cp] = cvtpk(bf_lo(q2) * e0, bf_hi(q2) * e1);
            tk[tok * 256 + cp] = cvtpk(bf_lo(k2) * i0, bf_hi(k2) * i1); }
        if (ph == 0) { const int c = dir ? 127 - n : n; float* rec = CC + ((size_t)(dir * 8 + b) * 128 + c) * 512;
            if (c >= 1) *(f32x2*)(rec - 512 + col) = (f32x2){__expf(bl0), __expf(bl1)}; }
        LBAR();
#pragma unroll
        for (int i = 0; i < 8; ++i) { const int off = (i * 512 + tid) * 16;
            *(v4u*)((char*)(QEd + row0 * 512) + off) = *(const LAS v4u*)(L + GP_Q + off); *(v4u*)((char*)(KEd + row0 * 512) + off) = *(const LAS v4u*)(L + GP_K + off); }
    }
}

constexpr int GS_QE = 0, GS_KE = 17408, GS_V = 34816, GS_CC = 44032, GS_BUF = 45568, GS_P = 3 * GS_BUF, GS_PB = 9216;
static_assert(GS_P + 2 * GS_PB <= LDSCTL_OFF, "gla scan LDS");
__device__ __forceinline__ void gla_scan(Frame& F) {
    const int lane = lane_id(), tid = F.wave * 64 + lane, w = F.wave, r16 = lane & 15, g4 = lane >> 4;
    LAS unsigned char* L = F.lds;
    const bf16* V0 = (const bf16*)(F.ws + WS_V0);
    for (int unit = F.vcu; unit < 256; unit += F.G) {
        const int combo = unit >> 2, dvq = unit & 3, dir = combo & 1, h = (combo >> 1) & 3, b = combo >> 3;
        const bf16* QEg = (const bf16*)(F.ws + WS_QE) + (size_t)dir * 2 * NTOK * 512; const bf16* KEg = QEg + (size_t)NTOK * 512;
        const float* CCg = (const float*)(F.ws + WS_CC) + (size_t)(dir * 8 + b) * 128 * 512;
        bf16* Og = dir ? (bf16*)((unsigned char*)F.out + OUT_OB) : (bf16*)(F.ws + WS_OF);
        v4u rqA[4], rkA[4], rvA[2], rcA, rqB[4], rkB[4], rvB[2], rcB;
        const int st = tid & 255, sqrow = st >> 4, sqch = st & 15, svrow = st >> 3, svch = st & 7, sct = st & 31;
        const long tstride = dir ? -64 : 64;
        const bf16* pQ = QEg + ((size_t)b * SEQ + (dir ? 127 * 64 : 0) + sqrow) * 512 + h * 128 + sqch * 8; const bf16* pK = pQ + (size_t)NTOK * 512;
        const bf16* pV = V0 + ((size_t)b * SEQ + (dir ? 127 * 64 : 0) + svrow) * 1024 + h * 256 + dvq * 64 + svch * 8;
        const float* pC = CCg + h * 128 + sct * 4;
#define GS_LOAD(c_, X) do { _Pragma("unroll") for (int k_ = 0; k_ < 4; ++k_) { rq##X[k_] = *(const v4u*)(pQ + k_ * 16 * 512); rk##X[k_] = *(const v4u*)(pK + k_ * 16 * 512); } \
        rv##X[0] = *(const v4u*)pV; rv##X[1] = *(const v4u*)(pV + 32 * 1024); rc##X = *(const v4u*)pC; \
        pQ += tstride * 512; pK += tstride * 512; pV += tstride * 1024; pC += 512; } while (0)
#define GS_STORE(buf_, X) do { LAS unsigned char* B_ = L + (buf_) * GS_BUF; \
        _Pragma("unroll") for (int k_ = 0; k_ < 4; ++k_) { *(LAS v4u*)(B_ + GS_QE + (sqrow + 16 * k_) * 272 + sqch * 16) = rq##X[k_]; *(LAS v4u*)(B_ + GS_KE + (sqrow + 16 * k_) * 272 + sqch * 16) = rk##X[k_]; } \
        *(LAS v4u*)(B_ + GS_V + svrow * 144 + svch * 16) = rv##X[0]; *(LAS v4u*)(B_ + GS_V + (svrow + 32) * 144 + svch * 16) = rv##X[1]; \
        if (st < 32) *(LAS v4u*)(B_ + GS_CC + st * 16) = rc##X; } while (0)
        int sit[3], sjt[3];
        { const int s2 = 2 * (w & 3); const int i0 = (123 >> s2) & 3, i1 = (27 >> s2) & 3, j0 = (48 >> s2) & 3, j1 = (21 >> s2) & 3, j2 = (26 >> s2) & 3;
          sit[0] = dir ? 3 - i0 : i0; sit[1] = dir ? 3 - i1 : i1; sit[2] = sit[1]; sjt[0] = dir ? 3 - j0 : j0; sjt[1] = dir ? 3 - j1 : j1; sjt[2] = dir ? 3 - j2 : j2; }
        bool skeep[4];
#pragma unroll
        for (int r = 0; r < 4; ++r) { const int j_ = 4 * g4 + r; skeep[r] = dir ? (j_ > r16) : (j_ <= r16); }
#define GS_SCORES(tb_, pb_) do { const LAS unsigned char* B_ = L + (tb_) * GS_BUF; LAS unsigned char* P_ = L + GS_P + (pb_) * GS_PB; \
        bf16x8 qf_[2][4], kf_[3][4];                                         \
        _Pragma("unroll") for (int k_ = 0; k_ < 3; ++k_) _Pragma("unroll") for (int ks = 0; ks < 4; ++ks) { \
            if (k_ < 2) qf_[k_][ks] = *(const LAS bf16x8*)(B_ + GS_QE + (16 * sit[k_] + r16) * 272 + ks * 64 + g4 * 16); kf_[k_][ks] = *(const LAS bf16x8*)(B_ + GS_KE + (16 * sjt[k_] + r16) * 272 + ks * 64 + g4 * 16); } \
        __builtin_amdgcn_sched_barrier(0); \
        f32x4 pa_[3]; \
        _Pragma("unroll") for (int k_ = 0; k_ < 3; ++k_) { pa_[k_] = (f32x4){0.f, 0.f, 0.f, 0.f}; _Pragma("unroll") for (int ks = 0; ks < 4; ++ks) pa_[k_] = mfma16(kf_[k_][ks], qf_[k_ < 2 ? k_ : 1][ks], pa_[k_]); } \
        _Pragma("unroll") for (int k_ = 0; k_ < 3; ++k_) { const bool diag_ = sit[k_] == sjt[k_]; \
            _Pragma("unroll") for (int r = 0; r < 4; ++r) pa_[k_][r] = (diag_ && !skeep[r]) ? 0.f : pa_[k_][r]; \
            *(LAS u32x2*)(P_ + (16 * sit[k_] + r16) * 144 + (16 * sjt[k_] + 4 * g4) * 2) = (u32x2){cvtpk(pa_[k_][0], pa_[k_][1]), cvtpk(pa_[k_][2], pa_[k_][3])}; } } while (0)
        LBAR();
#define GS_STEP_SCORE(cc, XS, XL) do { const int c = (cc); const int tbn = (c + 1) % 3, tbw = (c + 2) % 3, pb = c & 1; \
            GS_LOAD(c + 3, XL); if (c + 1 < 128) GS_SCORES(tbn, pb ^ 1); GS_STORE(tbw, XS); LBAR(); } while (0)
#define GS_STEP_STATE(cc) do { const int c = (cc); const int tb = c % 3, pb = c & 1; \
            const LAS unsigned char* B = L + tb * GS_BUF; const LAS unsigned char* P = L + GS_P + pb * GS_PB; \
            const int orig = dir ? 127 - c : c; const size_t row0 = (size_t)b * SEQ + 64 * orig; \
              \
            bf16x8 vf[2]; u32x4 qe[2][2][4]; bf16x8 pf[2][2][2]; bf16x8 kt[2][2][2]; f32x4 decn[2][2]; \
_Pragma("unroll")             for (int kk = 0; kk < 2; ++kk) { const LAS unsigned char* a = B + GS_V + (32 * kk + 8 * g4 + (r16 >> 2)) * 144 + (16 * w + 4 * (r16 & 3)) * 2; vf[kk] = cat8(ldtr(a), ldtr(a + 4 * 144)); } \
            GS_RD_A(0); GS_RD_A(1); GS_RD_B(0, 0); \
            __builtin_amdgcn_sched_barrier(0); \
            GS_CMP_A(0); __builtin_amdgcn_sched_barrier(0); \
            GS_CMP_A(1); __builtin_amdgcn_sched_barrier(0); \
            GS_RD_B(1, 1); __builtin_amdgcn_sched_barrier(0); GS_CMP_B(0, 0); __builtin_amdgcn_sched_barrier(0); \
            GS_RD_B(2, 0); __builtin_amdgcn_sched_barrier(0); GS_CMP_B(1, 1); __builtin_amdgcn_sched_barrier(0); \
            GS_RD_B(3, 1); __builtin_amdgcn_sched_barrier(0); GS_CMP_B(2, 0); __builtin_amdgcn_sched_barrier(0); \
            GS_CMP_B(3, 1); \
            LBAR(); } while (0)
#define GS_RD_A(ih) do { _Pragma("unroll") for (int i2 = 0; i2 < 2; ++i2) { const int it = 2 * (ih) + i2; \
_Pragma("unroll")                 for (int ks = 0; ks < 4; ++ks) { const LAS unsigned char* qa = B + GS_QE + (16 * it + r16) * 272 + (32 * ks + 4 * g4) * 2; \
                    const u32x2 q0 = *(const LAS u32x2*)qa, q1 = *(const LAS u32x2*)(qa + 32); qe[ih][i2][ks] = (u32x4){q0.x, q0.y, q1.x, q1.y}; } \
_Pragma("unroll")                 for (int kk = 0; kk < 2; ++kk) pf[ih][i2][kk] = *(const LAS bf16x8*)(P + (16 * it + r16) * 144 + (32 * kk + 8 * g4) * 2); } } while (0)
#define GS_CMP_A(ih) do { _Pragma("unroll") for (int i2 = 0; i2 < 2; ++i2) { const int it = 2 * (ih) + i2; f32x4 o = (f32x4){0.f, 0.f, 0.f, 0.f}; \
_Pragma("unroll")                 for (int ks = 0; ks < 4; ++ks) o = mfma16(sbf[ks], __builtin_bit_cast(bf16x8, qe[ih][i2][ks]), o); \
_Pragma("unroll")                 for (int kk = 0; kk < 2; ++kk) o = mfma16(vf[kk], pf[ih][i2][kk], o); \
                { u32x2* op_ = (u32x2*)(Og + (row0 + 16 * it + r16) * 1024 + h * 256 + dvq * 64 + 16 * w + 4 * g4); const u32x2 ov_ = (u32x2){cvtpk(o[0], o[1]), cvtpk(o[2], o[3])}; *op_ = ov_; } } } while (0)
#define GS_RD_B(ks, s_) do { _Pragma("unroll") for (int d = 0; d < 2; ++d) { const int dkt = 2 * (ks) + d; \
_Pragma("unroll")                 for (int kk = 0; kk < 2; ++kk) { const LAS unsigned char* a = B + GS_KE + (32 * kk + 8 * g4 + (r16 >> 2)) * 272 + (16 * dkt + 4 * (r16 & 3)) * 2; kt[s_][d][kk] = cat8(ldtr(a), ldtr(a + 4 * 272)); } \
                decn[s_][d] = *(const LAS f32x4*)(B + GS_CC + (16 * dkt + 4 * g4) * 4); } } while (0)
#define GS_CMP_B(ks, s_) do { u32x2 sw[2]; \
_Pragma("unroll")             for (int d = 0; d < 2; ++d) { const int dkt = 2 * (ks) + d; f32x4 ua = (f32x4){0.f, 0.f, 0.f, 0.f}; \
_Pragma("unroll")                 for (int kk = 0; kk < 2; ++kk) ua = mfma16(kt[s_][d][kk], vf[kk], ua); \
                sacc[dkt] = (sacc[dkt] + ua) * decn[s_][d]; \
                const f32x4 sb = sacc[dkt]; sw[d] = (u32x2){cvtpk(sb[0], sb[1]), cvtpk(sb[2], sb[3])}; } \
            sbf[ks] = __builtin_bit_cast(bf16x8, (u32x4){sw[0].x, sw[0].y, sw[1].x, sw[1].y}); } while (0)
        if (w >= 4) {
            GS_LOAD(0, A); GS_LOAD(1, B);
            for (int o = st * 16; o < 2 * GS_PB; o += 4096) *(LAS v4u*)(L + GS_P + o) = (v4u){0u, 0u, 0u, 0u};
            GS_STORE(0, A); GS_STORE(1, B); GS_LOAD(2, A);
            LBAR();
            GS_SCORES(0, 0);
            LBAR();
            for (int c2 = 0; c2 < 128; c2 += 2) { GS_STEP_SCORE(c2, A, B); GS_STEP_SCORE(c2 + 1, B, A); }
        } else {
            f32x4 sacc[8]; bf16x8 sbf[4];
#pragma unroll
            for (int d = 0; d < 8; ++d) sacc[d] = (f32x4){0.f, 0.f, 0.f, 0.f};
#pragma unroll
            for (int ks = 0; ks < 4; ++ks) sbf[ks] = (bf16x8){0, 0, 0, 0, 0, 0, 0, 0};
            LBAR();
            LBAR();
            for (int c2 = 0; c2 < 128; ++c2) GS_STEP_STATE(c2);
        }
#undef GS_STEP_SCORE
#undef GS_STEP_STATE
#undef GS_RD_A
#undef GS_CMP_A
#undef GS_RD_B
#undef GS_CMP_B
#undef GS_LOAD
#undef GS_STORE
#undef GS_SCORES
    }
}

__device__ __forceinline__ void gla_post(Frame& F) {
    const int gw = F.vcu * NWAVES + F.wave, NGW = F.G * NWAVES, lane = lane_id();
    const bf16* OFp = (const bf16*)(F.ws + WS_OF); const bf16* OBp = (const bf16*)((const unsigned char*)F.out + OUT_OB); const bf16* R0 = (const bf16*)(F.ws + WS_R0); bf16* Gp = (bf16*)(F.ws + WS_G);
    float gn[16];
#pragma unroll
    for (int j = 0; j < 4; ++j) { const f32x4 t = *(const f32x4*)(F.in[8] + 16 * lane + 4 * j); gn[4 * j] = t.x; gn[4 * j + 1] = t.y; gn[4 * j + 2] = t.z; gn[4 * j + 3] = t.w; }
    v4u nx[6];
    if (gw < NTOK) { const size_t off = (size_t)gw * 1024 + 16 * lane; nx[0] = *(const v4u*)(OFp + off); nx[1] = *(const v4u*)(OFp + off + 8); nx[2] = *(const v4u*)(OBp + off); nx[3] = *(const v4u*)(OBp + off + 8); nx[4] = *(const v4u*)(R0 + off); nx[5] = *(const v4u*)(R0 + off + 8); }
    for (int m = gw; m < NTOK; m += NGW) {
        const size_t off = (size_t)m * 1024 + 16 * lane;
        const v4u a0 = nx[0], a1 = nx[1], b0 = nx[2], b1 = nx[3], r0 = nx[4], r1 = nx[5];
        { const int mn = (m + NGW < NTOK) ? m + NGW : m; const size_t offn = (size_t)mn * 1024 + 16 * lane;
          nx[0] = *(const v4u*)(OFp + offn); nx[1] = *(const v4u*)(OFp + offn + 8); nx[2] = *(const v4u*)(OBp + offn); nx[3] = *(const v4u*)(OBp + offn + 8); nx[4] = *(const v4u*)(R0 + offn); nx[5] = *(const v4u*)(R0 + offn + 8); }
        float o[16], rr[16]; float ss = 0.f;
#pragma unroll
        for (int j = 0; j < 4; ++j) { o[2 * j] = bf_lo(a0[j]) + bf_lo(b0[j]); o[2 * j + 1] = bf_hi(a0[j]) + bf_hi(b0[j]); o[8 + 2 * j] = bf_lo(a1[j]) + bf_lo(b1[j]); o[8 + 2 * j + 1] = bf_hi(a1[j]) + bf_hi(b1[j]);
            rr[2 * j] = bf_lo(r0[j]); rr[2 * j + 1] = bf_hi(r0[j]); rr[8 + 2 * j] = bf_lo(r1[j]); rr[8 + 2 * j + 1] = bf_hi(r1[j]); }
#pragma unroll
        for (int j = 0; j < 16; ++j) ss += o[j] * o[j];
        ss += __shfl_xor(ss, 1); ss += __shfl_xor(ss, 2); ss += __shfl_xor(ss, 4); ss += __shfl_xor(ss, 8);
        const float rs = 1.0f / sqrtf(ss * (1.f / 256.f) + NORM_EPS);
        float y[16];
#pragma unroll
        for (int j = 0; j < 16; ++j) y[j] = o[j] * rs * gn[j] * pg8::silu_f(rr[j]);
        v4u w0, w1;
#pragma unroll
        for (int j = 0; j < 4; ++j) { w0[j] = cvtpk(y[2 * j], y[2 * j + 1]); w1[j] = cvtpk(y[8 + 2 * j], y[8 + 2 * j + 1]); }
        *(v4u*)(Gp + off) = w0; *(v4u*)(Gp + off + 8) = w1;
    }
}

constexpr int AT_K = 0, AT_V = 55296, AT_STRIDE = 144;
static_assert(2 * 55296 <= RING_BYTES, "attention LDS");
__device__ __forceinline__ void swa_attn(Frame& F) {
    const int lane = lane_id(), tid = F.wave * 64 + lane, w = F.wave, r16 = lane & 15, g4 = lane >> 4;
    LAS unsigned char* L = F.lds + RING_OFF;
    const bf16* Q1 = (const bf16*)(F.ws + WS_Q1); const bf16* K1 = (const bf16*)(F.ws + WS_K1); const bf16* V1 = (const bf16*)(F.ws + WS_V1); bf16* O1 = (bf16*)(F.ws + WS_O1);
    v4u kr[6], vr[6];
#define AT_FETCH(u_) do { const int b_ = (u_) >> 8, g_ = ((u_) >> 6) & 3, kb_ = (((u_) & 63) - 1) * 128; \
        _Pragma("unroll") for (int i = 0; i < 6; ++i) { const int piece = tid + 512 * i, row = piece >> 3, ch = piece & 7; int tok = kb_ + row; tok = tok < 0 ? 0 : (tok >= SEQ ? SEQ - 1 : tok); \
            const size_t go = ((size_t)b_ * SEQ + tok) * 256 + g_ * 64 + ch * 8; kr[i] = *(const v4u*)(K1 + go); vr[i] = *(const v4u*)(V1 + go); } } while (0)
    bf16x8 qfn[4][2];
#define AT_FETCHQ(u_) do { const int b_ = (u_) >> 8, g_ = ((u_) >> 6) & 3, nb_ = (u_) & 63; const int hq_ = 4 * g_ + (w >> 1), q0_ = nb_ * 128 + 64 * (w & 1); \
        _Pragma("unroll") for (int qt = 0; qt < 4; ++qt) _Pragma("unroll") for (int ks = 0; ks < 2; ++ks) qfn[qt][ks] = *(const bf16x8*)(Q1 + ((size_t)b_ * SEQ + q0_ + 16 * qt + r16) * 1024 + hq_ * 64 + 32 * ks + 8 * g4); } while (0)
    if (F.vcu < 2048) { AT_FETCHQ(F.vcu); AT_FETCH(F.vcu); }
    for (int u = F.vcu; u < 2048; u += F.G) {
        const int b = u >> 8, g = (u >> 6) & 3, nb = u & 63;
        const int kbase = (nb - 1) * 128;
        LBAR();
#pragma unroll
        for (int i = 0; i < 6; ++i) { const int piece = tid + 512 * i, row = piece >> 3, ch = piece & 7;
            *(LAS v4u*)(L + AT_K + row * AT_STRIDE + ch * 16) = kr[i]; *(LAS v4u*)(L + AT_V + row * AT_STRIDE + ch * 16) = vr[i]; }
        const int hq = 4 * g + (w >> 1), q0w = nb * 128 + 64 * (w & 1);
        bf16x8 qfa[4][2];
#pragma unroll
        for (int qt = 0; qt < 4; ++qt)
#pragma unroll
            for (int ks = 0; ks < 2; ++ks) qfa[qt][ks] = qfn[qt][ks];
        { const int un = (u + F.G < 2048) ? u + F.G : u; AT_FETCHQ(un); AT_FETCH(un); }
        const float slope = exp2f(-0.5f * (float)(hq + 1)) * LOG2E, sink2 = F.in[12][hq] * LOG2E;
        const float clf = (float)(r16 - 4 * g4);
        LBAR();
        for (int pass = 0; pass < 2; ++pass) {
            const int q0 = q0w + 32 * pass;
            bf16x8 qf[2][2];
#pragma unroll
            for (int qt = 0; qt < 2; ++qt)
#pragma unroll
                for (int ks = 0; ks < 2; ++ks) qf[qt][ks] = pass ? qfa[2 + qt][ks] : qfa[qt][ks];
            float mrun[2], lrun[2]; f32x4 oacc[2][4];
#pragma unroll
            for (int qt = 0; qt < 2; ++qt) { mrun[qt] = sink2; lrun[qt] = (g4 == 0) ? 1.f : 0.f;
#pragma unroll
                for (int dt = 0; dt < 4; ++dt) oacc[qt][dt] = (f32x4){0.f, 0.f, 0.f, 0.f}; }
            for (int t = 0; t < 9; ++t) {
                const int ktok0 = q0 - 128 + 32 * t, s0 = ktok0 - kbase;
                if (ktok0 < 0 || ktok0 >= SEQ) continue;
                bf16x8 kf[2][2];
#pragma unroll
                for (int sub = 0; sub < 2; ++sub)
#pragma unroll
                    for (int ks = 0; ks < 2; ++ks) kf[sub][ks] = *(const LAS bf16x8*)(L + AT_K + (s0 + 16 * sub + r16) * AT_STRIDE + ks * 64 + g4 * 16);
                bf16x8 vf[4];
#pragma unroll
                for (int dt = 0; dt < 4; ++dt) { const LAS unsigned char* a = L + AT_V + (s0 + 4 * g4 + (r16 >> 2)) * AT_STRIDE + (16 * dt + 4 * (r16 & 3)) * 2; vf[dt] = cat8(ldtr(a), ldtr(a + 16 * AT_STRIDE)); }
#pragma unroll
                for (int qt = 0; qt < 2; ++qt) {
                    f32x4 s[2];
#pragma unroll
                    for (int sub = 0; sub < 2; ++sub) { s[sub] = (f32x4){0.f, 0.f, 0.f, 0.f};
#pragma unroll
                        for (int ks = 0; ks < 2; ++ks) s[sub] = mfma16(kf[sub][ks], qf[qt][ks], s[sub]); }
                    const int d0 = 128 - 32 * t + 16 * qt; float mx = -INFINITY;
                    if ((d0 >= 31 && d0 <= 113) || (d0 <= -15 && d0 >= -97)) {
                        const float sg = d0 > 0 ? -slope : slope, b0 = -slope * (float)(d0 > 0 ? d0 : -d0) + sg * clf;
#pragma unroll
                        for (int sub = 0; sub < 2; ++sub)
#pragma unroll
                            for (int r = 0; r < 4; ++r) { const float v = s[sub][r] + (b0 - sg * (float)(16 * sub + r)); s[sub][r] = v; mx = fmaxf(mx, v); }
                    } else {
                        const float dlf = clf + (float)d0;
#pragma unroll
                        for (int sub = 0; sub < 2; ++sub)
#pragma unroll
                            for (int r = 0; r < 4; ++r) { const float ad = __builtin_fabsf(dlf - (float)(16 * sub + r));
                                float v = __builtin_fmaf(-slope, ad, s[sub][r]); v = (ad > 128.0f) ? -INFINITY : v; s[sub][r] = v; mx = fmaxf(mx, v); }
                    }
                    if (__any(mx > mrun[qt] + 6.0f)) {
                        mx = fmaxf(mx, __shfl_xor(mx, 16)); mx = fmaxf(mx, __shfl_xor(mx, 32));
                        const float mnew = fmaxf(mrun[qt], mx), alpha = __builtin_amdgcn_exp2f(mrun[qt] - mnew); mrun[qt] = mnew; lrun[qt] *= alpha;
#pragma unroll
                        for (int dt = 0; dt < 4; ++dt) oacc[qt][dt] = oacc[qt][dt] * alpha;
                    }
                    const float off = -mrun[qt]; float ps = 0.f;
#pragma unroll
                    for (int sub = 0; sub < 2; ++sub)
#pragma unroll
                        for (int r = 0; r < 4; ++r) { const float p = __builtin_amdgcn_exp2f(s[sub][r] + off); s[sub][r] = p; ps += p; }
                    lrun[qt] += ps;
                    const u32x4 pw = (u32x4){cvtpk(s[0][0], s[0][1]), cvtpk(s[0][2], s[0][3]), cvtpk(s[1][0], s[1][1]), cvtpk(s[1][2], s[1][3])};
#pragma unroll
                    for (int dt = 0; dt < 4; ++dt) oacc[qt][dt] = mfma16(vf[dt], __builtin_bit_cast(bf16x8, pw), oacc[qt][dt]);
                }
            }
#pragma unroll
            for (int qt = 0; qt < 2; ++qt) { float l = lrun[qt]; l += __shfl_xor(l, 16); l += __shfl_xor(l, 32); const float inv = 1.0f / l;
                bf16* op = O1 + ((size_t)b * SEQ + q0 + 16 * qt + r16) * 1024 + hq * 64 + 4 * g4;
#pragma unroll
                for (int dt = 0; dt < 4; ++dt) { const f32x4 o = oacc[qt][dt] * inv; *(u32x2*)(op + 16 * dt) = (u32x2){cvtpk(o[0], o[1]), cvtpk(o[2], o[3])}; } }
        }
    }
}

#undef AT_FETCH
#undef AT_FETCHQ
__device__ __forceinline__ void moe_route(Frame& F, const bf16* HB, const float* ssp, const float* gain) {
    const int gw = F.vcu * NWAVES + F.wave, NGW = F.G * NWAVES, lane = lane_id();
    unsigned char* XN = F.ws + WS_XN; int* sel = (int*)(F.ws + WS_SEL); float* wsel = (float*)(F.ws + WS_WSEL); int* wcnt = (int*)(F.ws + WS_WCNT);
    const float* router = F.in[18];
    f32x4 g[4]; f32x4 rt[4][4][2];
    { LAS f32x4* rl = (LAS f32x4*)F.lds; const int tid = F.wave * 64 + lane;
      LBAR();
#pragma unroll
      for (int q = 0; q < 4; ++q) { const int pi = tid + 512 * q; const f32x4 v = ((const f32x4*)router)[pi]; rl[(((pi >> 9) * 8 + ((pi >> 1) & 3) * 2 + (pi & 1)) << 6) + ((pi >> 3) & 63)] = v; }
      LBAR();
#pragma unroll
      for (int j = 0; j < 4; ++j) { g[j] = ((const f32x4*)gain)[lane + 64 * j];
#pragma unroll
        for (int i = 0; i < 4; ++i) { rt[j][i][0] = rl[((j * 8 + i * 2) << 6) + lane]; rt[j][i][1] = rl[((j * 8 + i * 2 + 1) << 6) + lane]; } } }
    int cnt[8];
#pragma unroll
    for (int e = 0; e < 8; ++e) cnt[e] = 0;
    u32x2 hvn[4]; float sn = 0.f;
    if (gw < NTOK) { const GAS u32x2* xr = (const GAS u32x2*)(HB + (size_t)gw * DM) + lane;
#pragma unroll
        for (int j = 0; j < 4; ++j) hvn[j] = xr[64 * j];
        sn = ssp[(size_t)gw * 16 + (lane & 15)]; }
    for (int m = gw; m < NTOK; m += NGW) {
        u32x2 hvc[4]; float s = sn;
#pragma unroll
        for (int j = 0; j < 4; ++j) hvc[j] = hvn[j];
        { const int mn = (m + NGW < NTOK) ? m + NGW : m; const GAS u32x2* xr = (const GAS u32x2*)(HB + (size_t)mn * DM) + lane;
#pragma unroll
          for (int j = 0; j < 4; ++j) hvn[j] = xr[64 * j];
          sn = ssp[(size_t)mn * 16 + (lane & 15)]; }
        s += __shfl_xor(s, 1); s += __shfl_xor(s, 2); s += __shfl_xor(s, 4); s += __shfl_xor(s, 8);
        const float rs = 1.0f / sqrtf(s * (1.f / DM) + NORM_EPS);
        GAS unsigned* o4 = (GAS unsigned*)(XN + (size_t)m * DM) + lane;
        float lg[8];
#pragma unroll
        for (int e = 0; e < 8; ++e) lg[e] = 0.f;
#pragma unroll
        for (int j = 0; j < 4; ++j) { const u32x2 hv = hvc[j]; const f32x4 v = (f32x4){bf_lo(hv.x), bf_hi(hv.x), bf_lo(hv.y), bf_hi(hv.y)};
            const f32x4 o = v * rs * g[j]; o4[64 * j] = pk4f8(o.x * XSCALE, o.y * XSCALE, o.z * XSCALE, o.w * XSCALE);
#pragma unroll
            for (int i = 0; i < 4; ++i)
#pragma unroll
                for (int e = 0; e < 8; ++e) lg[e] += o[i] * rt[j][i][e >> 2][e & 3]; }
        { float a4[4], b2[2], c1;
#pragma unroll
          for (int i = 0; i < 4; ++i) { const float mine = (lane & 1) ? lg[4 + i] : lg[i], other = (lane & 1) ? lg[i] : lg[4 + i]; a4[i] = mine + __shfl_xor(other, 1); }
#pragma unroll
          for (int i = 0; i < 2; ++i) { const float mine = (lane & 2) ? a4[2 + i] : a4[i], other = (lane & 2) ? a4[i] : a4[2 + i]; b2[i] = mine + __shfl_xor(other, 2); }
          { const float mine = (lane & 4) ? b2[1] : b2[0], other = (lane & 4) ? b2[0] : b2[1]; c1 = mine + __shfl_xor(other, 4); }
          c1 += __shfl_xor(c1, 8); c1 += __shfl_xor(c1, 16); c1 += __shfl_xor(c1, 32);
          const int ci = __float_as_int(c1);
          lg[0] = __int_as_float(__builtin_amdgcn_readlane(ci, 0)); lg[4] = __int_as_float(__builtin_amdgcn_readlane(ci, 1)); lg[2] = __int_as_float(__builtin_amdgcn_readlane(ci, 2)); lg[6] = __int_as_float(__builtin_amdgcn_readlane(ci, 3));
          lg[1] = __int_as_float(__builtin_amdgcn_readlane(ci, 4)); lg[5] = __int_as_float(__builtin_amdgcn_readlane(ci, 5)); lg[3] = __int_as_float(__builtin_amdgcn_readlane(ci, 6)); lg[7] = __int_as_float(__builtin_amdgcn_readlane(ci, 7)); }
        int e0 = 0; float l0 = lg[0];
#pragma unroll
        for (int e = 1; e < 8; ++e) if (lg[e] > l0) { l0 = lg[e]; e0 = e; }
        int e1 = -1; float l1 = -INFINITY;
#pragma unroll
        for (int e = 0; e < 8; ++e) if (e != e0 && lg[e] > l1) { l1 = lg[e]; e1 = e; }
        const float w0 = 1.0f / (1.0f + __expf(l1 - l0)), w1 = 1.0f - w0;
        int rk0 = 0, rk1 = 0;
#pragma unroll
        for (int e = 0; e < 8; ++e) { rk0 = (e0 == e) ? cnt[e] : rk0; rk1 = (e1 == e) ? cnt[e] : rk1; cnt[e] += ((e0 == e) ? 1 : 0) + ((e1 == e) ? 1 : 0); }
        if (lane == 0) { *(int4*)(sel + (size_t)m * 4) = make_int4(e0, e1, rk0, rk1); *(float2*)(wsel + (size_t)m * 2) = make_float2(w0, w1); }
    }
    if (lane < 8) { int cv = 0;
#pragma unroll
        for (int e = 0; e < 8; ++e) cv = (lane == e) ? cnt[e] : cv;
        wcnt[(size_t)gw * 8 + lane] = cv; }
}
__device__ __forceinline__ void moe_gather(Frame& F) {
    const int gw = F.vcu * NWAVES + F.wave, NGW = F.G * NWAVES, lane = lane_id();
    const unsigned char* XN = F.ws + WS_XN; unsigned char* XS = F.ws + WS_XS;
    const int* sel = (const int*)(F.ws + WS_SEL); const float* wsel = (const float*)(F.ws + WS_WSEL); const int* wcnt = (const int*)(F.ws + WS_WCNT);
    int* postok = (int*)(F.ws + WS_POSTOK); float* roww = (float*)(F.ws + WS_ROWW); int* meta = (int*)(F.ws + WS_META);
    int base[8], tot[8];
#pragma unroll
    for (int e = 0; e < 8; ++e) { base[e] = 0; tot[e] = 0; }
    { const int tid = F.wave * 64 + lane, gw0 = F.vcu * NWAVES; LAS int* red = (LAS int*)F.lds;
      for (int qb = 0; qb < NGW; qb += 2048) {
      int4 av[4], cv[4];
#pragma unroll
      for (int q = 0; q < 4; ++q) { const int w2 = qb + tid + 512 * q, wc = (w2 < NGW) ? w2 : 0; av[q] = *(const int4*)(wcnt + (size_t)wc * 8); cv[q] = *(const int4*)(wcnt + (size_t)wc * 8 + 4); }
#pragma unroll
      for (int q = 0; q < 4; ++q) { const int w2 = qb + tid + 512 * q; const int vz = (w2 < NGW) ? 1 : 0, lt = (w2 < gw0) ? vz : 0; const int4 a = av[q], c = cv[q];
          tot[0] += vz * a.x; tot[1] += vz * a.y; tot[2] += vz * a.z; tot[3] += vz * a.w; tot[4] += vz * c.x; tot[5] += vz * c.y; tot[6] += vz * c.z; tot[7] += vz * c.w;
          base[0] += lt * a.x; base[1] += lt * a.y; base[2] += lt * a.z; base[3] += lt * a.w; base[4] += lt * c.x; base[5] += lt * c.y; base[6] += lt * c.z; base[7] += lt * c.w; }
      }
      LBAR();
#pragma unroll
      for (int e = 0; e < 8; ++e) { const int t = wave_sum_i(tot[e]), bs = wave_sum_i(base[e]); if (lane == 0) { red[F.wave * 16 + e] = t; red[F.wave * 16 + 8 + e] = bs; } }
      LBAR();
#pragma unroll
      for (int e = 0; e < 8; ++e) { int t = 0, bs = 0;
#pragma unroll
          for (int w2 = 0; w2 < 8; ++w2) { t += red[w2 * 16 + e]; bs += red[w2 * 16 + 8 + e]; }
          tot[e] = t; base[e] = bs; }
      for (int w2 = 0; w2 < F.wave; ++w2) { const int4 a = *(const int4*)(wcnt + (size_t)(gw0 + w2) * 8), c = *(const int4*)(wcnt + (size_t)(gw0 + w2) * 8 + 4);
          base[0] += a.x; base[1] += a.y; base[2] += a.z; base[3] += a.w; base[4] += c.x; base[5] += c.y; base[6] += c.z; base[7] += c.w; }
    }
    int ts[9]; ts[0] = 0;
#pragma unroll
    for (int e = 0; e < 8; ++e) { ts[e + 1] = ts[e] + ((tot[e] + 255) >> 8); base[e] += ts[e] * 256; }
    if (gw == 0 && lane < 9) { int tv = 0;
#pragma unroll
        for (int e = 0; e < 9; ++e) tv = (lane == e) ? ts[e] : tv;
        meta[lane] = tv; }
    for (int m0 = gw; m0 < NTOK; m0 += 4 * NGW) {
        int4 sv[4]; v4u a0[4];
#pragma unroll
        for (int j = 0; j < 4; ++j) { const int m = (m0 + j * NGW < NTOK) ? m0 + j * NGW : m0;
            sv[j] = *(const int4*)(sel + (size_t)m * 4); a0[j] = *(const v4u*)(XN + (size_t)m * 1024 + 16 * lane); }
#pragma unroll
        for (int j = 0; j < 4; ++j) { const int m = m0 + j * NGW; if (m < NTOK) {
            int p0 = 0, p1 = 0;
#pragma unroll
            for (int e = 0; e < 8; ++e) { p0 = (sv[j].x == e) ? base[e] : p0; p1 = (sv[j].y == e) ? base[e] : p1; }
            p0 += sv[j].z; p1 += sv[j].w;
            *(v4u*)(XS + (size_t)p0 * 1024 + 16 * lane) = a0[j]; *(v4u*)(XS + (size_t)p1 * 1024 + 16 * lane) = a0[j];
            if (lane == 0) *(int2*)(postok + (size_t)m * 2) = make_int2(p0, p1); } }
    }
}
__device__ __forceinline__ void final_rows(Frame& F, const bf16* HB, float* out, const float* gain) {
    const int gw = F.vcu * NWAVES + F.wave, NGW = F.G * NWAVES, lane = lane_id();
    const bf16* Y = (const bf16*)(F.ws + WS_XS); const int* postok = (const int*)(F.ws + WS_POSTOK);
    f32x4 g[4];
#pragma unroll
    for (int j = 0; j < 4; ++j) g[j] = ((const f32x4*)gain)[lane + 64 * j];
    u32x2 hv[4], ya[4], yc[4]; int2 ppn = make_int2(0, 0); float2 wq = make_float2(0.f, 0.f);
    const float* wsel = (const float*)(F.ws + WS_WSEL);
    if (gw < NTOK) { const int2 pp = *(const int2*)(postok + (size_t)gw * 2);
        const GAS u32x2* hr = (const GAS u32x2*)(HB + (size_t)gw * DM) + lane; const u32x2* y0 = (const u32x2*)(Y + (size_t)pp.x * 1024) + lane; const u32x2* y1 = (const u32x2*)(Y + (size_t)pp.y * 1024) + lane;
#pragma unroll
        for (int j = 0; j < 4; ++j) { hv[j] = hr[64 * j]; ya[j] = y0[64 * j]; yc[j] = y1[64 * j]; }
        wq = *(const float2*)(wsel + (size_t)gw * 2);
        const int m1 = (gw + NGW < NTOK) ? gw + NGW : gw; ppn = *(const int2*)(postok + (size_t)m1 * 2); }
    for (int m = gw; m < NTOK; m += NGW) {
        u32x2 hvc[4], yac[4], ycc[4]; const float2 wcur = wq;
#pragma unroll
        for (int j = 0; j < 4; ++j) { hvc[j] = hv[j]; yac[j] = ya[j]; ycc[j] = yc[j]; }
        { const int m1 = (m + NGW < NTOK) ? m + NGW : m, m2 = (m + 2 * NGW < NTOK) ? m + 2 * NGW : m; const int2 pp = ppn;
          const GAS u32x2* hr = (const GAS u32x2*)(HB + (size_t)m1 * DM) + lane; const u32x2* y0 = (const u32x2*)(Y + (size_t)pp.x * 1024) + lane; const u32x2* y1 = (const u32x2*)(Y + (size_t)pp.y * 1024) + lane;
#pragma unroll
          for (int j = 0; j < 4; ++j) { hv[j] = hr[64 * j]; ya[j] = y0[64 * j]; yc[j] = y1[64 * j]; }
          wq = *(const float2*)(wsel + (size_t)m1 * 2);
          ppn = *(const int2*)(postok + (size_t)m2 * 2); }
        GAS f32x4* xr = (GAS f32x4*)(out + (size_t)m * DM) + lane;
        f32x4 v[4]; float s = 0.f;
#pragma unroll
        for (int j = 0; j < 4; ++j) { const u32x2 h2 = hvc[j], a = yac[j], c = ycc[j];
            v[j].x = bf_lo(h2.x) + (wcur.x * bf_lo(a.x) + wcur.y * bf_lo(c.x)); v[j].y = bf_hi(h2.x) + (wcur.x * bf_hi(a.x) + wcur.y * bf_hi(c.x)); v[j].z = bf_lo(h2.y) + (wcur.x * bf_lo(a.y) + wcur.y * bf_lo(c.y)); v[j].w = bf_hi(h2.y) + (wcur.x * bf_hi(a.y) + wcur.y * bf_hi(c.y));
            s += (v[j].x * v[j].x + v[j].y * v[j].y) + (v[j].z * v[j].z + v[j].w * v[j].w); }
        const float rs = 1.0f / sqrtf(wave_sum(s) * (1.f / DM) + NORM_EPS);
#pragma unroll
        for (int j = 0; j < 4; ++j) xr[64 * j] = v[j] * rs * g[j];
    }
}

struct Args { const float* in[23]; float* out; unsigned char* ws; int ph_lo, ph_hi; };
__global__ void __launch_bounds__(NWAVES * 64, 2) fwd_kernel(Args args) {
    extern __shared__ __attribute__((aligned(16))) unsigned char lds[];
    Frame F;
    F.lds = (LAS unsigned char*)lds;
    F.MISC = (volatile LAS unsigned*)(F.lds + MISC_OFF);
    F.wave = __builtin_amdgcn_readfirstlane((int)threadIdx.x >> 6);
    F.G = gridDim.x; { const int bx = blockIdx.x; F.vcu = (F.G % 8 == 0) ? (bx % 8) * (F.G / 8) + bx / 8 : bx; }
    F.ws = args.ws; F.out = args.out;
    F.in = args.in;
    for (int u = F.wave * 64 + lane_id(); u < (LDS_BYTES - LDSCTL_OFF) / 4; u += NWAVES * 64) ((LAS unsigned*)(F.lds + LDSCTL_OFF))[u] = 0u;
    __syncthreads();
    const int lo = args.ph_lo, hi = args.ph_hi;
    if (hi - lo > 1) (void)xcd_barrier_post((unsigned*)(F.ws + WS_CTL) + CW_BAR, F.MISC + 8, (F.wave == 0 && lane_id() == 0) ? 1u : 0u);
#define MKBAR() do { XcdBarrier bar_; bar_.bar = (unsigned*)(F.ws + WS_CTL) + CW_BAR; bar_.x = xb_xcc_id(); bar_.st = (volatile LAS unsigned*)(F.lds + MISC_OFF) + 8; bar_.t0 = (F.wave == 0 && lane_id() == 0) ? 1u : 0u; xcd_barrier(bar_); } while (0)
#ifndef MK_PHASE_MASK
#define MK_PHASE_MASK 0xFFFFu
#endif
#define IN(k) (((MK_PHASE_MASK >> (k)) & 1u) && lo <= (k) && (k) < hi)
#ifndef MK_BAR_REP
#define MK_BAR_REP 1
#endif
#define SEAM(k) do { if (IN(k) && IN((k) + 1)) { _Pragma("nounroll") for (int r_ = 0; r_ < MK_BAR_REP; ++r_) MKBAR(); } } while (0)
    bf16* XB = (bf16*)((unsigned char*)F.out + OUT_XB); bf16* HB = (bf16*)(F.ws + WS_HB);

#define PH0 do { p0_weights(F, args.in[3], args.in[9], args.in[10], args.in[13], args.in[15], args.in[16], args.in[17], args.in[19], args.in[20], args.in[21], F.in[1], F.in[2], F.in[1] + DM); \
        convert_rows(F, F.in[0], XB, (float*)(F.ws + WS_SS0), args.in[3], F.in[1], (float*)(F.ws + WS_LR)); } while (0)
#define PH1 do { pg8::Gemm g{XB, (const bf16*)(F.ws + WS_W_GLAIN), NTOK, 3072, 1024}; pg8::StaticOrder S0; S0.init(NTOK, 3072, F.G, (int)blockIdx.x); const auto S = pg8::unitlist_fill(F.lds + UL_OFF, S0, F.wave); \
        pg8::rowcache_fill(F.lds + AUX_OFF, S, (const float*)(F.ws + WS_SS0), 1, F.wave); \
        pg8::EpiGlaIn E{(bf16*)(F.ws + WS_Q0), (bf16*)(F.ws + WS_K0), (bf16*)(F.ws + WS_V0), (bf16*)(F.ws + WS_R0), (float*)(F.ws + WS_LR), (const float*)(F.ws + WS_SS0), F.lds + AUX_OFF}; \
        pg8::gemm_phase<pg8::EpiGlaIn, pg8::ListOrder<pg8::StaticOrder>, MK_DENSE_ALIGN, MK_DENSE_SP2>(F.lds + RING_OFF, g, S, E, F.wave); } while (0)
#define PH2 do { gla_prep(F); } while (0)
#define PH3 do { gla_scan(F); } while (0)
#define PH4 do { gla_post(F); } while (0)
#define PH5 do { pg8::Gemm g{(const bf16*)(F.ws + WS_G), (const bf16*)(F.ws + WS_W_GLAOUT), NTOK, 1024, 1024}; pg8::StaticOrder S0; S0.init(NTOK, 1024, F.G, (int)blockIdx.x); const auto S = pg8::unitlist_fill(F.lds + UL_OFF, S0, F.wave); \
        pg8::EpiResBf16 E{XB, HB, nullptr, (float*)(F.ws + WS_SSP1), 1.0f}; \
        pg8::gemm_phase<pg8::EpiResBf16, pg8::ListOrder<pg8::StaticOrder>, MK_DENSE_ALIGN, MK_DENSE_SP2>(F.lds + RING_OFF, g, S, E, F.wave); } while (0)
#define PH6 do { pg8::Gemm g{HB, (const bf16*)(F.ws + WS_W_DGU), NTOK, 5632, 1024}; pg8::StaticOrder S0; S0.init(NTOK, 5632, F.G, (int)blockIdx.x); const auto S = pg8::unitlist_fill(F.lds + UL_OFF, S0, F.wave); \
        pg8::rowcache_fill(F.lds + AUX_OFF, S, (const float*)(F.ws + WS_SSP1), 16, F.wave); \
        pg8::EpiSwiglu E{(bf16*)(F.ws + WS_ACT0), DFF, 22, (const float*)(F.ws + WS_SSP1), F.lds + AUX_OFF, MK_DDN_FP8 ? ASCALE : 0.f}; \
        pg8::gemm_phase<pg8::EpiSwiglu, pg8::ListOrder<pg8::StaticOrder>, MK_DENSE_ALIGN, MK_DENSE_SP2>(F.lds + RING_OFF, g, S, E, F.wave); } while (0)
#define PH7 do { pg8::Gemm g{(const bf16*)(F.ws + WS_ACT0), (const bf16*)(F.ws + WS_W_DDN), NTOK, 1024, MK_DDN_FP8 ? DFF / 2 : DFF}; pg8::StaticOrder S0; S0.init(NTOK, 1024, F.G, (int)blockIdx.x); const auto S = pg8::unitlist_fill(F.lds + UL_OFF, S0, F.wave); \
        pg8::EpiResBf16 E{HB, HB, nullptr, (float*)(F.ws + WS_SSP2), MK_DDN_FP8 ? 1.0f / (ASCALE * WSCALE) : 1.0f}; \
        pg8::gemm_phase<pg8::EpiResBf16, pg8::ListOrder<pg8::StaticOrder>, MK_DENSE_ALIGN, MK_DENSE_SP2, (MK_DDN_FP8 != 0)>(F.lds + RING_OFF, g, S, E, F.wave); } while (0)
#define PH8 do { pg8::Gemm g{HB, (const bf16*)(F.ws + WS_W_QKV), NTOK, 1536, 1024}; pg8::StaticOrder S0; S0.init(NTOK, 1536, F.G, (int)blockIdx.x); const auto S = pg8::unitlist_fill(F.lds + UL_OFF, S0, F.wave); \
        pg8::rowcache_fill(F.lds + AUX_OFF, S, (const float*)(F.ws + WS_SSP2), 16, F.wave); \
        pg8::EpiQkv E{(bf16*)(F.ws + WS_Q1), (bf16*)(F.ws + WS_K1), (bf16*)(F.ws + WS_V1), F.in[11], (const float*)(F.ws + WS_SSP2), F.lds + AUX_OFF}; \
        pg8::gemm_phase<pg8::EpiQkv, pg8::ListOrder<pg8::StaticOrder>, MK_DENSE_ALIGN, MK_DENSE_SP2>(F.lds + RING_OFF, g, S, E, F.wave); } while (0)
#define PH9 do { swa_attn(F); } while (0)
#define PH10 do { pg8::Gemm g{(const bf16*)(F.ws + WS_O1), (const bf16*)(F.ws + WS_W_SWAOUT), NTOK, 1024, 1024}; pg8::StaticOrder S0; S0.init(NTOK, 1024, F.G, (int)blockIdx.x); const auto S = pg8::unitlist_fill(F.lds + UL_OFF, S0, F.wave); \
        pg8::EpiResBf16 E{HB, HB, F.in[14], (float*)(F.ws + WS_SSP3), 1.0f}; \
        pg8::gemm_phase<pg8::EpiResBf16, pg8::ListOrder<pg8::StaticOrder>, MK_DENSE_ALIGN, MK_DENSE_SP2>(F.lds + RING_OFF, g, S, E, F.wave); } while (0)
#define PH11 do { moe_route(F, HB, (const float*)(F.ws + WS_SSP3), F.in[2] + DM); } while (0)
#define PH12 do { moe_gather(F); } while (0)
#define PH13 do { pg8::MoeOrder S0; S0.init((const int*)(F.ws + WS_META), 22, F.G, (int)blockIdx.x); const auto S = pg8::unitlist_fill(F.lds + UL_OFF, S0, F.wave); \
        pg8::Gemm g{(const bf16*)(F.ws + WS_XS), (const bf16*)(F.ws + WS_W_MGU), 0, 0, 512}; \
        pg8::EpiSwiglu8 E{F.ws + WS_ACT1, DFF, 22, 1.0f / (XSCALE * WSCALE), ASCALE}; \
        pg8::gemm_phase<pg8::EpiSwiglu8, pg8::ListOrder<pg8::MoeOrder>, MK_P13_ALIGN, MK_P13_SP2, true>(F.lds + RING_OFF, g, S, E, F.wave); } while (0)
#ifndef MK_P14_REV
#define MK_P14_REV 0
#endif
#ifndef MK_P14_ALIGN
#define MK_P14_ALIGN true
#endif
#ifndef MK_P14_SP2
#define MK_P14_SP2 true
#endif
#define PH14 do { pg8::MoeOrder S0; S0.init((const int*)(F.ws + WS_META), 4, F.G, (int)blockIdx.x, MK_P14_REV); const auto S = pg8::unitlist_fill(F.lds + UL_OFF, S0, F.wave); \
        pg8::Gemm g{(const bf16*)(F.ws + WS_ACT1), (const bf16*)(F.ws + WS_W_MDN), 0, 0, DFF / 2}; \
        pg8::EpiMoeDown E{(bf16*)(F.ws + WS_XS), 0}; \
        pg8::gemm_phase<pg8::EpiMoeDown, pg8::ListOrder<pg8::MoeOrder>, MK_P14_ALIGN, MK_P14_SP2, true>(F.lds + RING_OFF, g, S, E, F.wave); } while (0)
#define PH15 do { final_rows(F, HB, F.out, F.in[22]); } while (0)
#ifndef MK_DENSE_ALIGN
#define MK_DENSE_ALIGN true
#endif
#ifndef MK_DENSE_SP2
#define MK_DENSE_SP2 true
#endif
#ifndef MK_P13_ALIGN
#define MK_P13_ALIGN true
#endif
#ifndef MK_P13_SP2
#define MK_P13_SP2 true
#endif
#ifndef MK_REP_PHASE
#define MK_REP_PHASE -1
#endif
#define RUN(k) do { if (IN(k)) { PH##k; if (MK_REP_PHASE == (k)) { MKBAR(); PH##k; } } } while (0)
    RUN(0); SEAM(0); RUN(1); SEAM(1); RUN(2); SEAM(2); RUN(3); SEAM(3); RUN(4); SEAM(4); RUN(5); SEAM(5); RUN(6);
    SEAM(6); RUN(7); SEAM(7); RUN(8); SEAM(8);
    RUN(9); SEAM(9); RUN(10); SEAM(10); RUN(11); SEAM(11); RUN(12); SEAM(12); RUN(13); SEAM(13); RUN(14); SEAM(14); RUN(15);
#undef IN
#undef SEAM
}

extern "C" void kernel_launch(void* const* d_in, const int* in_sizes, int n_in, void* d_out, int out_size, void* d_ws, size_t ws_size, hipStream_t stream) {
    static int grid = 0;
    if (grid == 0) {
        if (n_in != 23 || in_sizes[0] != NTOK * DM || out_size != NTOK * DM || ws_size < WS_END) {
            fprintf(stderr, "kernel_launch: built for 23 inputs, x/out of %d floats, >= %zu bytes of workspace; got n_in %d, in0 %d, out %d, ws %zu; nothing launched\n", NTOK * DM, (size_t)WS_END, n_in, n_in > 0 ? in_sizes[0] : -1, out_size, ws_size); grid = -1; return; }
        int dev = 0, cus = 0, per_cu = 0;
        if (hipGetDevice(&dev) != hipSuccess || hipDeviceGetAttribute(&cus, hipDeviceAttributeMultiprocessorCount, dev) != hipSuccess) { fprintf(stderr, "kernel_launch: device query failed\n"); grid = -1; return; }
        if (hipFuncSetAttribute((const void*)fwd_kernel, hipFuncAttributeMaxDynamicSharedMemorySize, LDS_BYTES) != hipSuccess) { fprintf(stderr, "kernel_launch: hipFuncSetAttribute failed\n"); grid = -1; return; }
        if (hipOccupancyMaxActiveBlocksPerMultiprocessor(&per_cu, (const void*)fwd_kernel, NWAVES * 64, LDS_BYTES) != hipSuccess || per_cu < 1) {
            fprintf(stderr, "kernel_launch: occupancy query reports %d workgroups per CU\n", per_cu); (void)hipGetLastError(); grid = -1; return; }
        grid = cus;
    }
    if (grid < 0) return;
    if (hipMemsetAsync((char*)d_ws + WS_CTL, 0, CTL_ZERO_BYTES, stream) != hipSuccess) { fprintf(stderr, "kernel_launch: memset failed\n"); return; }
    Args a{};
    for (int i = 0; i < 23; ++i) a.in[i] = (const float*)d_in[i];
    a.out = (float*)d_out; a.ws = (unsigned char*)d_ws;
#if MK_ONE_LAUNCH
    a.ph_lo = 0; a.ph_hi = NPHASE;
    hipLaunchKernelGGL(fwd_kernel, dim3(grid), dim3(NWAVES * 64), LDS_BYTES, stream, a);
#else
    for (int p = 0; p < NPHASE; ++p) { a.ph_lo = p; a.ph_hi = p + 1; hipLaunchKernelGGL(fwd_kernel, dim3(grid), dim3(NWAVES * 64), LDS_BYTES, stream, a); }
#endif
    const hipError_t le = hipPeekAtLastError();
    if (le != hipSuccess) fprintf(stderr, "kernel_launch: launch failed: %s\n", hipGetErrorName(le));
}
```
